# Optimizing an MI355X kernel written in HIP

```python
import jax, jax.numpy as jnp
from jax import lax
import numpy as np

D_MODEL = 1024
BATCH = 16
SEQ = 2048
DEPTH = 1
DEC_BATCH = 128
DEC_SEQ = 8
PAST_LEN = 16384
PAGE_SIZE = 128

PLE_DIM = 256
D_FF = 2816
NORM_EPS = 1e-6
GDN_HEADS = 4
GDN_DK = 128
GDN_DV = 128
GDN_CONV = 4
GDN_CHUNK = 64
SWA_HEADS = 8
SWA_KV_HEADS = 2
SWA_HD = 64
WINDOW = 128
ROT_DIM = SWA_HD // 4
ROPE_THETA = 500000.0

GDN_QK_W = GDN_HEADS * GDN_DK
GDN_V_W = GDN_HEADS * GDN_DV
GDN_CONV_W = 2 * GDN_QK_W + GDN_V_W
SWA_Q_W = SWA_HEADS * SWA_HD
SWA_KV_W = SWA_KV_HEADS * SWA_HD
MIX_W = GDN_V_W + SWA_Q_W
IN_SIZES = (GDN_CONV_W, GDN_V_W, GDN_HEADS, GDN_HEADS, SWA_Q_W, SWA_KV_W, SWA_KV_W)
IN_W = sum(IN_SIZES)

kernel_name = 'hymba_gdn_swa_macaron_decode_step'


def rmsnorm(x, g):
    xf = x.astype(jnp.float32)
    xf = xf * lax.rsqrt(jnp.mean(xf * xf, axis=-1, keepdims=True) + NORM_EPS)
    return (xf * g.astype(jnp.float32)).astype(x.dtype)


def swiglu(x, w_gu, w_down):
    gate, up = jnp.split(x @ w_gu, 2, axis=-1)
    return (jax.nn.silu(gate) * up) @ w_down


def l2norm(x):
    return x * lax.rsqrt(jnp.sum(x * x, axis=-1, keepdims=True) + 1e-6)


def causal_conv(x, buf, w):
    T = x.shape[1]
    full = jnp.concatenate([buf.astype(x.dtype), x], axis=1)
    out = full[:, 0:T] * w[0]
    for j in range(1, GDN_CONV):
        out = out + full[:, j:j + T] * w[j]
    return jax.nn.silu(out), full[:, -(GDN_CONV - 1):]


def rope_partial(x, pos):
    half = ROT_DIM // 2
    inv = ROPE_THETA ** (-jnp.arange(half, dtype=jnp.float32) * 2.0 / ROT_DIM)
    ang = pos.astype(jnp.float32)[:, None] * inv[None, :]
    cos = jnp.cos(ang)[None, :, None, :]
    sin = jnp.sin(ang)[None, :, None, :]
    xf = x.astype(jnp.float32)
    x1 = xf[..., :half]
    x2 = xf[..., half:ROT_DIM]
    out = jnp.concatenate([x1 * cos - x2 * sin, x2 * cos + x1 * sin, xf[..., ROT_DIM:]], axis=-1)
    return out.astype(x.dtype)


def sink_softmax(s, mask, sinks):
    s = jnp.where(mask, s, -jnp.inf)
    sk = sinks.astype(jnp.float32).reshape(SWA_KV_HEADS, SWA_HEADS // SWA_KV_HEADS)[:, :, None, None]
    m = jnp.maximum(jnp.max(s, axis=-1, keepdims=True), sk)
    p = jnp.exp(s - m)
    return p / (jnp.sum(p, axis=-1, keepdims=True) + jnp.exp(sk - m))


def swa_prompt(q, k, v, sinks):
    B, T = q.shape[:2]
    G = SWA_HEADS // SWA_KV_HEADS
    NB = T // WINDOW
    qb = q.reshape(B, NB, WINDOW, SWA_KV_HEADS, G, SWA_HD)
    pad = ((0, 0), (WINDOW, 0), (0, 0), (0, 0))
    kp = jnp.pad(k, pad).reshape(B, NB + 1, WINDOW, SWA_KV_HEADS, SWA_HD)
    vp = jnp.pad(v, pad).reshape(B, NB + 1, WINDOW, SWA_KV_HEADS, SWA_HD)
    kk = jnp.concatenate([kp[:, :-1], kp[:, 1:]], axis=2)
    vv = jnp.concatenate([vp[:, :-1], vp[:, 1:]], axis=2)
    s = jnp.einsum('bnqkgd,bnskd->bnkgqs', qb, kk, preferred_element_type=jnp.float32) * (SWA_HD ** -0.5)
    blk = jnp.arange(NB)[:, None] * WINDOW
    qpos = blk + jnp.arange(WINDOW)[None, :]
    kpos = blk - WINDOW + jnp.arange(2 * WINDOW)[None, :]
    diff = qpos[:, :, None] - kpos[:, None, :]
    mask = (diff >= 0) & (diff < WINDOW) & (kpos[:, None, :] >= 0)
    p = sink_softmax(s, mask[:, None, None], sinks)
    o = jnp.einsum('bnkgqs,bnskd->bnqkgd', p.astype(vv.dtype), vv)
    return o.reshape(B, T, SWA_Q_W)


def swa_sample(q, k, v, k_buf, v_buf, sinks):
    B, T = q.shape[:2]
    G = SWA_HEADS // SWA_KV_HEADS
    wb = k_buf.shape[1]
    kk = jnp.concatenate([k_buf.astype(k.dtype), k], axis=1)
    vv = jnp.concatenate([v_buf.astype(v.dtype), v], axis=1)
    qg = q.reshape(B, T, SWA_KV_HEADS, G, SWA_HD)
    s = jnp.einsum('bqkgd,bskd->bkgqs', qg, kk, preferred_element_type=jnp.float32) * (SWA_HD ** -0.5)
    qpos = PAST_LEN + jnp.arange(T)
    kpos = jnp.concatenate([PAST_LEN - wb + jnp.arange(wb), qpos])
    diff = qpos[:, None] - kpos[None, :]
    mask = (diff >= 0) & (diff < WINDOW)
    p = sink_softmax(s, mask, sinks)
    o = jnp.einsum('bkgqs,bskd->bqkgd', p.astype(vv.dtype), vv)
    return o.reshape(B, T, SWA_Q_W), kk[:, -wb:], vv[:, -wb:]


def gated_delta_chunked(q, k, v, g, beta, S0):
    B, T, H, _ = q.shape
    dv = v.shape[-1]
    C = min(GDN_CHUNK, T)
    N = -(-T // C)
    pad = N * C - T

    def prep(x):
        x = jnp.pad(x, [(0, 0), (0, pad)] + [(0, 0)] * (x.ndim - 2))
        x = x.reshape((B, N, C) + x.shape[2:])
        return jnp.moveaxis(x, (1, 3), (0, 2))

    qc, kc, vc, gcs, bc = prep(q), prep(k), prep(v), prep(g), prep(beta)
    gc = jnp.cumsum(gcs, axis=-1)
    tri = jnp.tril(jnp.ones((C, C), bool))
    strict = jnp.tril(jnp.ones((C, C), bool), -1)
    decay = jnp.exp(jnp.where(tri, gc[..., :, None] - gc[..., None, :], -jnp.inf))
    kb = kc * bc[..., None]
    vb = vc * bc[..., None]
    A = jnp.where(strict, jnp.einsum('nbhid,nbhjd->nbhij', kb, kc) * decay, 0.0)
    Tm = A + jnp.eye(C, dtype=A.dtype)
    u = lax.linalg.triangular_solve(Tm, vb, left_side=True, lower=True)
    w = lax.linalg.triangular_solve(Tm, kb * jnp.exp(gc)[..., None], left_side=True, lower=True)
    qk = jnp.einsum('nbhid,nbhjd->nbhij', qc, kc) * decay
    glast = gc[..., -1]
    kdec = kc * jnp.exp(glast[..., None] - gc)[..., None]
    qdec = qc * jnp.exp(gc)[..., None]

    def step(S, xs):
        qd, kd, u_, w_, qk_, gl = xs
        v_new = u_ - jnp.einsum('bhcd,bhde->bhce', w_, S)
        o = jnp.einsum('bhcd,bhde->bhce', qd, S) + jnp.einsum('bhij,bhje->bhie', qk_, v_new)
        S = S * jnp.exp(gl)[..., None, None] + jnp.einsum('bhcd,bhce->bhde', kd, v_new)
        return S, o

    S, o = lax.scan(step, S0, (qdec, kdec, u, w, qk, glast))
    o = jnp.moveaxis(o, (0, 2), (1, 3)).reshape(B, N * C, H, dv)[:, :T]
    return o, S


def layer(x, p, lp, S0, conv_buf, kv_buf, pos0):
    B, T, _ = x.shape
    f32 = jnp.float32
    h = x + 0.5 * swiglu(rmsnorm(x, lp['norm_ffn1']), lp['ffn1_gu'], lp['ffn1_down'])
    n = rmsnorm(h, lp['norm_mix'])
    proj = n @ lp['w_in']
    qkv_pre, z, a, b, q_s, k_s, v_s = jnp.split(proj, np.cumsum(IN_SIZES)[:-1].tolist(), axis=-1)
    qkv, new_conv = causal_conv(qkv_pre, conv_buf, lp['conv_w'])
    qg, kg, vg = jnp.split(qkv.astype(f32), [GDN_QK_W, 2 * GDN_QK_W], axis=-1)
    qg = l2norm(qg.reshape(B, T, GDN_HEADS, GDN_DK)) * (GDN_DK ** -0.5)
    kg = l2norm(kg.reshape(B, T, GDN_HEADS, GDN_DK))
    vg = vg.reshape(B, T, GDN_HEADS, GDN_DV)
    gdec = -jnp.exp(lp['a_log'].astype(f32)) * jax.nn.softplus(a.astype(f32) + lp['dt_bias'].astype(f32))
    beta = jax.nn.sigmoid(b.astype(f32))
    o_g, S_new = gated_delta_chunked(qg, kg, vg, gdec, beta, S0.astype(f32))
    o_g = rmsnorm(o_g, lp['gdn_norm']) * jax.nn.silu(z.reshape(B, T, GDN_HEADS, GDN_DV).astype(f32))
    o_g = o_g.reshape(B, T, GDN_V_W).astype(x.dtype)
    pos = pos0 + jnp.arange(T)
    q_s = rope_partial(q_s.reshape(B, T, SWA_HEADS, SWA_HD), pos)
    k_s = rope_partial(k_s.reshape(B, T, SWA_KV_HEADS, SWA_HD), pos)
    v_s = v_s.reshape(B, T, SWA_KV_HEADS, SWA_HD)
    if kv_buf is None:
        o_s = swa_prompt(q_s, k_s, v_s, lp['sinks'])
        new_k, new_v = k_s[:, -WINDOW:], v_s[:, -WINDOW:]
    else:
        o_s, new_k, new_v = swa_sample(q_s, k_s, v_s, kv_buf[0], kv_buf[1], lp['sinks'])
    h = h + jnp.concatenate([o_g, o_s], axis=-1) @ lp['w_out']
    h = h + 0.5 * swiglu(rmsnorm(h, lp['norm_ffn2']), lp['ffn2_gu'], lp['ffn2_down'])
    h = h + jax.nn.sigmoid(rmsnorm(h, lp['norm_ple']) @ lp['ple_gate']) * (p @ lp['ple_proj'])
    return h, S_new.astype(S0.dtype), new_conv, new_k, new_v


def setup_inputs(seed: int = 0) -> dict:
    key = jax.random.key(seed)
    ks = jax.random.split(key, 32)
    f32 = jnp.float32

    def nrm(k, shape, scale):
        return jax.random.normal(k, shape, f32) * scale

    def gain(k, dim):
        return 1.0 + 0.02 * jax.random.normal(k, (DEPTH, dim), f32)

    wb = min(WINDOW, PAST_LEN)
    return {
        'x_prompt': nrm(ks[0], (BATCH, SEQ, D_MODEL), 1.0),
        'x_sample': nrm(ks[1], (DEC_BATCH, DEC_SEQ, D_MODEL), 1.0),
        'state_gdn': nrm(ks[2], (DEPTH, DEC_BATCH, GDN_HEADS, GDN_DK, GDN_DV), GDN_DK ** -0.5),
        'state_conv': nrm(ks[3], (DEPTH, DEC_BATCH, GDN_CONV - 1, GDN_CONV_W), 1.0),
        'cache_swa_k': nrm(ks[4], (DEPTH, DEC_BATCH, wb, SWA_KV_HEADS, SWA_HD), 1.0),
        'cache_swa_v': nrm(ks[5], (DEPTH, DEC_BATCH, wb, SWA_KV_HEADS, SWA_HD), 1.0),
        'p_prompt': nrm(ks[6], (DEPTH, BATCH, SEQ, PLE_DIM), 1.0),
        'p_sample': nrm(ks[7], (DEPTH, DEC_BATCH, DEC_SEQ, PLE_DIM), 1.0),
        'norm_ffn1': gain(ks[8], D_MODEL),
        'ffn1_gu': nrm(ks[9], (DEPTH, D_MODEL, 2 * D_FF), D_MODEL ** -0.5),
        'ffn1_down': nrm(ks[10], (DEPTH, D_FF, D_MODEL), D_FF ** -0.5),
        'norm_mix': gain(ks[11], D_MODEL),
        'w_in': nrm(ks[12], (DEPTH, D_MODEL, IN_W), D_MODEL ** -0.5),
        'conv_w': nrm(ks[13], (DEPTH, GDN_CONV, GDN_CONV_W), GDN_CONV ** -0.5),
        'a_log': jnp.log(jax.random.uniform(ks[14], (DEPTH, GDN_HEADS), f32, 1.0, 16.0)),
        'dt_bias': nrm(ks[15], (DEPTH, GDN_HEADS), 0.1),
        'gdn_norm': gain(ks[16], GDN_DV),
        'sinks': nrm(ks[17], (DEPTH, SWA_HEADS), 1.0),
        'w_out': nrm(ks[18], (DEPTH, MIX_W, D_MODEL), MIX_W ** -0.5),
        'norm_ffn2': gain(ks[19], D_MODEL),
        'ffn2_gu': nrm(ks[20], (DEPTH, D_MODEL, 2 * D_FF), D_MODEL ** -0.5),
        'ffn2_down': nrm(ks[21], (DEPTH, D_FF, D_MODEL), D_FF ** -0.5),
        'norm_ple': gain(ks[22], D_MODEL),
        'ple_proj': nrm(ks[23], (DEPTH, PLE_DIM, D_MODEL), PLE_DIM ** -0.5),
        'ple_gate': nrm(ks[24], (DEPTH, D_MODEL, D_MODEL), D_MODEL ** -0.5),
        'norm_final': 1.0 + 0.02 * jax.random.normal(ks[25], (D_MODEL,), f32),
    }


def reference(x_prompt, x_sample, state_gdn, state_conv, cache_swa_k, cache_swa_v, p_prompt, p_sample,
              norm_ffn1, ffn1_gu, ffn1_down, norm_mix, w_in, conv_w, a_log, dt_bias, gdn_norm, sinks,
              w_out, norm_ffn2, ffn2_gu, ffn2_down, norm_ple, ple_proj, ple_gate, norm_final):
    hp, hs = x_prompt, x_sample
    sg_p, sc_p, kk_p, vv_p = [], [], [], []
    sg_s, sc_s, kk_s, vv_s = [], [], [], []
    for i in range(DEPTH):
        lp = {'norm_ffn1': norm_ffn1[i], 'ffn1_gu': ffn1_gu[i], 'ffn1_down': ffn1_down[i],
              'norm_mix': norm_mix[i], 'w_in': w_in[i], 'conv_w': conv_w[i], 'a_log': a_log[i],
              'dt_bias': dt_bias[i], 'gdn_norm': gdn_norm[i], 'sinks': sinks[i], 'w_out': w_out[i],
              'norm_ffn2': norm_ffn2[i], 'ffn2_gu': ffn2_gu[i], 'ffn2_down': ffn2_down[i],
              'norm_ple': norm_ple[i], 'ple_proj': ple_proj[i], 'ple_gate': ple_gate[i]}
        B = hp.shape[0]
        S0 = jnp.zeros((B, GDN_HEADS, GDN_DK, GDN_DV), state_gdn.dtype)
        cb0 = jnp.zeros((B, GDN_CONV - 1, GDN_CONV_W), hp.dtype)
        hp, s1, c1, k1, v1 = layer(hp, p_prompt[i], lp, S0, cb0, None, 0)
        sg_p.append(s1); sc_p.append(c1); kk_p.append(k1); vv_p.append(v1)
        hs, s2, c2, k2, v2 = layer(hs, p_sample[i], lp, state_gdn[i], state_conv[i],
                                   (cache_swa_k[i], cache_swa_v[i]), PAST_LEN)
        sg_s.append(s2); sc_s.append(c2); kk_s.append(k2); vv_s.append(v2)
    y_prompt = rmsnorm(hp, norm_final)
    y_sample = rmsnorm(hs, norm_final)
    return (y_prompt, y_sample,
            jnp.stack(sg_p), jnp.stack(sc_p), jnp.stack(kk_p), jnp.stack(vv_p),
            jnp.stack(sg_s), jnp.stack(sc_s), jnp.stack(kk_s), jnp.stack(vv_s))
```

```cpp
#include <hip/hip_runtime.h>
#include <hip/hip_cooperative_groups.h>
#include <cstdio>
#include <cstdint>
namespace cg = cooperative_groups;
namespace pg8 {
#define PG8_LAS __attribute__((address_space(3)))
typedef unsigned short bf16_t;
typedef short bf16x8 __attribute__((ext_vector_type(8)));
typedef float f32x4 __attribute__((ext_vector_type(4)));
typedef unsigned u32x4 __attribute__((ext_vector_type(4)));
constexpr int BM = 256, BK = 64, HALF = 128, HTB = HALF * BK * 2  , STAGE_BYTES = 8 * HTB, NXCD = 8, WGM = 8;

__host__ __device__ __forceinline__ int lds_byte(int r, int c) { const int st = (r >> 4) * 2 + (c >> 5), rr = r & 15, cc = c & 31, ob = rr * 64 + cc * 2; return st * 1024 + (ob ^ (((ob >> 9) & 1) << 5)); }
__host__ __device__ __forceinline__ void stage_rc(int b, int& R, int& C) { const int st = b / 1024, sb = b % 1024, swz = sb ^ (((sb >> 9) & 1) << 5); R = (st >> 1) * 16 + swz / 64; C = (st & 1) * 32 + (swz % 64) / 2; }
__host__ __device__ __forceinline__ int perm32(int rho) { const int n = rho >> 4, i = rho & 15; return 8 * (i >> 2) + 4 * n + (i & 3); }

struct Unit { int pm, pn; };
struct Gemm { const bf16_t* A; const bf16_t* Bt; int M, N, K; };

struct StaticOrder {
    int nM, nN, nwg, G, c;
    __host__ __device__ void init(int M, int N, int G_, int c_) { nM = M / BM; nN = N / BM; nwg = nM * nN; G = G_; c = c_; }
    __host__ __device__ bool next(int i, Unit& u) const {
        const long L = (long)i * G + c; if (L >= nwg) return false;
        int wgid = (int)L; { const int q = nwg / NXCD, r = nwg % NXCD, xcd = wgid % NXCD, off = wgid / NXCD; wgid = (xcd < r ? xcd * (q + 1) : r * (q + 1) + (xcd - r) * q) + off; }
        const int nig = WGM * nN, gid = wgid / nig, fm = gid * WGM, gsz = (nM - fm) < WGM ? (nM - fm) : WGM;
        u.pm = fm + ((wgid % nig) % gsz); u.pn = (wgid % nig) / gsz; return true;
    }
    __device__ __forceinline__ void a_ready(const Unit&) const {}
    __device__ __forceinline__ void done(const Unit&) const {}
};

__device__ __forceinline__ unsigned cvt_pk_bf16(float lo, float hi) { unsigned r; asm volatile("v_cvt_pk_bf16_f32 %0, %1, %2" : "=v"(r) : "v"(lo), "v"(hi)); return r; }
typedef float f32x2 __attribute__((ext_vector_type(2)));
template <class Epi, class Sched, bool ALIGN_EPI = false, bool SP2 = false>
__device__ __forceinline__ void gemm_phase(PG8_LAS unsigned char* lds, const Gemm g, const Sched& S, const Epi& E) {
    const int tid = threadIdx.x, wid = __builtin_amdgcn_readfirstlane(tid >> 6), lane = tid & 63, wr = wid >> 2, wc = wid & 3, fr = lane & 15, fq = lane >> 4;
    const int K = g.K, nt = K / BK;
    unsigned voffA[2], voffB[2];
#pragma unroll
    for (int i = 0; i < 2; ++i) { int R, C; stage_rc(tid * 16 + i * 8192, R, C); const int Rb = Epi::PERM ? ((R & ~31) + perm32(R & 31)) : R;
        voffA[i] = (unsigned)(R * K + C) * 2u; voffB[i] = (unsigned)(Rb * K + C) * 2u; }
    const size_t kstep = (size_t)(BK * 2);
    const size_t hstep = (size_t)HALF * K * 2;
    const size_t tstep = 2 * hstep;
    const unsigned ldsw = (unsigned)wid * 1024u;
    const int aoff = lds_byte(wr * 64 + fr, fq * 8), boff = lds_byte(wc * 32 + fr, fq * 8);
#define PG8_SA(b, h) (((b) * 2 + (h)) * HTB)
#define PG8_SB(b, h) ((4 + (b) * 2 + (h)) * HTB)
#define PG8_STAGE(bufoff, gbase, voff) do { _Pragma("unroll") for (int _i = 0; _i < 2; ++_i) \
        __builtin_amdgcn_global_load_lds((const unsigned*)((const char*)(gbase) + (voff)[_i]), (PG8_LAS unsigned*)(lds + (bufoff) + ldsw + _i * 8192), 16, 0, 0); } while (0)
#define PG8_LDA(dst, b, h) do { _Pragma("unroll") for (int m = 0; m < 4; ++m) _Pragma("unroll") for (int k = 0; k < 2; ++k) dst[m][k] = *(const PG8_LAS bf16x8*)(lds + PG8_SA(b, h) + aoff + m * 2048 + k * 1024); } while (0)
#define PG8_LDB(dst, b, h) do { _Pragma("unroll") for (int n = 0; n < 2; ++n) _Pragma("unroll") for (int k = 0; k < 2; ++k) dst[n][k] = *(const PG8_LAS bf16x8*)(lds + PG8_SB(b, h) + boff + n * 2048 + k * 1024); } while (0)
#define PG8_MMA(ai, bj, At, Bt) do { __builtin_amdgcn_s_setprio(1); _Pragma("unroll") for (int m = 0; m < 4; ++m) _Pragma("unroll") for (int n = 0; n < 2; ++n) _Pragma("unroll") for (int k = 0; k < 2; ++k) \
        acc[ai][bj][m][n] = __builtin_amdgcn_mfma_f32_16x16x32_bf16(Bt[n][k], At[m][k], acc[ai][bj][m][n], 0, 0, 0); __builtin_amdgcn_s_setprio(0); } while (0)
#define PG8_WAIT_V(n) asm volatile("s_waitcnt vmcnt(" #n ")" ::: "memory")
#define PG8_WAIT_L(n) asm volatile("s_waitcnt lgkmcnt(" #n ")" ::: "memory")
#define PG8_BAR __builtin_amdgcn_s_barrier()
#define PG8_SCHED __builtin_amdgcn_sched_barrier(0)
    Unit cur, nxt; int ui = 0;
    if (!S.next(0, cur)) return;
    f32x4 acc[2][2][4][2];
#pragma unroll
    for (int a = 0; a < 2; ++a)
#pragma unroll
        for (int b = 0; b < 2; ++b)
#pragma unroll
            for (int m = 0; m < 4; ++m)
#pragma unroll
                for (int n = 0; n < 2; ++n) acc[a][b][m][n] = (f32x4){0.f, 0.f, 0.f, 0.f};
    bf16x8 At[4][2], B0[2][2], B1[2][2];
    const char* cA = (const char*)g.A + (size_t)cur.pm * tstep; const char* cB = (const char*)g.Bt + (size_t)cur.pn * tstep;
    S.a_ready(cur);
    if constexpr (SP2) {
        PG8_STAGE(PG8_SB(0, 0), cB, voffB); PG8_STAGE(PG8_SB(0, 1), cB + hstep, voffB); PG8_STAGE(PG8_SA(0, 0), cA, voffA); PG8_STAGE(PG8_SA(0, 1), cA + hstep, voffA);
        if (wr == 1) PG8_BAR;
        PG8_WAIT_V(2); PG8_BAR;
        PG8_STAGE(PG8_SB(1, 0), cB + kstep, voffB); PG8_STAGE(PG8_SA(1, 0), cA + kstep, voffA); PG8_STAGE(PG8_SB(1, 1), cB + hstep + kstep, voffB);
        PG8_WAIT_V(6); PG8_BAR;
    } else {
        PG8_STAGE(PG8_SB(0, 0), cB, voffB); PG8_STAGE(PG8_SA(0, 0), cA, voffA); PG8_STAGE(PG8_SB(0, 1), cB + hstep, voffB); PG8_STAGE(PG8_SA(0, 1), cA + hstep, voffA);
        if (wr == 1) PG8_BAR;
        PG8_WAIT_V(4); PG8_BAR;
        PG8_STAGE(PG8_SB(1, 0), cB + kstep, voffB); PG8_STAGE(PG8_SA(1, 0), cA + kstep, voffA); PG8_STAGE(PG8_SB(1, 1), cB + hstep + kstep, voffB);
        PG8_WAIT_V(6); PG8_BAR;
    }
    for (;;) {
        const bool has_next = S.next(ui + 1, nxt);
        const char* nA = has_next ? (const char*)g.A + (size_t)nxt.pm * tstep : cA; const char* nB = has_next ? (const char*)g.Bt + (size_t)nxt.pn * tstep : cB;
        for (int t = 0; t < nt; t += 2) {
            const bool last = (t == nt - 2);
            const char* a1 = cA + (size_t)(t + 1) * kstep;
            const char* a2 = last ? nA : cA + (size_t)(t + 2) * kstep; const char* b2 = last ? nB : cB + (size_t)(t + 2) * kstep;
            const char* a3 = a2 + kstep; const char* b3 = b2 + kstep;
            if (last && has_next) S.a_ready(nxt);
            if constexpr (SP2) {
            PG8_LDB(B0, 0, 0); PG8_LDB(B1, 0, 1); PG8_SCHED; PG8_LDA(At, 0, 0); PG8_STAGE(PG8_SA(1, 1), a1 + hstep, voffA);
            PG8_WAIT_V(8); PG8_WAIT_L(0); PG8_BAR; PG8_MMA(0, 0, At, B0); PG8_MMA(0, 1, At, B1); PG8_BAR; PG8_SCHED;
            PG8_LDA(At, 0, 1); PG8_STAGE(PG8_SB(0, 0), b2, voffB); PG8_STAGE(PG8_SB(0, 1), b2 + hstep, voffB); PG8_STAGE(PG8_SA(0, 0), a2, voffA);
            PG8_WAIT_V(8); PG8_WAIT_L(0); PG8_BAR; PG8_MMA(1, 0, At, B0); PG8_MMA(1, 1, At, B1); PG8_BAR; PG8_SCHED;
            PG8_LDB(B0, 1, 0); PG8_LDB(B1, 1, 1); PG8_SCHED; PG8_LDA(At, 1, 0); PG8_STAGE(PG8_SA(0, 1), a2 + hstep, voffA);
            PG8_WAIT_V(8); PG8_WAIT_L(0); PG8_BAR; PG8_MMA(0, 0, At, B0); PG8_MMA(0, 1, At, B1); PG8_BAR; PG8_SCHED;
            PG8_LDA(At, 1, 1); PG8_STAGE(PG8_SB(1, 0), b3, voffB); PG8_STAGE(PG8_SB(1, 1), b3 + hstep, voffB); PG8_STAGE(PG8_SA(1, 0), a3, voffA);
            PG8_WAIT_V(8); PG8_WAIT_L(0); PG8_BAR; PG8_MMA(1, 0, At, B0); PG8_MMA(1, 1, At, B1); PG8_BAR; PG8_SCHED;
            } else {
            PG8_LDB(B0, 0, 0); PG8_SCHED; PG8_LDA(At, 0, 0); PG8_STAGE(PG8_SA(1, 1), a1 + hstep, voffA);
            PG8_WAIT_L(8); PG8_BAR; PG8_WAIT_L(0); PG8_MMA(0, 0, At, B0); PG8_BAR; PG8_SCHED;
            PG8_LDB(B1, 0, 1); PG8_STAGE(PG8_SB(0, 0), b2, voffB);
            PG8_BAR; PG8_WAIT_L(0); PG8_MMA(0, 1, At, B1); PG8_BAR;
            PG8_LDA(At, 0, 1); PG8_STAGE(PG8_SA(0, 0), a2, voffA);
            PG8_BAR; PG8_WAIT_L(0); PG8_MMA(1, 0, At, B0); PG8_BAR; PG8_SCHED;
            PG8_STAGE(PG8_SB(0, 1), b2 + hstep, voffB);
            PG8_WAIT_V(6); PG8_BAR; PG8_MMA(1, 1, At, B1); PG8_BAR;
            PG8_LDB(B0, 1, 0); PG8_SCHED; PG8_LDA(At, 1, 0); PG8_STAGE(PG8_SA(0, 1), a2 + hstep, voffA);
            PG8_WAIT_L(8); PG8_BAR; PG8_WAIT_L(0); PG8_MMA(0, 0, At, B0); PG8_BAR; PG8_SCHED;
            PG8_LDB(B1, 1, 1); PG8_STAGE(PG8_SB(1, 0), b3, voffB);
            PG8_BAR; PG8_WAIT_L(0); PG8_MMA(0, 1, At, B1); PG8_BAR;
            PG8_LDA(At, 1, 1); PG8_STAGE(PG8_SA(1, 0), a3, voffA);
            PG8_BAR; PG8_WAIT_L(0); PG8_MMA(1, 0, At, B0); PG8_BAR; PG8_SCHED;
            PG8_STAGE(PG8_SB(1, 1), b3 + hstep, voffB);
            PG8_WAIT_V(6); PG8_BAR; PG8_MMA(1, 1, At, B1); PG8_BAR;
            }
        }
        if constexpr (ALIGN_EPI) { if (wr == 0) PG8_BAR; }
        if constexpr (!Epi::AFTER_DRAIN) { E(acc, cur, wr, wc, fr, fq); S.done(cur); }
        if (!has_next) break;
#pragma unroll
        for (int a = 0; a < 2; ++a)
#pragma unroll
            for (int b = 0; b < 2; ++b)
#pragma unroll
                for (int m = 0; m < 4; ++m)
#pragma unroll
                    for (int n = 0; n < 2; ++n) acc[a][b][m][n] = (f32x4){0.f, 0.f, 0.f, 0.f};
        cur = nxt; cA = nA; cB = nB; ++ui;
        if constexpr (ALIGN_EPI) { if (wr == 1) PG8_BAR; }
    }
    PG8_WAIT_V(0);
    if constexpr (!ALIGN_EPI) { if (wr == 0) PG8_BAR; }
    PG8_BAR;
    if constexpr (Epi::AFTER_DRAIN) { E.fused(acc, cur, wr, wc, fr, fq, lds, wid, lane); S.done(cur); }
#undef PG8_SA
#undef PG8_SB
#undef PG8_STAGE
#undef PG8_LDA
#undef PG8_LDB
#undef PG8_MMA
#undef PG8_WAIT_V
#undef PG8_WAIT_L
#undef PG8_BAR
#undef PG8_SCHED
}
}

#define LAS __attribute__((address_space(3)))
typedef unsigned short bf16_t;
typedef float f32x4 __attribute__((ext_vector_type(4)));
typedef unsigned u32x4 __attribute__((ext_vector_type(4)));
typedef unsigned u32x2 __attribute__((ext_vector_type(2)));
using pg8::cvt_pk_bf16;

constexpr int DM = 1024, TP = 2048, NBP = 16, NBS = 128, TS = 8;
constexpr int MP = NBP * TP, MS = NBS * TS, M = MP + MS;
constexpr int DFF = 2816, NGU = 2 * DFF, NINP = 3072, NIN = 2824, PLE = 256;
constexpr float EPS = 1e-6f;
constexpr int PAST = 16384;

constexpr size_t O_Y = 0;
constexpr size_t O_SGP = (size_t)M * DM;
constexpr size_t O_SCP = O_SGP + (size_t)NBP * 4 * 128 * 128;
constexpr size_t O_CKP = O_SCP + (size_t)NBP * 3 * 1536;
constexpr size_t O_CVP = O_CKP + (size_t)NBP * 128 * 128;
constexpr size_t O_SGS = O_CVP + (size_t)NBP * 128 * 128;
constexpr size_t O_SCS = O_SGS + (size_t)NBS * 4 * 128 * 128;
constexpr size_t O_CKS = O_SCS + (size_t)NBS * 3 * 1536;
constexpr size_t O_CVS = O_CKS + (size_t)NBS * 128 * 128;
constexpr size_t O_END = O_CVS + (size_t)NBS * 128 * 128;

constexpr size_t MiB = 1u << 20;
constexpr size_t WS_GU1 = 0, WS_D1 = 11 * MiB, WS_IN = 17 * MiB, WS_OUT = 23 * MiB, WS_GU2 = 25 * MiB, WS_D2 = 36 * MiB, WS_PG = 42 * MiB, WS_PPW = 44 * MiB;
constexpr size_t WS_HB = 48 * MiB;
constexpr size_t WS_QS = 48 * MiB, WS_KS = 81 * MiB, WS_VS = 90 * MiB;
constexpr size_t WS_ACT = 114 * MiB;
constexpr size_t WS_PROJ = 114 * MiB;
constexpr size_t WS_GQ = 312 * MiB, WS_GK = 345 * MiB, WS_GV = 378 * MiB;
constexpr size_t WS_PP = 312 * MiB;
constexpr size_t WS_MIX = 411 * MiB;
constexpr size_t WS_PB = 477 * MiB;
constexpr size_t WS_SS = 494 * MiB;
constexpr size_t WS_AB = 495 * MiB;
constexpr size_t WS_GD = 497 * MiB;
constexpr size_t WS_BT = 498 * MiB;
constexpr size_t WS_ROPE = 499 * MiB;
constexpr size_t WS_END = 500 * MiB;

constexpr int LDS_BYTES = 131072 + 2048;

struct Args { const float* in[26]; float* out; unsigned char* ws; int ph_lo, ph_hi; };
typedef __attribute__((address_space(4))) const Args CArgs;
__device__ __forceinline__ CArgs* get_args() {
    unsigned long long p = (unsigned long long)__builtin_amdgcn_kernarg_segment_ptr();
    unsigned l = (unsigned)p, h = (unsigned)(p >> 32);
    asm volatile("" : "+s"(l), "+s"(h));
    l = __builtin_amdgcn_readfirstlane(l); h = __builtin_amdgcn_readfirstlane(h);
    return (CArgs*)(((unsigned long long)h << 32) | l);
}


__device__ __forceinline__ float bf2f(unsigned b) { return __uint_as_float(b << 16); }
__device__ __forceinline__ float wave_sum(float v) {
#pragma unroll
    for (int o = 1; o < 64; o <<= 1) v += __shfl_xor(v, o);
    return v;
}
__device__ __forceinline__ float wave_max(float v) {
#pragma unroll
    for (int o = 1; o < 64; o <<= 1) v = fmaxf(v, __shfl_xor(v, o));
    return v;
}
template <int CTRL> __device__ __forceinline__ float dppf(float v) { return __int_as_float(__builtin_amdgcn_update_dpp(0, __float_as_int(v), CTRL, 0xf, 0xf, true)); }
__device__ __forceinline__ float reduce16(float v) {
    v += dppf<0xB1>(v); v += dppf<0x4E>(v); v += dppf<0x141>(v); v += dppf<0x140>(v); return v;
}
__device__ __forceinline__ void unpack8(const u32x4 r, float* x) {
    x[0] = bf2f(r.x & 0xffffu); x[1] = bf2f(r.x >> 16); x[2] = bf2f(r.y & 0xffffu); x[3] = bf2f(r.y >> 16);
    x[4] = bf2f(r.z & 0xffffu); x[5] = bf2f(r.z >> 16); x[6] = bf2f(r.w & 0xffffu); x[7] = bf2f(r.w >> 16);
}
__device__ __forceinline__ u32x4 pack8(const float* x) {
    u32x4 w; w.x = cvt_pk_bf16(x[0], x[1]); w.y = cvt_pk_bf16(x[2], x[3]); w.z = cvt_pk_bf16(x[4], x[5]); w.w = cvt_pk_bf16(x[6], x[7]); return w;
}
__device__ __forceinline__ float sigmoidf_(float x) { return 1.f / (1.f + __expf(-x)); }
#define LDS_WAIT() asm volatile("s_waitcnt lgkmcnt(0)" ::: "memory")

struct EpiSwiglu {
    static constexpr bool PERM = true, AFTER_DRAIN = false;
    bf16_t* O; const float* ss;
    __device__ __forceinline__ void operator()(const f32x4 (&acc)[2][2][4][2], const pg8::Unit& u, int wr, int wc, int fr, int fq) const {
        const int col0 = u.pn * 128 + wc * 32 + 8 * fq;
#pragma unroll
        for (int ai = 0; ai < 2; ++ai)
#pragma unroll
            for (int m = 0; m < 4; ++m) {
                const int row = u.pm * 256 + ai * 128 + wr * 64 + m * 16 + fr;
                const float rs = rsqrtf(ss[row] * (1.f / DM) + EPS);
                float a[8];
#pragma unroll
                for (int n = 0; n < 2; ++n)
#pragma unroll
                    for (int j = 0; j < 4; ++j) { const float g = acc[ai][0][m][n][j] * rs, up = acc[ai][1][m][n][j] * rs; a[4 * n + j] = g * sigmoidf_(g) * up; }
                *(u32x4*)(O + (size_t)row * DFF + col0) = pack8(a);
            }
    }
};
struct EpiProj {
    static constexpr bool PERM = true, AFTER_DRAIN = false;
    bf16_t* O; const float* ss; float* AB;
    __device__ __forceinline__ void operator()(const f32x4 (&acc)[2][2][4][2], const pg8::Unit& u, int wr, int wc, int fr, int fq) const {
#pragma unroll
        for (int ai = 0; ai < 2; ++ai)
#pragma unroll
            for (int m = 0; m < 4; ++m) {
                const int row = u.pm * 256 + ai * 128 + wr * 64 + m * 16 + fr;
                const float rs = rsqrtf(ss[row] * (1.f / DM) + EPS);
#pragma unroll
                for (int bj = 0; bj < 2; ++bj) {
                    float a[8];
#pragma unroll
                    for (int n = 0; n < 2; ++n)
#pragma unroll
                        for (int j = 0; j < 4; ++j) a[4 * n + j] = acc[ai][bj][m][n][j] * rs;
                    *(u32x4*)(O + (size_t)row * NINP + u.pn * 256 + bj * 128 + wc * 32 + 8 * fq) = pack8(a);
                    if (bj == 0 && u.pn == 11 && wc == 0 && fq == 0) {
                        *(f32x4*)(AB + (size_t)row * 8) = (f32x4){a[0], a[1], a[2], a[3]};
                        *(f32x4*)(AB + (size_t)row * 8 + 4) = (f32x4){a[4], a[5], a[6], a[7]};
                    }
                }
            }
    }
};
struct EpiPlain {
    static constexpr bool PERM = true, AFTER_DRAIN = false;
    bf16_t* O;
    __device__ __forceinline__ void operator()(const f32x4 (&acc)[2][2][4][2], const pg8::Unit& u, int wr, int wc, int fr, int fq) const {
#pragma unroll
        for (int ai = 0; ai < 2; ++ai)
#pragma unroll
            for (int m = 0; m < 4; ++m) {
                const int row = u.pm * 256 + ai * 128 + wr * 64 + m * 16 + fr;
#pragma unroll
                for (int bj = 0; bj < 2; ++bj) {
                    float a[8];
#pragma unroll
                    for (int n = 0; n < 2; ++n)
#pragma unroll
                        for (int j = 0; j < 4; ++j) a[4 * n + j] = acc[ai][bj][m][n][j];
                    *(u32x4*)(O + (size_t)row * DM + u.pn * 256 + bj * 128 + wc * 32 + 8 * fq) = pack8(a);
                }
            }
    }
};
struct EpiResid {
    static constexpr bool PERM = false, AFTER_DRAIN = false;
    const float* base0; const float* base1; float* out; bf16_t* outb; float* ss; float alpha;
    __device__ __forceinline__ void operator()(const f32x4 (&acc)[2][2][4][2], const pg8::Unit& u, int wr, int wc, int fr, int fq) const {
#pragma unroll
        for (int ai = 0; ai < 2; ++ai)
#pragma unroll
            for (int m = 0; m < 4; ++m) {
                const int row = u.pm * 256 + ai * 128 + wr * 64 + m * 16 + fr;
                const float* bp = row < MP ? base0 + (size_t)row * DM : base1 + (size_t)(row - MP) * DM;
                float sq = 0.f;
#pragma unroll
                for (int bj = 0; bj < 2; ++bj)
#pragma unroll
                    for (int n = 0; n < 2; ++n) {
                        const int c = u.pn * 256 + bj * 128 + wc * 32 + n * 16 + 4 * fq;
                        const f32x4 bv = *(const f32x4*)(bp + c);
                        const f32x4 v = bv + acc[ai][bj][m][n] * alpha;
                        *(f32x4*)(out + (size_t)row * DM + c) = v;
                        u32x2 w; w.x = cvt_pk_bf16(v[0], v[1]); w.y = cvt_pk_bf16(v[2], v[3]);
                        *(u32x2*)(outb + (size_t)row * DM + c) = w;
                        sq += (v[0] * v[0] + v[1] * v[1]) + (v[2] * v[2] + v[3] * v[3]);
                    }
                sq += __shfl_xor(sq, 16); sq += __shfl_xor(sq, 32);
                if (fq == 0) unsafeAtomicAdd(ss + row, sq);
                asm volatile("" ::: "memory");
            }
    }
};
struct EpiGate {
    static constexpr bool PERM = false, AFTER_DRAIN = false;
    float* h; const bf16_t* pp; const float* ss; float* ss2;
    __device__ __forceinline__ void operator()(const f32x4 (&acc)[2][2][4][2], const pg8::Unit& u, int wr, int wc, int fr, int fq) const {
#pragma unroll
        for (int ai = 0; ai < 2; ++ai)
#pragma unroll
            for (int m = 0; m < 4; ++m) {
                const int row = u.pm * 256 + ai * 128 + wr * 64 + m * 16 + fr;
                const float rs = rsqrtf(ss[row] * (1.f / DM) + EPS);
                float sq = 0.f;
#pragma unroll
                for (int bj = 0; bj < 2; ++bj)
#pragma unroll
                    for (int n = 0; n < 2; ++n) {
                        const int c = u.pn * 256 + bj * 128 + wc * 32 + n * 16 + 4 * fq;
                        const f32x4 hv = *(const f32x4*)(h + (size_t)row * DM + c);
                        const u32x2 pw = *(const u32x2*)(pp + (size_t)row * DM + c);
                        f32x4 v;
                        v[0] = hv[0] + sigmoidf_(acc[ai][bj][m][n][0] * rs) * bf2f(pw.x & 0xffffu);
                        v[1] = hv[1] + sigmoidf_(acc[ai][bj][m][n][1] * rs) * bf2f(pw.x >> 16);
                        v[2] = hv[2] + sigmoidf_(acc[ai][bj][m][n][2] * rs) * bf2f(pw.y & 0xffffu);
                        v[3] = hv[3] + sigmoidf_(acc[ai][bj][m][n][3] * rs) * bf2f(pw.y >> 16);
                        *(f32x4*)(h + (size_t)row * DM + c) = v;
                        sq += (v[0] * v[0] + v[1] * v[1]) + (v[2] * v[2] + v[3] * v[3]);
                    }
                sq += __shfl_xor(sq, 16); sq += __shfl_xor(sq, 32);
                if (fq == 0) unsafeAtomicAdd(ss2 + row, sq);
                asm volatile("" ::: "memory");
            }
    }
};

__device__ __forceinline__ int map_row(int mode, int n) {
    if (mode == 1) { if (n < DFF) return 256 * (n >> 7) + (n & 127); n -= DFF; return 256 * (n >> 7) + 128 + (n & 127); }
    if (mode == 2) { if (n < 2048) return n; if (n < 2052) return 2816 + (n - 2048); if (n < 2056) return 2820 + (n - 2052); return n - 8; }
    return n;
}
__device__ __forceinline__ void p0_transpose_item(const float* W, int K, int N, const float* gain, bf16_t* WT, int mode, LAS float* scr, int item, int lane) {
    const int nblk = (N + 31) / 32, kb = item / nblk, nb = item % nblk, k0 = 64 * kb, n0 = 32 * nb;
#pragma unroll 8
    for (int i = 0; i < 32; ++i) {
        const int kk = 2 * i + (lane >> 5), n = n0 + (lane & 31);
        float v = 0.f;
        if (n < N) { v = W[(size_t)(k0 + kk) * N + n]; if (gain) v *= gain[k0 + kk]; }
        scr[kk * 33 + (lane & 31)] = v;
    }
    LDS_WAIT();
    const int c = lane & 7;
#pragma unroll
    for (int j = 0; j < 4; ++j) {
        const int n = (lane >> 3) + 8 * j;
        if (n0 + n < N) {
            const LAS float* s = scr + (8 * c) * 33 + n;
            u32x4 o; o.x = cvt_pk_bf16(s[0 * 33], s[1 * 33]); o.y = cvt_pk_bf16(s[2 * 33], s[3 * 33]); o.z = cvt_pk_bf16(s[4 * 33], s[5 * 33]); o.w = cvt_pk_bf16(s[6 * 33], s[7 * 33]);
            *(u32x4*)(WT + (size_t)map_row(mode, n0 + n) * K + k0 + 8 * c) = o;
        }
    }
    LDS_WAIT();
}

__device__ __forceinline__ void p0_prologue(CArgs* a, LAS unsigned char* L) {
    const int tid = threadIdx.x, lane = tid & 63, wave = tid >> 6;
    unsigned char* ws = a->ws;
    LAS float* scr = (LAS float*)(L + wave * 16384);
    const int gw = blockIdx.x * 8 + wave, NGW = gridDim.x * 8;
    constexpr int I_GU = 16 * 176, I_D = 44 * 32, I_IN = 16 * 89, I_SQ = 16 * 32, I_PP = 4 * 32;
    constexpr int NITEMS = 2 * I_GU + 2 * I_D + I_IN + 2 * I_SQ + I_PP;
    for (int it = gw; it < NITEMS; it += NGW) {
        int r = it;
        if (r < I_GU) { p0_transpose_item(a->in[9], DM, NGU, a->in[8], (bf16_t*)(ws + WS_GU1), 1, scr, r, lane); continue; } r -= I_GU;
        if (r < I_GU) { p0_transpose_item(a->in[20], DM, NGU, a->in[19], (bf16_t*)(ws + WS_GU2), 1, scr, r, lane); continue; } r -= I_GU;
        if (r < I_D) { p0_transpose_item(a->in[10], DFF, DM, nullptr, (bf16_t*)(ws + WS_D1), 0, scr, r, lane); continue; } r -= I_D;
        if (r < I_D) { p0_transpose_item(a->in[21], DFF, DM, nullptr, (bf16_t*)(ws + WS_D2), 0, scr, r, lane); continue; } r -= I_D;
        if (r < I_IN) { p0_transpose_item(a->in[12], DM, NIN, a->in[11], (bf16_t*)(ws + WS_IN), 2, scr, r, lane); continue; } r -= I_IN;
        if (r < I_SQ) { p0_transpose_item(a->in[18], DM, DM, nullptr, (bf16_t*)(ws + WS_OUT), 0, scr, r, lane); continue; } r -= I_SQ;
        if (r < I_SQ) { p0_transpose_item(a->in[24], DM, DM, a->in[22], (bf16_t*)(ws + WS_PG), 0, scr, r, lane); continue; } r -= I_SQ;
        p0_transpose_item(a->in[23], PLE, DM, nullptr, (bf16_t*)(ws + WS_PPW), 0, scr, r, lane);
    }
    {
        u32x4* z = (u32x4*)(ws + WS_IN + (size_t)NIN * DM * 2);
        const int nz = (NINP - NIN) * DM * 2 / 16;
        for (int i = blockIdx.x * 512 + tid; i < nz; i += gridDim.x * 512) z[i] = (u32x4){0u, 0u, 0u, 0u};
    }
    bf16_t* HB = (bf16_t*)(ws + WS_HB); bf16_t* PB = (bf16_t*)(ws + WS_PB); float* SS = (float*)(ws + WS_SS);
    for (int m = gw; m < M; m += NGW) {
        const float* xr = m < MP ? a->in[0] + (size_t)m * DM : a->in[1] + (size_t)(m - MP) * DM;
        float s = 0.f;
#pragma unroll
        for (int j = 0; j < 4; ++j) {
            const f32x4 v = ((const f32x4*)xr)[lane + 64 * j];
            s += (v[0] * v[0] + v[1] * v[1]) + (v[2] * v[2] + v[3] * v[3]);
            u32x2 w; w.x = cvt_pk_bf16(v[0], v[1]); w.y = cvt_pk_bf16(v[2], v[3]);
            ((u32x2*)(HB + (size_t)m * DM))[lane + 64 * j] = w;
        }
        s = wave_sum(s);
        if (lane == 0) SS[m] = s;
        const float* pr = m < MP ? a->in[6] + (size_t)m * PLE : a->in[7] + (size_t)(m - MP) * PLE;
        const f32x4 pv = ((const f32x4*)pr)[lane];
        u32x2 w; w.x = cvt_pk_bf16(pv[0], pv[1]); w.y = cvt_pk_bf16(pv[2], pv[3]);
        ((u32x2*)(PB + (size_t)m * PLE))[lane] = w;
    }
    for (int i = blockIdx.x * 512 + tid; i < 4 * M; i += gridDim.x * 512) SS[M + i] = 0.f;
    float* RT = (float*)(ws + WS_ROPE);
    for (int i = blockIdx.x * 512 + tid; i < 2056 * 8; i += gridDim.x * 512) {
        const int idx = i >> 3, f = i & 7;
        const int pos = idx < 2048 ? idx : PAST + (idx - 2048);
        const float inv = powf(500000.0f, -(float)f * 0.125f);
        const float ang = (float)pos * inv;
        const double rev = (double)ang * 0.15915494309189535;
        const float fr = (float)(rev - rint(rev));
        RT[idx * 16 + f] = __builtin_amdgcn_cosf(fr);
        RT[idx * 16 + 8 + f] = __builtin_amdgcn_sinf(fr);
    }
}

__device__ __forceinline__ void p4_mixprep(CArgs* a) {
    const int tid = threadIdx.x, lane = tid & 63, wave = tid >> 6;
    unsigned char* ws = a->ws;
    const bf16_t* PROJ = (const bf16_t*)(ws + WS_PROJ);
    bf16_t* GQ = (bf16_t*)(ws + WS_GQ); bf16_t* GK = (bf16_t*)(ws + WS_GK); bf16_t* GV = (bf16_t*)(ws + WS_GV);
    bf16_t* QS = (bf16_t*)(ws + WS_QS); bf16_t* KS = (bf16_t*)(ws + WS_KS); bf16_t* VS = (bf16_t*)(ws + WS_VS);
    const float* AB = (const float*)(ws + WS_AB); float* GD = (float*)(ws + WS_GD); float* BT = (float*)(ws + WS_BT);
    const float* RT = (const float*)(ws + WS_ROPE);
    const float* state_conv = a->in[3]; const float* conv_w = a->in[13];
    const int gw = blockIdx.x * 8 + wave, NGW = gridDim.x * 8;
    for (int r = gw; r < M; r += NGW) {
        const bool samp = r >= MP;
        int b, t;
        if (!samp) { b = r >> 11; t = r & 2047; } else { b = (r - MP) >> 3; t = (r - MP) & 7; }
        const int T = samp ? TS : TP;
        const bf16_t* prow = PROJ + (size_t)r * NINP;
#pragma unroll
        for (int j = 0; j < 3; ++j) {
            const int ch = j * 512 + lane * 8;
            float acc[8], cur[8];
#pragma unroll
            for (int i = 0; i < 8; ++i) acc[i] = 0.f;
#pragma unroll
            for (int tap = 0; tap < 4; ++tap) {
                const int tt = t - 3 + tap;
                float x[8];
                if (tt >= 0) { const u32x4 raw = *(const u32x4*)(prow - (ptrdiff_t)(3 - tap) * NINP + ch); unpack8(raw, x); }
                else if (samp) {
                    const float* sc = state_conv + ((size_t)b * 3 + (3 + tt)) * 1536 + ch;
                    const f32x4 s0 = *(const f32x4*)sc, s1 = *(const f32x4*)(sc + 4);
                    x[0] = s0[0]; x[1] = s0[1]; x[2] = s0[2]; x[3] = s0[3]; x[4] = s1[0]; x[5] = s1[1]; x[6] = s1[2]; x[7] = s1[3];
                } else {
#pragma unroll
                    for (int i = 0; i < 8; ++i) x[i] = 0.f;
                }
                const f32x4 w0 = *(const f32x4*)(conv_w + tap * 1536 + ch), w1 = *(const f32x4*)(conv_w + tap * 1536 + ch + 4);
                acc[0] += x[0] * w0[0]; acc[1] += x[1] * w0[1]; acc[2] += x[2] * w0[2]; acc[3] += x[3] * w0[3];
                acc[4] += x[4] * w1[0]; acc[5] += x[5] * w1[1]; acc[6] += x[6] * w1[2]; acc[7] += x[7] * w1[3];
                if (tap == 3) {
#pragma unroll
                    for (int i = 0; i < 8; ++i) cur[i] = x[i];
                }
            }
            float ssq = 0.f;
#pragma unroll
            for (int i = 0; i < 8; ++i) { acc[i] = acc[i] * sigmoidf_(acc[i]); ssq += acc[i] * acc[i]; }
            if (j < 2) {
                ssq += __shfl_xor(ssq, 1); ssq += __shfl_xor(ssq, 2); ssq += __shfl_xor(ssq, 4); ssq += __shfl_xor(ssq, 8);
                const float sc = rsqrtf(ssq + 1e-6f) * (j == 0 ? 0.08838834764831845f : 1.0f);
#pragma unroll
                for (int i = 0; i < 8; ++i) acc[i] *= sc;
            }
            bf16_t* dst = (j == 0 ? GQ : (j == 1 ? GK : GV)) + (size_t)r * 512 + lane * 8;
            *(u32x4*)dst = pack8(acc);
            if (t >= T - 3) {
                float* so = a->out + (samp ? O_SCS : O_SCP) + ((size_t)b * 3 + (t - (T - 3))) * 1536 + ch;
                *(f32x4*)so = (f32x4){cur[0], cur[1], cur[2], cur[3]};
                *(f32x4*)(so + 4) = (f32x4){cur[4], cur[5], cur[6], cur[7]};
            }
        }
        if (lane < 4) {
            const float av = AB[(size_t)r * 8 + lane], bv = AB[(size_t)r * 8 + 4 + lane];
            const float sp = av + a->in[15][lane];
            const float softplus = sp > 20.f ? sp : log1pf(expf(sp));
            GD[(size_t)r * 4 + lane] = -expf(a->in[14][lane]) * softplus;
            BT[(size_t)r * 4 + lane] = 1.f / (1.f + expf(-bv));
        }
        const float* rt = RT + (size_t)(samp ? 2048 + t : t) * 16;
        float cs[8], sn[8];
        {
            const f32x4 c0 = *(const f32x4*)rt, c1 = *(const f32x4*)(rt + 4), s0 = *(const f32x4*)(rt + 8), s1 = *(const f32x4*)(rt + 12);
            cs[0] = c0[0]; cs[1] = c0[1]; cs[2] = c0[2]; cs[3] = c0[3]; cs[4] = c1[0]; cs[5] = c1[1]; cs[6] = c1[2]; cs[7] = c1[3];
            sn[0] = s0[0]; sn[1] = s0[1]; sn[2] = s0[2]; sn[3] = s0[3]; sn[4] = s1[0]; sn[5] = s1[1]; sn[6] = s1[2]; sn[7] = s1[3];
        }
        {
            float x[8], o[8];
            unpack8(*(const u32x4*)(prow + 2048 + lane * 8), x);
#pragma unroll
            for (int i = 0; i < 8; ++i) o[i] = __shfl_xor(x[i], 1);
            const int l8 = lane & 7;
            if (l8 == 0) {
#pragma unroll
                for (int i = 0; i < 8; ++i) x[i] = x[i] * cs[i] - o[i] * sn[i];
            } else if (l8 == 1) {
#pragma unroll
                for (int i = 0; i < 8; ++i) x[i] = x[i] * cs[i] + o[i] * sn[i];
            }
#pragma unroll
            for (int i = 0; i < 8; ++i) x[i] *= 0.125f;
            *(u32x4*)(QS + (size_t)r * 512 + lane * 8) = pack8(x);
        }
        {
            const int kl = lane & 15;
            float x[8], o[8];
            unpack8(*(const u32x4*)(prow + 2560 + kl * 8), x);
#pragma unroll
            for (int i = 0; i < 8; ++i) o[i] = __shfl_xor(x[i], 1);
            const int l8 = kl & 7;
            if (l8 == 0) {
#pragma unroll
                for (int i = 0; i < 8; ++i) x[i] = x[i] * cs[i] - o[i] * sn[i];
            } else if (l8 == 1) {
#pragma unroll
                for (int i = 0; i < 8; ++i) x[i] = x[i] * cs[i] + o[i] * sn[i];
            }
            const u32x4 vraw = *(const u32x4*)(prow + 2688 + kl * 8);
            if (lane < 16) {
                *(u32x4*)(KS + (size_t)r * 128 + kl * 8) = pack8(x);
                *(u32x4*)(VS + (size_t)r * 128 + kl * 8) = vraw;
                const int crow = samp ? 120 + t : t - (TP - 128);
                if (crow >= 0) {
                    float v[8]; unpack8(vraw, v);
                    float* ck = a->out + (samp ? O_CKS : O_CKP) + ((size_t)b * 128 + crow) * 128 + kl * 8;
                    float* cv = a->out + (samp ? O_CVS : O_CVP) + ((size_t)b * 128 + crow) * 128 + kl * 8;
                    *(f32x4*)ck = (f32x4){x[0], x[1], x[2], x[3]}; *(f32x4*)(ck + 4) = (f32x4){x[4], x[5], x[6], x[7]};
                    *(f32x4*)cv = (f32x4){v[0], v[1], v[2], v[3]}; *(f32x4*)(cv + 4) = (f32x4){v[4], v[5], v[6], v[7]};
                }
            }
        }
        if (samp) {
            for (int e = lane; e < 15 * 32; e += 64) {
                const int j = t * 15 + (e >> 5), c4 = (e & 31) * 4;
                const size_t d = ((size_t)b * 128 + j) * 128 + c4, s = ((size_t)b * 128 + j + 8) * 128 + c4;
                *(f32x4*)(a->out + O_CKS + d) = *(const f32x4*)(a->in[4] + s);
                *(f32x4*)(a->out + O_CVS + d) = *(const f32x4*)(a->in[5] + s);
            }
        }
    }
}

__device__ __forceinline__ void gdn_item(CArgs* a, LAS unsigned char* L, int item, bool samp) {
    const int tid = threadIdx.x;
    unsigned char* ws = a->ws;
    const bf16_t* GQ = (const bf16_t*)(ws + WS_GQ); const bf16_t* GK = (const bf16_t*)(ws + WS_GK); const bf16_t* GV = (const bf16_t*)(ws + WS_GV);
    const float* GD = (const float*)(ws + WS_GD); const float* BT = (const float*)(ws + WS_BT);
    unsigned char* PROJb = ws + WS_PROJ;
    const int b = item >> 4, h = (item >> 2) & 3, qd = item & 3;
    const int row0 = samp ? MP + b * TS : b * TP, T = samp ? TS : TP;
    const float* S0 = samp ? a->in[2] + (size_t)(b * 4 + h) * 16384 : nullptr;
    float* Sout = a->out + (samp ? O_SGS : O_SGP) + (size_t)(b * 4 + h) * 16384;
    const int cl = tid >> 4, part = tid & 15;
    LAS float* kb = (LAS float*)L;
    LAS float* qb = kb + 32 * 128;
    LAS float* vb = qb + 32 * 128;
    LAS float* ob = vb + 32 * 32;
    LAS float* eg = ob + 32 * 32;
    LAS float* bt = eg + 32;
    LAS float* sb = bt + 32;
    __syncthreads();
    float S[8];
    if (S0) {
        const int dk = tid >> 2, c8 = (tid & 3) * 8;
        const f32x4 s0 = *(const f32x4*)(S0 + (size_t)dk * 128 + qd * 32 + c8), s1 = *(const f32x4*)(S0 + (size_t)dk * 128 + qd * 32 + c8 + 4);
#pragma unroll
        for (int i = 0; i < 4; ++i) { sb[dk * 33 + c8 + i] = s0[i]; sb[dk * 33 + c8 + 4 + i] = s1[i]; }
        __syncthreads();
#pragma unroll
        for (int i = 0; i < 8; ++i) S[i] = sb[(part * 8 + i) * 33 + cl];
    } else {
#pragma unroll
        for (int i = 0; i < 8; ++i) S[i] = 0.f;
    }
    const int TB = T < 32 ? T : 32;
    const int ptok = tid >> 4, pch = (tid & 15) * 8;
    const int vtok = tid >> 2, vch = (tid & 3) * 8;
    const bool pk_ok = ptok < TB, pv_ok = vtok < TB && tid < 128, pe_ok = tid < TB;
    u32x4 rk = {0u, 0u, 0u, 0u}, rq = {0u, 0u, 0u, 0u}, rv = {0u, 0u, 0u, 0u}; float re = 0.f, rb = 0.f;
#define GDN_PREFETCH(t0) do { \
        if (pk_ok) { const size_t o_ = (size_t)(row0 + (t0) + ptok) * 512 + h * 128 + pch; rk = *(const u32x4*)(GK + o_); rq = *(const u32x4*)(GQ + o_); } \
        if (pv_ok) { rv = *(const u32x4*)(GV + (size_t)(row0 + (t0) + vtok) * 512 + h * 128 + qd * 32 + vch); } \
        if (pe_ok) { re = GD[(size_t)(row0 + (t0) + tid) * 4 + h]; rb = BT[(size_t)(row0 + (t0) + tid) * 4 + h]; } } while (0)
    GDN_PREFETCH(0);
    for (int t0 = 0; t0 < T; t0 += TB) {
        if (pk_ok) {
            float x[8];
            unpack8(rk, x); *(LAS f32x4*)(kb + ptok * 128 + pch) = (f32x4){x[0], x[1], x[2], x[3]}; *(LAS f32x4*)(kb + ptok * 128 + pch + 4) = (f32x4){x[4], x[5], x[6], x[7]};
            unpack8(rq, x); *(LAS f32x4*)(qb + ptok * 128 + pch) = (f32x4){x[0], x[1], x[2], x[3]}; *(LAS f32x4*)(qb + ptok * 128 + pch + 4) = (f32x4){x[4], x[5], x[6], x[7]};
        }
        if (pv_ok) { float x[8]; unpack8(rv, x); *(LAS f32x4*)(vb + vtok * 32 + vch) = (f32x4){x[0], x[1], x[2], x[3]}; *(LAS f32x4*)(vb + vtok * 32 + vch + 4) = (f32x4){x[4], x[5], x[6], x[7]}; }
        if (pe_ok) { eg[tid] = __expf(re); bt[tid] = rb; }
        __syncthreads();
        if (t0 + TB < T) GDN_PREFETCH(t0 + TB);
        for (int tok = 0; tok < TB; ++tok) {
            const f32x4 k0 = *(const LAS f32x4*)(kb + tok * 128 + part * 8), k1 = *(const LAS f32x4*)(kb + tok * 128 + part * 8 + 4);
            const f32x4 q0 = *(const LAS f32x4*)(qb + tok * 128 + part * 8), q1 = *(const LAS f32x4*)(qb + tok * 128 + part * 8 + 4);
            const float v = vb[tok * 32 + cl], e = eg[tok], be = bt[tok];
            float ks = ((k0[0] * S[0] + k0[1] * S[1]) + (k0[2] * S[2] + k0[3] * S[3])) + ((k1[0] * S[4] + k1[1] * S[5]) + (k1[2] * S[6] + k1[3] * S[7]));
            ks = reduce16(ks);
            const float vn = be * (v - e * ks);
            S[0] = e * S[0] + k0[0] * vn; S[1] = e * S[1] + k0[1] * vn; S[2] = e * S[2] + k0[2] * vn; S[3] = e * S[3] + k0[3] * vn;
            S[4] = e * S[4] + k1[0] * vn; S[5] = e * S[5] + k1[1] * vn; S[6] = e * S[6] + k1[2] * vn; S[7] = e * S[7] + k1[3] * vn;
            float o = ((q0[0] * S[0] + q0[1] * S[1]) + (q0[2] * S[2] + q0[3] * S[3])) + ((q1[0] * S[4] + q1[1] * S[5]) + (q1[2] * S[6] + q1[3] * S[7]));
            o = reduce16(o);
            if (part == 0) ob[tok * 32 + cl] = o;
        }
        __syncthreads();
        if (tid < 256) {
            const int tok = tid >> 3, c4 = (tid & 7) * 4;
            if (tok < TB) {
                float* og = (float*)(PROJb + (size_t)(row0 + t0 + tok) * (NINP * 2));
                *(f32x4*)(og + h * 128 + qd * 32 + c4) = *(const LAS f32x4*)(ob + tok * 32 + c4);
            }
        }
    }
#undef GDN_PREFETCH
    __syncthreads();
#pragma unroll
    for (int i = 0; i < 8; ++i) sb[(part * 8 + i) * 33 + cl] = S[i];
    __syncthreads();
    {
        const int dk = tid >> 2, c8 = (tid & 3) * 8;
        f32x4 s0, s1;
#pragma unroll
        for (int i = 0; i < 4; ++i) { s0[i] = sb[dk * 33 + c8 + i]; s1[i] = sb[dk * 33 + c8 + 4 + i]; }
        *(f32x4*)(Sout + (size_t)dk * 128 + qd * 32 + c8) = s0; *(f32x4*)(Sout + (size_t)dk * 128 + qd * 32 + c8 + 4) = s1;
    }
}

__device__ __forceinline__ void swa_item(CArgs* a, LAS unsigned char* L, int it) {
    const int tid = threadIdx.x, lane = tid & 63, wave = tid >> 6;
    unsigned char* ws = a->ws;
    const bf16_t* QS = (const bf16_t*)(ws + WS_QS); const bf16_t* KS = (const bf16_t*)(ws + WS_KS); const bf16_t* VS = (const bf16_t*)(ws + WS_VS);
    bf16_t* MIX = (bf16_t*)(ws + WS_MIX);
    const bool samp = it >= 2048;
    int b, kvh, tq0, nq, row0;
    if (!samp) { b = it >> 7; const int rem = it & 127; kvh = rem & 1; tq0 = (rem >> 1) * 32; nq = 32; row0 = b * TP; }
    else { const int i2 = it - 2048; b = i2 >> 1; kvh = i2 & 1; tq0 = 0; nq = TS; row0 = MP + b * TS; }
    const int nrows = 127 + nq;
    LAS float* Kf = (LAS float*)L;
    LAS float* Vf = Kf + 159 * 68;
    LAS float* Qw = Vf + 159 * 68;
    LAS float* Pw = Qw + 8 * 256;
    __syncthreads();
    for (int e = tid; e < nrows * 8; e += 512) {
        const int j = e >> 3, d8 = (e & 7) * 8, p = tq0 - 127 + j;
        float kx[8], vx[8];
        if (p >= 0) {
            const size_t o_ = (size_t)(row0 + p) * 128 + kvh * 64 + d8;
            unpack8(*(const u32x4*)(KS + o_), kx); unpack8(*(const u32x4*)(VS + o_), vx);
        } else if (samp) {
            const size_t o_ = ((size_t)b * 128 + (128 + p)) * 128 + kvh * 64 + d8;
            const f32x4 k0 = *(const f32x4*)(a->in[4] + o_), k1 = *(const f32x4*)(a->in[4] + o_ + 4), v0 = *(const f32x4*)(a->in[5] + o_), v1 = *(const f32x4*)(a->in[5] + o_ + 4);
#pragma unroll
            for (int i = 0; i < 4; ++i) { kx[i] = k0[i]; kx[4 + i] = k1[i]; vx[i] = v0[i]; vx[4 + i] = v1[i]; }
        } else {
#pragma unroll
            for (int i = 0; i < 8; ++i) { kx[i] = 0.f; vx[i] = 0.f; }
        }
        *(LAS f32x4*)(Kf + j * 68 + d8) = (f32x4){kx[0], kx[1], kx[2], kx[3]}; *(LAS f32x4*)(Kf + j * 68 + d8 + 4) = (f32x4){kx[4], kx[5], kx[6], kx[7]};
        *(LAS f32x4*)(Vf + j * 68 + d8) = (f32x4){vx[0], vx[1], vx[2], vx[3]}; *(LAS f32x4*)(Vf + j * 68 + d8 + 4) = (f32x4){vx[4], vx[5], vx[6], vx[7]};
    }
    __syncthreads();
    LAS float* Qm = Qw + wave * 256;
    LAS float* Pm = Pw + wave * 512;
    for (int i = wave; i < nq; i += 8) {
        const int row = row0 + tq0 + i;
        {
            const u32x2 rq = *(const u32x2*)(QS + (size_t)row * 512 + kvh * 256 + lane * 4);
            *(LAS f32x4*)(Qm + lane * 4) = (f32x4){bf2f(rq.x & 0xffffu), bf2f(rq.x >> 16), bf2f(rq.y & 0xffffu), bf2f(rq.y >> 16)};
        }
        LDS_WAIT();
        float s[2][4];
#pragma unroll
        for (int kk = 0; kk < 2; ++kk) {
            const int j = i + lane + 64 * kk;
            const LAS float* kr = Kf + j * 68;
            float ac[4] = {0.f, 0.f, 0.f, 0.f};
#pragma unroll 4
            for (int d4 = 0; d4 < 16; ++d4) {
                const f32x4 kv = *(const LAS f32x4*)(kr + d4 * 4);
#pragma unroll
                for (int hh = 0; hh < 4; ++hh) {
                    const f32x4 qv = *(const LAS f32x4*)(Qm + hh * 64 + d4 * 4);
                    ac[hh] += (kv[0] * qv[0] + kv[1] * qv[1]) + (kv[2] * qv[2] + kv[3] * qv[3]);
                }
            }
            const bool valid = samp || (tq0 - 127 + j >= 0);
#pragma unroll
            for (int hh = 0; hh < 4; ++hh) s[kk][hh] = valid ? ac[hh] : -INFINITY;
        }
        f32x4 p0, p1;
#pragma unroll
        for (int hh = 0; hh < 4; ++hh) {
            const float sk = a->in[17][kvh * 4 + hh];
            float mx = wave_max(fmaxf(s[0][hh], s[1][hh]));
            mx = fmaxf(mx, sk);
            const float e0 = __expf(s[0][hh] - mx), e1 = __expf(s[1][hh] - mx);
            const float den = wave_sum(e0 + e1) + __expf(sk - mx);
            const float inv = 1.f / den;
            p0[hh] = e0 * inv; p1[hh] = e1 * inv;
        }
        *(LAS f32x4*)(Pm + lane * 4) = p0; *(LAS f32x4*)(Pm + (lane + 64) * 4) = p1;
        LDS_WAIT();
        float o[4] = {0.f, 0.f, 0.f, 0.f};
#pragma unroll 8
        for (int jj = 0; jj < 128; ++jj) {
            const f32x4 pj = *(const LAS f32x4*)(Pm + jj * 4);
            const float v = Vf[(i + jj) * 68 + lane];
            o[0] += pj[0] * v; o[1] += pj[1] * v; o[2] += pj[2] * v; o[3] += pj[3] * v;
        }
#pragma unroll
        for (int hh = 0; hh < 4; ++hh) MIX[(size_t)row * 1024 + 512 + (kvh * 4 + hh) * 64 + lane] = (bf16_t)(cvt_pk_bf16(o[hh], 0.f) & 0xffffu);
        LDS_WAIT();
    }
}

__device__ __forceinline__ void p5b_finalize(CArgs* a) {
    const int tid = threadIdx.x, lane = tid & 63, wave = tid >> 6;
    unsigned char* ws = a->ws;
    const unsigned char* PROJb = ws + WS_PROJ; bf16_t* MIX = (bf16_t*)(ws + WS_MIX);
    const int gw = blockIdx.x * 8 + wave, NGW = gridDim.x * 8;
    const float* gn = a->in[16] + (lane & 15) * 8;
    const f32x4 g0 = *(const f32x4*)gn, g1 = *(const f32x4*)(gn + 4);
    for (int r = gw; r < M; r += NGW) {
        const float* og = (const float*)(PROJb + (size_t)r * (NINP * 2)) + lane * 8;
        const f32x4 o0 = *(const f32x4*)og, o1 = *(const f32x4*)(og + 4);
        float z[8]; unpack8(*(const u32x4*)((const bf16_t*)(PROJb + (size_t)r * (NINP * 2)) + 1536 + lane * 8), z);
        float ssq = (o0[0] * o0[0] + o0[1] * o0[1]) + (o0[2] * o0[2] + o0[3] * o0[3]) + (o1[0] * o1[0] + o1[1] * o1[1]) + (o1[2] * o1[2] + o1[3] * o1[3]);
        ssq += __shfl_xor(ssq, 1); ssq += __shfl_xor(ssq, 2); ssq += __shfl_xor(ssq, 4); ssq += __shfl_xor(ssq, 8);
        const float rs = rsqrtf(ssq * (1.f / 128.f) + EPS);
        float x[8];
#pragma unroll
        for (int i = 0; i < 4; ++i) { x[i] = o0[i] * rs * g0[i] * (z[i] * sigmoidf_(z[i])); x[4 + i] = o1[i] * rs * g1[i] * (z[4 + i] * sigmoidf_(z[4 + i])); }
        *(u32x4*)(MIX + (size_t)r * 1024 + lane * 8) = pack8(x);
    }
}

__device__ __forceinline__ void p10_final(CArgs* a) {
    const int tid = threadIdx.x, lane = tid & 63, wave = tid >> 6;
    const float* SS5 = (const float*)(a->ws + WS_SS) + 4 * (size_t)M;
    const int gw = blockIdx.x * 8 + wave, NGW = gridDim.x * 8;
    f32x4 g[4];
#pragma unroll
    for (int j = 0; j < 4; ++j) g[j] = ((const f32x4*)a->in[25])[lane + 64 * j];
    for (int r = gw; r < M; r += NGW) {
        const float rs = rsqrtf(SS5[r] * (1.f / DM) + EPS);
        f32x4* y = (f32x4*)(a->out + O_Y + (size_t)r * DM);
#pragma unroll
        for (int j = 0; j < 4; ++j) { const f32x4 v = y[lane + 64 * j]; y[lane + 64 * j] = v * rs * g[j]; }
    }
}

constexpr int NPHASE = 12;
#ifndef PHMASK
#define PHMASK 0xFFF
#endif
__global__ void __launch_bounds__(512, 2) mk_fwd(Args a_by_value) {
    extern __shared__ __attribute__((aligned(16))) unsigned char lds_raw[];
    LAS unsigned char* L = (LAS unsigned char*)lds_raw;
    cg::grid_group grid = cg::this_grid();
    const int lo = get_args()->ph_lo, hi = get_args()->ph_hi, G = gridDim.x, bid = blockIdx.x;
#define IN(k) (((PHMASK >> (k)) & 1) && lo <= (k) && (k) < hi)
#define SEAM(k) do { if (IN(k) && IN((k) + 1)) grid.sync(); } while (0)
#define PH_ARGS() CArgs* a = get_args(); unsigned char* ws = a->ws; (void)ws
    if (IN(0)) { PH_ARGS(); p0_prologue(a, L); } SEAM(0);
    if (IN(1)) {
        PH_ARGS(); float* SS = (float*)(ws + WS_SS);
        pg8::Gemm g{(const bf16_t*)(ws + WS_HB), (const bf16_t*)(ws + WS_GU1), M, NGU, DM}; pg8::StaticOrder S; S.init(M, NGU, G, bid);
        EpiSwiglu E{(bf16_t*)(ws + WS_ACT), SS};
        pg8::gemm_phase<EpiSwiglu, pg8::StaticOrder, true, true>(L, g, S, E);
    } SEAM(1);
    if (IN(2)) {
        PH_ARGS(); float* SS = (float*)(ws + WS_SS);
        pg8::Gemm g{(const bf16_t*)(ws + WS_ACT), (const bf16_t*)(ws + WS_D1), M, DM, DFF}; pg8::StaticOrder S; S.init(M, DM, G, bid);
        EpiResid E{a->in[0], a->in[1], a->out + O_Y, (bf16_t*)(ws + WS_HB), SS + M, 0.5f};
        pg8::gemm_phase<EpiResid, pg8::StaticOrder, true, true>(L, g, S, E);
    } SEAM(2);
    if (IN(3)) {
        PH_ARGS(); float* SS = (float*)(ws + WS_SS);
        pg8::Gemm g{(const bf16_t*)(ws + WS_HB), (const bf16_t*)(ws + WS_IN), M, NINP, DM}; pg8::StaticOrder S; S.init(M, NINP, G, bid);
        EpiProj E{(bf16_t*)(ws + WS_PROJ), SS + M, (float*)(ws + WS_AB)};
        pg8::gemm_phase<EpiProj, pg8::StaticOrder, true, true>(L, g, S, E);
    } SEAM(3);
    if (IN(4)) { PH_ARGS(); p4_mixprep(a); } SEAM(4);
    if (IN(5)) {
        PH_ARGS();
        for (int it = bid; it < 256 + 2048 + 2304; it += G) {
            if (it < 256) gdn_item(a, L, it, false);
            else if (it < 2304) gdn_item(a, L, it - 256, true);
            else swa_item(a, L, it - 2304);
        }
    } SEAM(5);
    if (IN(6)) { PH_ARGS(); p5b_finalize(a); } SEAM(6);
    if (IN(7)) {
        PH_ARGS(); float* SS = (float*)(ws + WS_SS); float* HF = a->out + O_Y;
        pg8::Gemm g{(const bf16_t*)(ws + WS_MIX), (const bf16_t*)(ws + WS_OUT), M, DM, DM}; pg8::StaticOrder S; S.init(M, DM, G, bid);
        EpiResid E{HF, HF + (size_t)MP * DM, HF, (bf16_t*)(ws + WS_HB), SS + 2 * M, 1.0f};
        pg8::gemm_phase<EpiResid, pg8::StaticOrder, true, true>(L, g, S, E);
    } SEAM(7);
    if (IN(8)) {
        PH_ARGS(); float* SS = (float*)(ws + WS_SS);
        pg8::Gemm g{(const bf16_t*)(ws + WS_HB), (const bf16_t*)(ws + WS_GU2), M, NGU, DM}; pg8::StaticOrder S; S.init(M, NGU, G, bid);
        EpiSwiglu E{(bf16_t*)(ws + WS_ACT), SS + 2 * M};
        pg8::gemm_phase<EpiSwiglu, pg8::StaticOrder, true, true>(L, g, S, E);
    } SEAM(8);
    if (IN(9)) {
        {
            PH_ARGS(); float* SS = (float*)(ws + WS_SS); float* HF = a->out + O_Y;
            pg8::Gemm g{(const bf16_t*)(ws + WS_ACT), (const bf16_t*)(ws + WS_D2), M, DM, DFF}; pg8::StaticOrder S; S.init(M, DM, G, bid);
            EpiResid E{HF, HF + (size_t)MP * DM, HF, (bf16_t*)(ws + WS_HB), SS + 3 * M, 0.5f};
            pg8::gemm_phase<EpiResid, pg8::StaticOrder, true, true>(L, g, S, E);
        }
        {
            PH_ARGS();
            int kple = PLE; asm volatile("" : "+s"(kple)); kple = __builtin_amdgcn_readfirstlane(kple);
            pg8::Gemm g{(const bf16_t*)(ws + WS_PB), (const bf16_t*)(ws + WS_PPW), M, DM, kple}; pg8::StaticOrder S; S.init(M, DM, G, bid);
            EpiPlain E{(bf16_t*)(ws + WS_PP)};
            pg8::gemm_phase<EpiPlain, pg8::StaticOrder, true, true>(L, g, S, E);
        }
    } SEAM(9);
    if (IN(10)) {
        PH_ARGS(); float* SS = (float*)(ws + WS_SS);
        pg8::Gemm g{(const bf16_t*)(ws + WS_HB), (const bf16_t*)(ws + WS_PG), M, DM, DM}; pg8::StaticOrder S; S.init(M, DM, G, bid);
        EpiGate E{a->out + O_Y, (const bf16_t*)(ws + WS_PP), SS + 3 * M, SS + 4 * M};
        pg8::gemm_phase<EpiGate, pg8::StaticOrder, true, true>(L, g, S, E);
    } SEAM(10);
    if (IN(11)) { PH_ARGS(); p10_final(a); }
#undef IN
#undef SEAM
#undef PH_ARGS
}

#ifndef MK_LAUNCHES
#define MK_LAUNCHES 1
#endif
extern "C" void kernel_launch(void* const* d_in, const int* in_sizes, int n_in, void* d_out, int out_size, void* d_ws, size_t ws_size, hipStream_t stream) {
    static int grid = 0;
    if (grid == 0) {
        if (n_in != 26 || (size_t)out_size != O_END || ws_size < WS_END) {
            fprintf(stderr, "kernel_launch: unexpected shapes: n_in %d out %d ws %zu (need out %zu, ws >= %zu)\n", n_in, out_size, ws_size, (size_t)O_END, (size_t)WS_END);
            grid = -1; return;
        }
        int dev = 0, cus = 0, per_cu = 0;
        hipGetDevice(&dev);
        hipDeviceGetAttribute(&cus, hipDeviceAttributeMultiprocessorCount, dev);
        if (hipFuncSetAttribute((const void*)mk_fwd, hipFuncAttributeMaxDynamicSharedMemorySize, LDS_BYTES) != hipSuccess) { fprintf(stderr, "kernel_launch: hipFuncSetAttribute failed\n"); grid = -1; return; }
        if (hipOccupancyMaxActiveBlocksPerMultiprocessor(&per_cu, (const void*)mk_fwd, 512, LDS_BYTES) != hipSuccess || per_cu < 1) { fprintf(stderr, "kernel_launch: occupancy query gave %d\n", per_cu); per_cu = 1; }
        (void)hipGetLastError();
        grid = cus * per_cu;
        fprintf(stderr, "kernel_launch: grid %d (cus %d x %d)\n", grid, cus, per_cu);
    }
    if (grid < 0) return;
    Args a{};
    for (int i = 0; i < 26; ++i) a.in[i] = (const float*)d_in[i];
    a.out = (float*)d_out; a.ws = (unsigned char*)d_ws;
#if MK_LAUNCHES == 1
    a.ph_lo = 0; a.ph_hi = NPHASE;
    void* kargs[] = {&a};
    hipError_t e = hipLaunchCooperativeKernel((const void*)mk_fwd, dim3(grid), dim3(512), kargs, LDS_BYTES, stream);
    if (e != hipSuccess) fprintf(stderr, "kernel_launch: cooperative launch failed: %s (grid %d)\n", hipGetErrorString(e), grid);
#else
    for (int p = 0; p < NPHASE; ++p) {
        a.ph_lo = p; a.ph_hi = p + 1;
        hipLaunchKernelGGL(mk_fwd, dim3(grid), dim3(512), LDS_BYTES, stream, a);
    }
#endif
}
```

```cpp
#include <hip/hip_runtime.h>
#include <hip/hip_cooperative_groups.h>
#include <cstdio>
#include <cstdint>
namespace cg = cooperative_groups;
namespace pg8 {
#define PG8_LAS __attribute__((address_space(3)))
typedef unsigned short bf16_t;
typedef short bf16x8 __attribute__((ext_vector_type(8)));
typedef float f32x4 __attribute__((ext_vector_type(4)));
typedef unsigned u32x4 __attribute__((ext_vector_type(4)));
constexpr int BM = 256, BK = 64, HALF = 128, HTB = HALF * BK * 2  , STAGE_BYTES = 8 * HTB, NXCD = 8, WGM = 8;

__host__ __device__ __forceinline__ int lds_byte(int r, int c) { const int st = (r >> 4) * 2 + (c >> 5), rr = r & 15, cc = c & 31, ob = rr * 64 + cc * 2; return st * 1024 + (ob ^ (((ob >> 9) & 1) << 5)); }
__host__ __device__ __forceinline__ void stage_rc(int b, int& R, int& C) { const int st = b / 1024, sb = b % 1024, swz = sb ^ (((sb >> 9) & 1) << 5); R = (st >> 1) * 16 + swz / 64; C = (st & 1) * 32 + (swz % 64) / 2; }
__host__ __device__ __forceinline__ int perm32(int rho) { const int n = rho >> 4, i = rho & 15; return 8 * (i >> 2) + 4 * n + (i & 3); }

struct Unit { int pm, pn; };
struct Gemm { const bf16_t* A; const bf16_t* Bt; int M, N, K; };

struct StaticOrder {
    int nM, nN, nwg, G, c;
    __host__ __device__ void init(int M, int N, int G_, int c_) { nM = M / BM; nN = N / BM; nwg = nM * nN; G = G_; c = c_; }
    __host__ __device__ bool next(int i, Unit& u) const {
        const long L = (long)i * G + c; if (L >= nwg) return false;
        int wgid = (int)L; { const int q = nwg / NXCD, r = nwg % NXCD, xcd = wgid % NXCD, off = wgid / NXCD; wgid = (xcd < r ? xcd * (q + 1) : r * (q + 1) + (xcd - r) * q) + off; }
        const int nig = WGM * nN, gid = wgid / nig, fm = gid * WGM, gsz = (nM - fm) < WGM ? (nM - fm) : WGM;
        u.pm = fm + ((wgid % nig) % gsz); u.pn = (wgid % nig) / gsz; return true;
    }
    __device__ __forceinline__ void a_ready(const Unit&) const {}
    __device__ __forceinline__ void done(const Unit&) const {}
};

__device__ __forceinline__ unsigned cvt_pk_bf16(float lo, float hi) { unsigned r; asm volatile("v_cvt_pk_bf16_f32 %0, %1, %2" : "=v"(r) : "v"(lo), "v"(hi)); return r; }
typedef float f32x2 __attribute__((ext_vector_type(2)));
template <class Epi, class Sched, bool ALIGN_EPI = false, bool SP2 = false>
__device__ __forceinline__ void gemm_phase(PG8_LAS unsigned char* lds, const Gemm g, const Sched& S, const Epi& E) {
    const int tid = threadIdx.x, wid = __builtin_amdgcn_readfirstlane(tid >> 6), lane = tid & 63, wr = wid >> 2, wc = wid & 3, fr = lane & 15, fq = lane >> 4;
    const int K = g.K, nt = K / BK;
    unsigned voffA[2], voffB[2];
#pragma unroll
    for (int i = 0; i < 2; ++i) { int R, C; stage_rc(tid * 16 + i * 8192, R, C); const int Rb = Epi::PERM ? ((R & ~31) + perm32(R & 31)) : R;
        voffA[i] = (unsigned)(R * K + C) * 2u; voffB[i] = (unsigned)(Rb * K + C) * 2u; }
    const size_t kstep = (size_t)(BK * 2);
    const size_t hstep = (size_t)HALF * K * 2;
    const size_t tstep = 2 * hstep;
    const unsigned ldsw = (unsigned)wid * 1024u;
    const int aoff = lds_byte(wr * 64 + fr, fq * 8), boff = lds_byte(wc * 32 + fr, fq * 8);
#define PG8_SA(b, h) (((b) * 2 + (h)) * HTB)
#define PG8_SB(b, h) ((4 + (b) * 2 + (h)) * HTB)
#define PG8_STAGE(bufoff, gbase, voff) do { _Pragma("unroll") for (int _i = 0; _i < 2; ++_i) \
        __builtin_amdgcn_global_load_lds((const unsigned*)((const char*)(gbase) + (voff)[_i]), (PG8_LAS unsigned*)(lds + (bufoff) + ldsw + _i * 8192), 16, 0, 0); } while (0)
#define PG8_LDA(dst, b, h) do { _Pragma("unroll") for (int m = 0; m < 4; ++m) _Pragma("unroll") for (int k = 0; k < 2; ++k) dst[m][k] = *(const PG8_LAS bf16x8*)(lds + PG8_SA(b, h) + aoff + m * 2048 + k * 1024); } while (0)
#define PG8_LDB(dst, b, h) do { _Pragma("unroll") for (int n = 0; n < 2; ++n) _Pragma("unroll") for (int k = 0; k < 2; ++k) dst[n][k] = *(const PG8_LAS bf16x8*)(lds + PG8_SB(b, h) + boff + n * 2048 + k * 1024); } while (0)
#define PG8_MMA(ai, bj, At, Bt) do { __builtin_amdgcn_s_setprio(1); _Pragma("unroll") for (int m = 0; m < 4; ++m) _Pragma("unroll") for (int n = 0; n < 2; ++n) _Pragma("unroll") for (int k = 0; k < 2; ++k) \
        acc[ai][bj][m][n] = __builtin_amdgcn_mfma_f32_16x16x32_bf16(Bt[n][k], At[m][k], acc[ai][bj][m][n], 0, 0, 0); __builtin_amdgcn_s_setprio(0); } while (0)
#define PG8_WAIT_V(n) asm volatile("s_waitcnt vmcnt(" #n ")" ::: "memory")
#define PG8_WAIT_L(n) asm volatile("s_waitcnt lgkmcnt(" #n ")" ::: "memory")
#define PG8_BAR __builtin_amdgcn_s_barrier()
#define PG8_SCHED __builtin_amdgcn_sched_barrier(0)
    Unit cur, nxt; int ui = 0;
    if (!S.next(0, cur)) return;
    f32x4 acc[2][2][4][2];
#pragma unroll
    for (int a = 0; a < 2; ++a)
#pragma unroll
        for (int b = 0; b < 2; ++b)
#pragma unroll
            for (int m = 0; m < 4; ++m)
#pragma unroll
                for (int n = 0; n < 2; ++n) acc[a][b][m][n] = (f32x4){0.f, 0.f, 0.f, 0.f};
    bf16x8 At[4][2], B0[2][2], B1[2][2];
    const char* cA = (const char*)g.A + (size_t)cur.pm * tstep; const char* cB = (const char*)g.Bt + (size_t)cur.pn * tstep;
    S.a_ready(cur);
    if constexpr (SP2) {
        PG8_STAGE(PG8_SB(0, 0), cB, voffB); PG8_STAGE(PG8_SB(0, 1), cB + hstep, voffB); PG8_STAGE(PG8_SA(0, 0), cA, voffA); PG8_STAGE(PG8_SA(0, 1), cA + hstep, voffA);
        if (wr == 1) PG8_BAR;
        PG8_WAIT_V(2); PG8_BAR;
        PG8_STAGE(PG8_SB(1, 0), cB + kstep, voffB); PG8_STAGE(PG8_SA(1, 0), cA + kstep, voffA); PG8_STAGE(PG8_SB(1, 1), cB + hstep + kstep, voffB);
        PG8_WAIT_V(6); PG8_BAR;
    } else {
        PG8_STAGE(PG8_SB(0, 0), cB, voffB); PG8_STAGE(PG8_SA(0, 0), cA, voffA); PG8_STAGE(PG8_SB(0, 1), cB + hstep, voffB); PG8_STAGE(PG8_SA(0, 1), cA + hstep, voffA);
        if (wr == 1) PG8_BAR;
        PG8_WAIT_V(4); PG8_BAR;
        PG8_STAGE(PG8_SB(1, 0), cB + kstep, voffB); PG8_STAGE(PG8_SA(1, 0), cA + kstep, voffA); PG8_STAGE(PG8_SB(1, 1), cB + hstep + kstep, voffB);
        PG8_WAIT_V(6); PG8_BAR;
    }
    for (;;) {
        const bool has_next = S.next(ui + 1, nxt);
        const char* nA = has_next ? (const char*)g.A + (size_t)nxt.pm * tstep : cA; const char* nB = has_next ? (const char*)g.Bt + (size_t)nxt.pn * tstep : cB;
        for (int t = 0; t < nt; t += 2) {
            const bool last = (t == nt - 2);
            const char* a1 = cA + (size_t)(t + 1) * kstep;
            const char* a2 = last ? nA : cA + (size_t)(t + 2) * kstep; const char* b2 = last ? nB : cB + (size_t)(t + 2) * kstep;
            const char* a3 = a2 + kstep; const char* b3 = b2 + kstep;
            if (last && has_next) S.a_ready(nxt);
            if constexpr (SP2) {
            PG8_LDB(B0, 0, 0); PG8_LDB(B1, 0, 1); PG8_SCHED; PG8_LDA(At, 0, 0); PG8_STAGE(PG8_SA(1, 1), a1 + hstep, voffA);
            PG8_WAIT_V(8); PG8_WAIT_L(0); PG8_BAR; PG8_MMA(0, 0, At, B0); PG8_MMA(0, 1, At, B1); PG8_BAR; PG8_SCHED;
            PG8_LDA(At, 0, 1); PG8_STAGE(PG8_SB(0, 0), b2, voffB); PG8_STAGE(PG8_SB(0, 1), b2 + hstep, voffB); PG8_STAGE(PG8_SA(0, 0), a2, voffA);
            PG8_WAIT_V(8); PG8_WAIT_L(0); PG8_BAR; PG8_MMA(1, 0, At, B0); PG8_MMA(1, 1, At, B1); PG8_BAR; PG8_SCHED;
            PG8_LDB(B0, 1, 0); PG8_LDB(B1, 1, 1); PG8_SCHED; PG8_LDA(At, 1, 0); PG8_STAGE(PG8_SA(0, 1), a2 + hstep, voffA);
            PG8_WAIT_V(8); PG8_WAIT_L(0); PG8_BAR; PG8_MMA(0, 0, At, B0); PG8_MMA(0, 1, At, B1); PG8_BAR; PG8_SCHED;
            PG8_LDA(At, 1, 1); PG8_STAGE(PG8_SB(1, 0), b3, voffB); PG8_STAGE(PG8_SB(1, 1), b3 + hstep, voffB); PG8_STAGE(PG8_SA(1, 0), a3, voffA);
            PG8_WAIT_V(8); PG8_WAIT_L(0); PG8_BAR; PG8_MMA(1, 0, At, B0); PG8_MMA(1, 1, At, B1); PG8_BAR; PG8_SCHED;
            } else {
            PG8_LDB(B0, 0, 0); PG8_SCHED; PG8_LDA(At, 0, 0); PG8_STAGE(PG8_SA(1, 1), a1 + hstep, voffA);
            PG8_WAIT_L(8); PG8_BAR; PG8_WAIT_L(0); PG8_MMA(0, 0, At, B0); PG8_BAR; PG8_SCHED;
            PG8_LDB(B1, 0, 1); PG8_STAGE(PG8_SB(0, 0), b2, voffB);
            PG8_BAR; PG8_WAIT_L(0); PG8_MMA(0, 1, At, B1); PG8_BAR;
            PG8_LDA(At, 0, 1); PG8_STAGE(PG8_SA(0, 0), a2, voffA);
            PG8_BAR; PG8_WAIT_L(0); PG8_MMA(1, 0, At, B0); PG8_BAR; PG8_SCHED;
            PG8_STAGE(PG8_SB(0, 1), b2 + hstep, voffB);
            PG8_WAIT_V(6); PG8_BAR; PG8_MMA(1, 1, At, B1); PG8_BAR;
            PG8_LDB(B0, 1, 0); PG8_SCHED; PG8_LDA(At, 1, 0); PG8_STAGE(PG8_SA(0, 1), a2 + hstep, voffA);
            PG8_WAIT_L(8); PG8_BAR; PG8_WAIT_L(0); PG8_MMA(0, 0, At, B0); PG8_BAR; PG8_SCHED;
            PG8_LDB(B1, 1, 1); PG8_STAGE(PG8_SB(1, 0), b3, voffB);
            PG8_BAR; PG8_WAIT_L(0); PG8_MMA(0, 1, At, B1); PG8_BAR;
            PG8_LDA(At, 1, 1); PG8_STAGE(PG8_SA(1, 0), a3, voffA);
            PG8_BAR; PG8_WAIT_L(0); PG8_MMA(1, 0, At, B0); PG8_BAR; PG8_SCHED;
            PG8_STAGE(PG8_SB(1, 1), b3 + hstep, voffB);
            PG8_WAIT_V(6); PG8_BAR; PG8_MMA(1, 1, At, B1); PG8_BAR;
            }
        }
        if constexpr (ALIGN_EPI) { if (wr == 0) PG8_BAR; }
        if constexpr (!Epi::AFTER_DRAIN) { E(acc, cur, wr, wc, fr, fq); S.done(cur); }
        if (!has_next) break;
#pragma unroll
        for (int a = 0; a < 2; ++a)
#pragma unroll
            for (int b = 0; b < 2; ++b)
#pragma unroll
                for (int m = 0; m < 4; ++m)
#pragma unroll
                    for (int n = 0; n < 2; ++n) acc[a][b][m][n] = (f32x4){0.f, 0.f, 0.f, 0.f};
        cur = nxt; cA = nA; cB = nB; ++ui;
        if constexpr (ALIGN_EPI) { if (wr == 1) PG8_BAR; }
    }
    PG8_WAIT_V(0);
    if constexpr (!ALIGN_EPI) { if (wr == 0) PG8_BAR; }
    PG8_BAR;
    if constexpr (Epi::AFTER_DRAIN) { E.fused(acc, cur, wr, wc, fr, fq, lds, wid, lane); S.done(cur); }
#undef PG8_SA
#undef PG8_SB
#undef PG8_STAGE
#undef PG8_LDA
#undef PG8_LDB
#undef PG8_MMA
#undef PG8_WAIT_V
#undef PG8_WAIT_L
#undef PG8_BAR
#undef PG8_SCHED
}
}

#define LAS __attribute__((address_space(3)))
typedef unsigned short bf16_t;
typedef float f32x4 __attribute__((ext_vector_type(4)));
typedef unsigned u32x4 __attribute__((ext_vector_type(4)));
typedef unsigned u32x2 __attribute__((ext_vector_type(2)));
using pg8::cvt_pk_bf16;

constexpr int DM = 1024, TP = 2048, NBP = 16, NBS = 128, TS = 8;
constexpr int MP = NBP * TP, MS = NBS * TS, M = MP + MS;
constexpr int DFF = 2816, NGU = 2 * DFF, NINP = 3072, NIN = 2824, PLE = 256;
constexpr float EPS = 1e-6f;
constexpr int PAST = 16384;

constexpr size_t O_Y = 0;
constexpr size_t O_SGP = (size_t)M * DM;
constexpr size_t O_SCP = O_SGP + (size_t)NBP * 4 * 128 * 128;
constexpr size_t O_CKP = O_SCP + (size_t)NBP * 3 * 1536;
constexpr size_t O_CVP = O_CKP + (size_t)NBP * 128 * 128;
constexpr size_t O_SGS = O_CVP + (size_t)NBP * 128 * 128;
constexpr size_t O_SCS = O_SGS + (size_t)NBS * 4 * 128 * 128;
constexpr size_t O_CKS = O_SCS + (size_t)NBS * 3 * 1536;
constexpr size_t O_CVS = O_CKS + (size_t)NBS * 128 * 128;
constexpr size_t O_END = O_CVS + (size_t)NBS * 128 * 128;

constexpr size_t MiB = 1u << 20;
constexpr size_t WS_GU1 = 0, WS_D1 = 11 * MiB, WS_IN = 17 * MiB, WS_OUT = 23 * MiB, WS_GU2 = 25 * MiB, WS_D2 = 36 * MiB, WS_PG = 42 * MiB, WS_PPW = 44 * MiB;
constexpr size_t WS_HB = 48 * MiB;
constexpr size_t WS_QS = 48 * MiB, WS_KS = 81 * MiB, WS_VS = 90 * MiB;
constexpr size_t WS_ACT = 114 * MiB;
constexpr size_t WS_PROJ = 114 * MiB;
constexpr size_t WS_GQ = 312 * MiB, WS_GK = 345 * MiB, WS_GV = 378 * MiB;
constexpr size_t WS_PP = 312 * MiB;
constexpr size_t WS_MIX = 411 * MiB;
constexpr size_t WS_PB = 477 * MiB;
constexpr size_t WS_SS = 494 * MiB;
constexpr size_t WS_AB = 495 * MiB;
constexpr size_t WS_GD = 497 * MiB;
constexpr size_t WS_BT = 498 * MiB;
constexpr size_t WS_ROPE = 499 * MiB;
constexpr size_t WS_EGL = 499 * MiB + 512 * 1024;
constexpr size_t WS_END = 500 * MiB;

constexpr int LDS_BYTES = 131072 + 2048;

struct Args { const float* in[26]; float* out; unsigned char* ws; int ph_lo, ph_hi; };
typedef __attribute__((address_space(4))) const Args CArgs;
__device__ __forceinline__ CArgs* get_args() {
    unsigned long long p = (unsigned long long)__builtin_amdgcn_kernarg_segment_ptr();
    unsigned l = (unsigned)p, h = (unsigned)(p >> 32);
    asm volatile("" : "+s"(l), "+s"(h));
    l = __builtin_amdgcn_readfirstlane(l); h = __builtin_amdgcn_readfirstlane(h);
    return (CArgs*)(((unsigned long long)h << 32) | l);
}


__device__ __forceinline__ float bf2f(unsigned b) { return __uint_as_float(b << 16); }
__device__ __forceinline__ float wave_sum(float v) {
#pragma unroll
    for (int o = 1; o < 64; o <<= 1) v += __shfl_xor(v, o);
    return v;
}
__device__ __forceinline__ float wave_max(float v) {
#pragma unroll
    for (int o = 1; o < 64; o <<= 1) v = fmaxf(v, __shfl_xor(v, o));
    return v;
}
template <int CTRL> __device__ __forceinline__ float dppf(float v) { return __int_as_float(__builtin_amdgcn_update_dpp(0, __float_as_int(v), CTRL, 0xf, 0xf, true)); }
__device__ __forceinline__ float reduce16(float v) {
    v += dppf<0xB1>(v); v += dppf<0x4E>(v); v += dppf<0x141>(v); v += dppf<0x140>(v); return v;
}
__device__ __forceinline__ void unpack8(const u32x4 r, float* x) {
    x[0] = bf2f(r.x & 0xffffu); x[1] = bf2f(r.x >> 16); x[2] = bf2f(r.y & 0xffffu); x[3] = bf2f(r.y >> 16);
    x[4] = bf2f(r.z & 0xffffu); x[5] = bf2f(r.z >> 16); x[6] = bf2f(r.w & 0xffffu); x[7] = bf2f(r.w >> 16);
}
__device__ __forceinline__ u32x4 pack8(const float* x) {
    u32x4 w; w.x = cvt_pk_bf16(x[0], x[1]); w.y = cvt_pk_bf16(x[2], x[3]); w.z = cvt_pk_bf16(x[4], x[5]); w.w = cvt_pk_bf16(x[6], x[7]); return w;
}
__device__ __forceinline__ float sigmoidf_(float x) { return 1.f / (1.f + __expf(-x)); }
#define LDS_WAIT() asm volatile("s_waitcnt lgkmcnt(0)" ::: "memory")

struct EpiSwiglu {
    static constexpr bool PERM = true, AFTER_DRAIN = false;
    bf16_t* O; const float* ss;
    __device__ __forceinline__ void operator()(const f32x4 (&acc)[2][2][4][2], const pg8::Unit& u, int wr, int wc, int fr, int fq) const {
        const int col0 = u.pn * 128 + wc * 32 + 8 * fq;
#pragma unroll
        for (int ai = 0; ai < 2; ++ai)
#pragma unroll
            for (int m = 0; m < 4; ++m) {
                const int row = u.pm * 256 + ai * 128 + wr * 64 + m * 16 + fr;
                const float rs = rsqrtf(ss[row] * (1.f / DM) + EPS);
                float a[8];
#pragma unroll
                for (int n = 0; n < 2; ++n)
#pragma unroll
                    for (int j = 0; j < 4; ++j) { const float g = acc[ai][0][m][n][j] * rs, up = acc[ai][1][m][n][j] * rs; a[4 * n + j] = g * sigmoidf_(g) * up; }
                *(u32x4*)(O + (size_t)row * DFF + col0) = pack8(a);
            }
    }
};
struct EpiProj {
    static constexpr bool PERM = true, AFTER_DRAIN = false;
    bf16_t* O; const float* ss; float* AB;
    __device__ __forceinline__ void operator()(const f32x4 (&acc)[2][2][4][2], const pg8::Unit& u, int wr, int wc, int fr, int fq) const {
#pragma unroll
        for (int ai = 0; ai < 2; ++ai)
#pragma unroll
            for (int m = 0; m < 4; ++m) {
                const int row = u.pm * 256 + ai * 128 + wr * 64 + m * 16 + fr;
                const float rs = rsqrtf(ss[row] * (1.f / DM) + EPS);
#pragma unroll
                for (int bj = 0; bj < 2; ++bj) {
                    float a[8];
#pragma unroll
                    for (int n = 0; n < 2; ++n)
#pragma unroll
                        for (int j = 0; j < 4; ++j) a[4 * n + j] = acc[ai][bj][m][n][j] * rs;
                    *(u32x4*)(O + (size_t)row * NINP + u.pn * 256 + bj * 128 + wc * 32 + 8 * fq) = pack8(a);
                    if (bj == 0 && u.pn == 11 && wc == 0 && fq == 0) {
                        *(f32x4*)(AB + (size_t)row * 8) = (f32x4){a[0], a[1], a[2], a[3]};
                        *(f32x4*)(AB + (size_t)row * 8 + 4) = (f32x4){a[4], a[5], a[6], a[7]};
                    }
                }
            }
    }
};
struct EpiPlain {
    static constexpr bool PERM = true, AFTER_DRAIN = false;
    bf16_t* O;
    __device__ __forceinline__ void operator()(const f32x4 (&acc)[2][2][4][2], const pg8::Unit& u, int wr, int wc, int fr, int fq) const {
#pragma unroll
        for (int ai = 0; ai < 2; ++ai)
#pragma unroll
            for (int m = 0; m < 4; ++m) {
                const int row = u.pm * 256 + ai * 128 + wr * 64 + m * 16 + fr;
#pragma unroll
                for (int bj = 0; bj < 2; ++bj) {
                    float a[8];
#pragma unroll
                    for (int n = 0; n < 2; ++n)
#pragma unroll
                        for (int j = 0; j < 4; ++j) a[4 * n + j] = acc[ai][bj][m][n][j];
                    *(u32x4*)(O + (size_t)row * DM + u.pn * 256 + bj * 128 + wc * 32 + 8 * fq) = pack8(a);
                }
            }
    }
};
struct EpiResid {
    static constexpr bool PERM = false, AFTER_DRAIN = false;
    const float* base0; const float* base1; float* out; bf16_t* outb; float* ss; float alpha;
    __device__ __forceinline__ void operator()(const f32x4 (&acc)[2][2][4][2], const pg8::Unit& u, int wr, int wc, int fr, int fq) const {
#pragma unroll
        for (int ai = 0; ai < 2; ++ai)
#pragma unroll
            for (int m = 0; m < 4; ++m) {
                const int row = u.pm * 256 + ai * 128 + wr * 64 + m * 16 + fr;
                const float* bp = row < MP ? base0 + (size_t)row * DM : base1 + (size_t)(row - MP) * DM;
                float sq = 0.f;
#pragma unroll
                for (int bj = 0; bj < 2; ++bj)
#pragma unroll
                    for (int n = 0; n < 2; ++n) {
                        const int c = u.pn * 256 + bj * 128 + wc * 32 + n * 16 + 4 * fq;
                        const f32x4 bv = *(const f32x4*)(bp + c);
                        const f32x4 v = bv + acc[ai][bj][m][n] * alpha;
                        *(f32x4*)(out + (size_t)row * DM + c) = v;
                        u32x2 w; w.x = cvt_pk_bf16(v[0], v[1]); w.y = cvt_pk_bf16(v[2], v[3]);
                        *(u32x2*)(outb + (size_t)row * DM + c) = w;
                        sq += (v[0] * v[0] + v[1] * v[1]) + (v[2] * v[2] + v[3] * v[3]);
                    }
                sq += __shfl_xor(sq, 16); sq += __shfl_xor(sq, 32);
                if (fq == 0) unsafeAtomicAdd(ss + row, sq);
                asm volatile("" ::: "memory");
            }
    }
};
struct EpiGate {
    static constexpr bool PERM = false, AFTER_DRAIN = false;
    float* h; const bf16_t* pp; const float* ss; float* ss2;
    __device__ __forceinline__ void operator()(const f32x4 (&acc)[2][2][4][2], const pg8::Unit& u, int wr, int wc, int fr, int fq) const {
#pragma unroll
        for (int ai = 0; ai < 2; ++ai)
#pragma unroll
            for (int m = 0; m < 4; ++m) {
                const int row = u.pm * 256 + ai * 128 + wr * 64 + m * 16 + fr;
                const float rs = rsqrtf(ss[row] * (1.f / DM) + EPS);
                float sq = 0.f;
#pragma unroll
                for (int bj = 0; bj < 2; ++bj)
#pragma unroll
                    for (int n = 0; n < 2; ++n) {
                        const int c = u.pn * 256 + bj * 128 + wc * 32 + n * 16 + 4 * fq;
                        const f32x4 hv = *(const f32x4*)(h + (size_t)row * DM + c);
                        const u32x2 pw = *(const u32x2*)(pp + (size_t)row * DM + c);
                        f32x4 v;
                        v[0] = hv[0] + sigmoidf_(acc[ai][bj][m][n][0] * rs) * bf2f(pw.x & 0xffffu);
                        v[1] = hv[1] + sigmoidf_(acc[ai][bj][m][n][1] * rs) * bf2f(pw.x >> 16);
                        v[2] = hv[2] + sigmoidf_(acc[ai][bj][m][n][2] * rs) * bf2f(pw.y & 0xffffu);
                        v[3] = hv[3] + sigmoidf_(acc[ai][bj][m][n][3] * rs) * bf2f(pw.y >> 16);
                        *(f32x4*)(h + (size_t)row * DM + c) = v;
                        sq += (v[0] * v[0] + v[1] * v[1]) + (v[2] * v[2] + v[3] * v[3]);
                    }
                sq += __shfl_xor(sq, 16); sq += __shfl_xor(sq, 32);
                if (fq == 0) unsafeAtomicAdd(ss2 + row, sq);
                asm volatile("" ::: "memory");
            }
    }
};

__device__ __forceinline__ int map_row(int mode, int n) {
    if (mode == 1) { if (n < DFF) return 256 * (n >> 7) + (n & 127); n -= DFF; return 256 * (n >> 7) + 128 + (n & 127); }
    if (mode == 2) { if (n < 2048) return n; if (n < 2052) return 2816 + (n - 2048); if (n < 2056) return 2820 + (n - 2052); return n - 8; }
    return n;
}
__device__ __forceinline__ void p0_transpose_item(const float* W, int K, int N, const float* gain, bf16_t* WT, int mode, LAS float* scr, int item, int lane) {
    const int nblk = (N + 31) / 32, kb = item / nblk, nb = item % nblk, k0 = 64 * kb, n0 = 32 * nb;
#pragma unroll 8
    for (int i = 0; i < 32; ++i) {
        const int kk = 2 * i + (lane >> 5), n = n0 + (lane & 31);
        float v = 0.f;
        if (n < N) { v = W[(size_t)(k0 + kk) * N + n]; if (gain) v *= gain[k0 + kk]; }
        scr[kk * 33 + (lane & 31)] = v;
    }
    LDS_WAIT();
    const int c = lane & 7;
#pragma unroll
    for (int j = 0; j < 4; ++j) {
        const int n = (lane >> 3) + 8 * j;
        if (n0 + n < N) {
            const LAS float* s = scr + (8 * c) * 33 + n;
            u32x4 o; o.x = cvt_pk_bf16(s[0 * 33], s[1 * 33]); o.y = cvt_pk_bf16(s[2 * 33], s[3 * 33]); o.z = cvt_pk_bf16(s[4 * 33], s[5 * 33]); o.w = cvt_pk_bf16(s[6 * 33], s[7 * 33]);
            *(u32x4*)(WT + (size_t)map_row(mode, n0 + n) * K + k0 + 8 * c) = o;
        }
    }
    LDS_WAIT();
}

__device__ __forceinline__ void p0_prologue(CArgs* a, LAS unsigned char* L) {
    const int tid = threadIdx.x, lane = tid & 63, wave = tid >> 6;
    unsigned char* ws = a->ws;
    LAS float* scr = (LAS float*)(L + wave * 16384);
    const int gw = blockIdx.x * 8 + wave, NGW = gridDim.x * 8;
    constexpr int I_GU = 16 * 176, I_D = 44 * 32, I_IN = 16 * 89, I_SQ = 16 * 32, I_PP = 4 * 32;
    constexpr int NITEMS = 2 * I_GU + 2 * I_D + I_IN + 2 * I_SQ + I_PP;
    for (int it = gw; it < NITEMS; it += NGW) {
        int r = it;
        if (r < I_GU) { p0_transpose_item(a->in[9], DM, NGU, a->in[8], (bf16_t*)(ws + WS_GU1), 1, scr, r, lane); continue; } r -= I_GU;
        if (r < I_GU) { p0_transpose_item(a->in[20], DM, NGU, a->in[19], (bf16_t*)(ws + WS_GU2), 1, scr, r, lane); continue; } r -= I_GU;
        if (r < I_D) { p0_transpose_item(a->in[10], DFF, DM, nullptr, (bf16_t*)(ws + WS_D1), 0, scr, r, lane); continue; } r -= I_D;
        if (r < I_D) { p0_transpose_item(a->in[21], DFF, DM, nullptr, (bf16_t*)(ws + WS_D2), 0, scr, r, lane); continue; } r -= I_D;
        if (r < I_IN) { p0_transpose_item(a->in[12], DM, NIN, a->in[11], (bf16_t*)(ws + WS_IN), 2, scr, r, lane); continue; } r -= I_IN;
        if (r < I_SQ) { p0_transpose_item(a->in[18], DM, DM, nullptr, (bf16_t*)(ws + WS_OUT), 0, scr, r, lane); continue; } r -= I_SQ;
        if (r < I_SQ) { p0_transpose_item(a->in[24], DM, DM, a->in[22], (bf16_t*)(ws + WS_PG), 0, scr, r, lane); continue; } r -= I_SQ;
        p0_transpose_item(a->in[23], PLE, DM, nullptr, (bf16_t*)(ws + WS_PPW), 0, scr, r, lane);
    }
    {
        u32x4* z = (u32x4*)(ws + WS_IN + (size_t)NIN * DM * 2);
        const int nz = (NINP - NIN) * DM * 2 / 16;
        for (int i = blockIdx.x * 512 + tid; i < nz; i += gridDim.x * 512) z[i] = (u32x4){0u, 0u, 0u, 0u};
    }
    bf16_t* HB = (bf16_t*)(ws + WS_HB); bf16_t* PB = (bf16_t*)(ws + WS_PB); float* SS = (float*)(ws + WS_SS);
    for (int m = gw; m < M; m += NGW) {
        const float* xr = m < MP ? a->in[0] + (size_t)m * DM : a->in[1] + (size_t)(m - MP) * DM;
        float s = 0.f;
#pragma unroll
        for (int j = 0; j < 4; ++j) {
            const f32x4 v = ((const f32x4*)xr)[lane + 64 * j];
            s += (v[0] * v[0] + v[1] * v[1]) + (v[2] * v[2] + v[3] * v[3]);
            u32x2 w; w.x = cvt_pk_bf16(v[0], v[1]); w.y = cvt_pk_bf16(v[2], v[3]);
            ((u32x2*)(HB + (size_t)m * DM))[lane + 64 * j] = w;
        }
        s = wave_sum(s);
        if (lane == 0) SS[m] = s;
        const float* pr = m < MP ? a->in[6] + (size_t)m * PLE : a->in[7] + (size_t)(m - MP) * PLE;
        const f32x4 pv = ((const f32x4*)pr)[lane];
        u32x2 w; w.x = cvt_pk_bf16(pv[0], pv[1]); w.y = cvt_pk_bf16(pv[2], pv[3]);
        ((u32x2*)(PB + (size_t)m * PLE))[lane] = w;
    }
    for (int i = blockIdx.x * 512 + tid; i < 4 * M; i += gridDim.x * 512) SS[M + i] = 0.f;
    float* RT = (float*)(ws + WS_ROPE);
    for (int i = blockIdx.x * 512 + tid; i < 2056 * 8; i += gridDim.x * 512) {
        const int idx = i >> 3, f = i & 7;
        const int pos = idx < 2048 ? idx : PAST + (idx - 2048);
        const float inv = powf(500000.0f, -(float)f * 0.125f);
        const float ang = (float)pos * inv;
        const double rev = (double)ang * 0.15915494309189535;
        const float fr = (float)(rev - rint(rev));
        RT[idx * 16 + f] = __builtin_amdgcn_cosf(fr);
        RT[idx * 16 + 8 + f] = __builtin_amdgcn_sinf(fr);
    }
}

__device__ __forceinline__ void p4_mixprep(CArgs* a) {
    const int tid = threadIdx.x, lane = tid & 63, wave = tid >> 6;
    unsigned char* ws = a->ws;
    const bf16_t* PROJ = (const bf16_t*)(ws + WS_PROJ);
    bf16_t* GQ = (bf16_t*)(ws + WS_GQ); bf16_t* GK = (bf16_t*)(ws + WS_GK); bf16_t* GV = (bf16_t*)(ws + WS_GV);
    bf16_t* QS = (bf16_t*)(ws + WS_QS); bf16_t* KS = (bf16_t*)(ws + WS_KS); bf16_t* VS = (bf16_t*)(ws + WS_VS);
    const float* AB = (const float*)(ws + WS_AB); float* GD = (float*)(ws + WS_GD); float* BT = (float*)(ws + WS_BT);
    const float* RT = (const float*)(ws + WS_ROPE);
    const float* state_conv = a->in[3]; const float* conv_w = a->in[13];
    const int gw = blockIdx.x * 8 + wave, NGW = gridDim.x * 8;
    for (int r = gw; r < M; r += NGW) {
        const bool samp = r >= MP;
        int b, t;
        if (!samp) { b = r >> 11; t = r & 2047; } else { b = (r - MP) >> 3; t = (r - MP) & 7; }
        const int T = samp ? TS : TP;
        const bf16_t* prow = PROJ + (size_t)r * NINP;
#pragma unroll
        for (int j = 0; j < 3; ++j) {
            const int ch = j * 512 + lane * 8;
            float acc[8], cur[8];
#pragma unroll
            for (int i = 0; i < 8; ++i) acc[i] = 0.f;
#pragma unroll
            for (int tap = 0; tap < 4; ++tap) {
                const int tt = t - 3 + tap;
                float x[8];
                if (tt >= 0) { const u32x4 raw = *(const u32x4*)(prow - (ptrdiff_t)(3 - tap) * NINP + ch); unpack8(raw, x); }
                else if (samp) {
                    const float* sc = state_conv + ((size_t)b * 3 + (3 + tt)) * 1536 + ch;
                    const f32x4 s0 = *(const f32x4*)sc, s1 = *(const f32x4*)(sc + 4);
                    x[0] = s0[0]; x[1] = s0[1]; x[2] = s0[2]; x[3] = s0[3]; x[4] = s1[0]; x[5] = s1[1]; x[6] = s1[2]; x[7] = s1[3];
                } else {
#pragma unroll
                    for (int i = 0; i < 8; ++i) x[i] = 0.f;
                }
                const f32x4 w0 = *(const f32x4*)(conv_w + tap * 1536 + ch), w1 = *(const f32x4*)(conv_w + tap * 1536 + ch + 4);
                acc[0] += x[0] * w0[0]; acc[1] += x[1] * w0[1]; acc[2] += x[2] * w0[2]; acc[3] += x[3] * w0[3];
                acc[4] += x[4] * w1[0]; acc[5] += x[5] * w1[1]; acc[6] += x[6] * w1[2]; acc[7] += x[7] * w1[3];
                if (tap == 3) {
#pragma unroll
                    for (int i = 0; i < 8; ++i) cur[i] = x[i];
                }
            }
            float ssq = 0.f;
#pragma unroll
            for (int i = 0; i < 8; ++i) { acc[i] = acc[i] * sigmoidf_(acc[i]); ssq += acc[i] * acc[i]; }
            if (j < 2) {
                ssq += __shfl_xor(ssq, 1); ssq += __shfl_xor(ssq, 2); ssq += __shfl_xor(ssq, 4); ssq += __shfl_xor(ssq, 8);
                const float sc = rsqrtf(ssq + 1e-6f) * (j == 0 ? 0.08838834764831845f : 1.0f);
#pragma unroll
                for (int i = 0; i < 8; ++i) acc[i] *= sc;
            }
            bf16_t* dst = (j == 0 ? GQ : (j == 1 ? GK : GV)) + (size_t)r * 512 + lane * 8;
            *(u32x4*)dst = pack8(acc);
            if (t >= T - 3) {
                float* so = a->out + (samp ? O_SCS : O_SCP) + ((size_t)b * 3 + (t - (T - 3))) * 1536 + ch;
                *(f32x4*)so = (f32x4){cur[0], cur[1], cur[2], cur[3]};
                *(f32x4*)(so + 4) = (f32x4){cur[4], cur[5], cur[6], cur[7]};
            }
        }
        if (lane < 4) {
            const float av = AB[(size_t)r * 8 + lane], bv = AB[(size_t)r * 8 + 4 + lane];
            const float sp = av + a->in[15][lane];
            const float softplus = sp > 20.f ? sp : log1pf(expf(sp));
            GD[(size_t)r * 4 + lane] = -expf(a->in[14][lane]) * softplus;
            BT[(size_t)r * 4 + lane] = 1.f / (1.f + expf(-bv));
        }
        const float* rt = RT + (size_t)(samp ? 2048 + t : t) * 16;
        float cs[8], sn[8];
        {
            const f32x4 c0 = *(const f32x4*)rt, c1 = *(const f32x4*)(rt + 4), s0 = *(const f32x4*)(rt + 8), s1 = *(const f32x4*)(rt + 12);
            cs[0] = c0[0]; cs[1] = c0[1]; cs[2] = c0[2]; cs[3] = c0[3]; cs[4] = c1[0]; cs[5] = c1[1]; cs[6] = c1[2]; cs[7] = c1[3];
            sn[0] = s0[0]; sn[1] = s0[1]; sn[2] = s0[2]; sn[3] = s0[3]; sn[4] = s1[0]; sn[5] = s1[1]; sn[6] = s1[2]; sn[7] = s1[3];
        }
        {
            float x[8], o[8];
            unpack8(*(const u32x4*)(prow + 2048 + lane * 8), x);
#pragma unroll
            for (int i = 0; i < 8; ++i) o[i] = __shfl_xor(x[i], 1);
            const int l8 = lane & 7;
            if (l8 == 0) {
#pragma unroll
                for (int i = 0; i < 8; ++i) x[i] = x[i] * cs[i] - o[i] * sn[i];
            } else if (l8 == 1) {
#pragma unroll
                for (int i = 0; i < 8; ++i) x[i] = x[i] * cs[i] + o[i] * sn[i];
            }
#pragma unroll
            for (int i = 0; i < 8; ++i) x[i] *= 0.125f;
            *(u32x4*)(QS + (size_t)r * 512 + lane * 8) = pack8(x);
        }
        {
            const int kl = lane & 15;
            float x[8], o[8];
            unpack8(*(const u32x4*)(prow + 2560 + kl * 8), x);
#pragma unroll
            for (int i = 0; i < 8; ++i) o[i] = __shfl_xor(x[i], 1);
            const int l8 = kl & 7;
            if (l8 == 0) {
#pragma unroll
                for (int i = 0; i < 8; ++i) x[i] = x[i] * cs[i] - o[i] * sn[i];
            } else if (l8 == 1) {
#pragma unroll
                for (int i = 0; i < 8; ++i) x[i] = x[i] * cs[i] + o[i] * sn[i];
            }
            const u32x4 vraw = *(const u32x4*)(prow + 2688 + kl * 8);
            if (lane < 16) {
                *(u32x4*)(KS + (size_t)r * 128 + kl * 8) = pack8(x);
                *(u32x4*)(VS + (size_t)r * 128 + kl * 8) = vraw;
                const int crow = samp ? 120 + t : t - (TP - 128);
                if (crow >= 0) {
                    float v[8]; unpack8(vraw, v);
                    float* ck = a->out + (samp ? O_CKS : O_CKP) + ((size_t)b * 128 + crow) * 128 + kl * 8;
                    float* cv = a->out + (samp ? O_CVS : O_CVP) + ((size_t)b * 128 + crow) * 128 + kl * 8;
                    *(f32x4*)ck = (f32x4){x[0], x[1], x[2], x[3]}; *(f32x4*)(ck + 4) = (f32x4){x[4], x[5], x[6], x[7]};
                    *(f32x4*)cv = (f32x4){v[0], v[1], v[2], v[3]}; *(f32x4*)(cv + 4) = (f32x4){v[4], v[5], v[6], v[7]};
                }
            }
        }
        if (samp) {
            for (int e = lane; e < 15 * 32; e += 64) {
                const int j = t * 15 + (e >> 5), c4 = (e & 31) * 4;
                const size_t d = ((size_t)b * 128 + j) * 128 + c4, s = ((size_t)b * 128 + j + 8) * 128 + c4;
                *(f32x4*)(a->out + O_CKS + d) = *(const f32x4*)(a->in[4] + s);
                *(f32x4*)(a->out + O_CVS + d) = *(const f32x4*)(a->in[5] + s);
            }
        }
    }
}

__device__ __forceinline__ void gdn_item(CArgs* a, LAS unsigned char* L, int item, bool samp) {
    const int tid = threadIdx.x;
    unsigned char* ws = a->ws;
    const bf16_t* GQ = (const bf16_t*)(ws + WS_GQ); const bf16_t* GK = (const bf16_t*)(ws + WS_GK); const bf16_t* GV = (const bf16_t*)(ws + WS_GV);
    const float* GD = (const float*)(ws + WS_GD); const float* BT = (const float*)(ws + WS_BT);
    unsigned char* PROJb = ws + WS_PROJ;
    const int b = item >> 4, h = (item >> 2) & 3, qd = item & 3;
    const int row0 = samp ? MP + b * TS : b * TP, T = samp ? TS : TP;
    const float* S0 = samp ? a->in[2] + (size_t)(b * 4 + h) * 16384 : nullptr;
    float* Sout = a->out + (samp ? O_SGS : O_SGP) + (size_t)(b * 4 + h) * 16384;
    const int cl = tid >> 4, part = tid & 15;
    LAS float* kb = (LAS float*)L;
    LAS float* qb = kb + 32 * 128;
    LAS float* vb = qb + 32 * 128;
    LAS float* ob = vb + 32 * 32;
    LAS float* eg = ob + 32 * 32;
    LAS float* bt = eg + 32;
    LAS float* sb = bt + 32;
    __syncthreads();
    float S[8];
    if (S0) {
        const int dk = tid >> 2, c8 = (tid & 3) * 8;
        const f32x4 s0 = *(const f32x4*)(S0 + (size_t)dk * 128 + qd * 32 + c8), s1 = *(const f32x4*)(S0 + (size_t)dk * 128 + qd * 32 + c8 + 4);
#pragma unroll
        for (int i = 0; i < 4; ++i) { sb[dk * 33 + c8 + i] = s0[i]; sb[dk * 33 + c8 + 4 + i] = s1[i]; }
        __syncthreads();
#pragma unroll
        for (int i = 0; i < 8; ++i) S[i] = sb[(part * 8 + i) * 33 + cl];
    } else {
#pragma unroll
        for (int i = 0; i < 8; ++i) S[i] = 0.f;
    }
    const int TB = T < 32 ? T : 32;
    const int ptok = tid >> 4, pch = (tid & 15) * 8;
    const int vtok = tid >> 2, vch = (tid & 3) * 8;
    const bool pk_ok = ptok < TB, pv_ok = vtok < TB && tid < 128, pe_ok = tid < TB;
    u32x4 rk = {0u, 0u, 0u, 0u}, rq = {0u, 0u, 0u, 0u}, rv = {0u, 0u, 0u, 0u}; float re = 0.f, rb = 0.f;
#define GDN_PREFETCH(t0) do { \
        if (pk_ok) { const size_t o_ = (size_t)(row0 + (t0) + ptok) * 512 + h * 128 + pch; rk = *(const u32x4*)(GK + o_); rq = *(const u32x4*)(GQ + o_); } \
        if (pv_ok) { rv = *(const u32x4*)(GV + (size_t)(row0 + (t0) + vtok) * 512 + h * 128 + qd * 32 + vch); } \
        if (pe_ok) { re = GD[(size_t)(row0 + (t0) + tid) * 4 + h]; rb = BT[(size_t)(row0 + (t0) + tid) * 4 + h]; } } while (0)
    GDN_PREFETCH(0);
    for (int t0 = 0; t0 < T; t0 += TB) {
        if (pk_ok) {
            float x[8];
            unpack8(rk, x); *(LAS f32x4*)(kb + ptok * 128 + pch) = (f32x4){x[0], x[1], x[2], x[3]}; *(LAS f32x4*)(kb + ptok * 128 + pch + 4) = (f32x4){x[4], x[5], x[6], x[7]};
            unpack8(rq, x); *(LAS f32x4*)(qb + ptok * 128 + pch) = (f32x4){x[0], x[1], x[2], x[3]}; *(LAS f32x4*)(qb + ptok * 128 + pch + 4) = (f32x4){x[4], x[5], x[6], x[7]};
        }
        if (pv_ok) { float x[8]; unpack8(rv, x); *(LAS f32x4*)(vb + vtok * 32 + vch) = (f32x4){x[0], x[1], x[2], x[3]}; *(LAS f32x4*)(vb + vtok * 32 + vch + 4) = (f32x4){x[4], x[5], x[6], x[7]}; }
        if (pe_ok) { eg[tid] = __expf(re); bt[tid] = rb; }
        __syncthreads();
        if (t0 + TB < T) GDN_PREFETCH(t0 + TB);
        for (int tok = 0; tok < TB; ++tok) {
            const f32x4 k0 = *(const LAS f32x4*)(kb + tok * 128 + part * 8), k1 = *(const LAS f32x4*)(kb + tok * 128 + part * 8 + 4);
            const f32x4 q0 = *(const LAS f32x4*)(qb + tok * 128 + part * 8), q1 = *(const LAS f32x4*)(qb + tok * 128 + part * 8 + 4);
            const float v = vb[tok * 32 + cl], e = eg[tok], be = bt[tok];
            float ks = ((k0[0] * S[0] + k0[1] * S[1]) + (k0[2] * S[2] + k0[3] * S[3])) + ((k1[0] * S[4] + k1[1] * S[5]) + (k1[2] * S[6] + k1[3] * S[7]));
            ks = reduce16(ks);
            const float vn = be * (v - e * ks);
            S[0] = e * S[0] + k0[0] * vn; S[1] = e * S[1] + k0[1] * vn; S[2] = e * S[2] + k0[2] * vn; S[3] = e * S[3] + k0[3] * vn;
            S[4] = e * S[4] + k1[0] * vn; S[5] = e * S[5] + k1[1] * vn; S[6] = e * S[6] + k1[2] * vn; S[7] = e * S[7] + k1[3] * vn;
            float o = ((q0[0] * S[0] + q0[1] * S[1]) + (q0[2] * S[2] + q0[3] * S[3])) + ((q1[0] * S[4] + q1[1] * S[5]) + (q1[2] * S[6] + q1[3] * S[7]));
            o = reduce16(o);
            if (part == 0) ob[tok * 32 + cl] = o;
        }
        __syncthreads();
        if (tid < 256) {
            const int tok = tid >> 3, c4 = (tid & 7) * 4;
            if (tok < TB) {
                float* og = (float*)(PROJb + (size_t)(row0 + t0 + tok) * (NINP * 2));
                *(f32x4*)(og + h * 128 + qd * 32 + c4) = *(const LAS f32x4*)(ob + tok * 32 + c4);
            }
        }
    }
#undef GDN_PREFETCH
    __syncthreads();
#pragma unroll
    for (int i = 0; i < 8; ++i) sb[(part * 8 + i) * 33 + cl] = S[i];
    __syncthreads();
    {
        const int dk = tid >> 2, c8 = (tid & 3) * 8;
        f32x4 s0, s1;
#pragma unroll
        for (int i = 0; i < 4; ++i) { s0[i] = sb[dk * 33 + c8 + i]; s1[i] = sb[dk * 33 + c8 + 4 + i]; }
        *(f32x4*)(Sout + (size_t)dk * 128 + qd * 32 + c8) = s0; *(f32x4*)(Sout + (size_t)dk * 128 + qd * 32 + c8 + 4) = s1;
    }
}

typedef short bf16x8 __attribute__((ext_vector_type(8)));
#define MFMA16(a_, b_, c_) __builtin_amdgcn_mfma_f32_16x16x32_bf16(a_, b_, c_, 0, 0, 0)
__device__ __forceinline__ void gdn_chunk_prep(CArgs* a, LAS unsigned char* L, int pair) {
    const int tid = threadIdx.x, hb = tid >> 8, t2 = tid & 255, w = t2 >> 6, lane = tid & 63, fr = lane & 15, fq = lane >> 4;
    unsigned char* ws = a->ws;
    bf16_t* GQ = (bf16_t*)(ws + WS_GQ); bf16_t* GK = (bf16_t*)(ws + WS_GK); const bf16_t* GV = (const bf16_t*)(ws + WS_GV);
    const float* GD = (const float*)(ws + WS_GD); const float* BT = (const float*)(ws + WS_BT);
    unsigned char* PROJb = ws + WS_PROJ; float* EGL = (float*)(ws + WS_EGL);
    const int ci = pair * 2 + hb;
    const int b = ci >> 7, h = (ci >> 5) & 3, c = ci & 31;
    const int r0 = b * TP + c * 64;
    LAS unsigned char* Lh = L + hb * 66560;
    LAS float* gcs = (LAS float*)Lh;
    LAS float* bts = gcs + 64;
    LAS float* egc = bts + 64;
    LAS float* ekd = egc + 64;
    LAS float* Af = ekd + 64;
    LAS unsigned char* STG = Lh + 1024 + 16384;
    __syncthreads();
    if (w == 0) {
        float v = GD[(size_t)(r0 + lane) * 4 + h];
#pragma unroll
        for (int o = 1; o < 64; o <<= 1) { const float t = __shfl_up(v, o); if (lane >= o) v += t; }
        const float gl = __shfl(v, 63);
        gcs[lane] = v; bts[lane] = BT[(size_t)(r0 + lane) * 4 + h]; egc[lane] = __expf(v); ekd[lane] = __expf(gl - v);
    }
#pragma unroll 2
    for (int jj = 0; jj < 8; ++jj) {
        const int e = t2 + 256 * jj, row = e >> 5, ch = e & 31;
        const bf16_t* src = (ch < 16 ? GV : (const bf16_t*)GK) + (size_t)(r0 + row) * 512 + h * 128 + (ch & 15) * 8;
        *(LAS u32x4*)(STG + row * 512 + ch * 16) = *(const u32x4*)src;
    }
    __syncthreads();
    bf16x8 aK[4], aQ[4];
    {
        const size_t o_ = (size_t)(r0 + 16 * w + fr) * 512 + h * 128 + fq * 8;
#pragma unroll
        for (int ks = 0; ks < 4; ++ks) { aK[ks] = *(const bf16x8*)(GK + o_ + ks * 32); aQ[ks] = *(const bf16x8*)(GQ + o_ + ks * 32); }
    }
    f32x4 qkd[4];
#pragma unroll
    for (int n = 0; n < 4; ++n) {
        bf16x8 bK[4];
        const size_t o_ = (size_t)(r0 + 16 * n + fr) * 512 + h * 128 + fq * 8;
#pragma unroll
        for (int ks = 0; ks < 4; ++ks) bK[ks] = *(const bf16x8*)(GK + o_ + ks * 32);
        f32x4 kk = {0.f, 0.f, 0.f, 0.f}, qk = {0.f, 0.f, 0.f, 0.f};
#pragma unroll
        for (int ks = 0; ks < 4; ++ks) { kk = MFMA16(aK[ks], bK[ks], kk); qk = MFMA16(aQ[ks], bK[ks], qk); }
        const int j = 16 * n + fr; const float gj = gcs[j];
#pragma unroll
        for (int r = 0; r < 4; ++r) {
            const int i = 16 * w + 4 * fq + r;
            const float d = (i >= j) ? __expf(gcs[i] - gj) : 0.f;
            Af[i * 64 + j] = (i > j) ? bts[i] * kk[r] * d : 0.f;
            qkd[n][r] = qk[r] * d;
        }
    }
#pragma unroll 1
    for (int jj = 0; jj < 4; ++jj) {
        const int e = t2 + 256 * jj, tok = e >> 4, ch = (e & 15) * 8;
        float x[8]; unpack8(*(const u32x4*)(GQ + (size_t)(r0 + tok) * 512 + h * 128 + ch), x);
        const float sc = egc[tok];
#pragma unroll
        for (int i = 0; i < 8; ++i) x[i] *= sc;
        *(u32x4*)((bf16_t*)(PROJb + (size_t)(r0 + tok) * (NINP * 2)) + 2048 + h * 128 + ch) = pack8(x);
    }
    const bool isU = t2 < 128; const int col = t2 & 127;
    float cv[64], x[64];
#pragma unroll
    for (int i = 0; i < 64; ++i) cv[i] = bf2f(*(const LAS bf16_t*)(STG + i * 512 + t2 * 2));
    asm volatile("s_waitcnt vmcnt(0)" ::: "memory");
    __syncthreads();
#pragma unroll
    for (int n = 0; n < 4; ++n)
#pragma unroll
        for (int r = 0; r < 4; ++r) {
            const int i = 16 * w + 4 * fq + r, j = 16 * n + fr;
            GQ[(size_t)(r0 + (i >> 1)) * 512 + h * 128 + (i & 1) * 64 + j] = (bf16_t)(cvt_pk_bf16(qkd[n][r], 0.f) & 0xffffu);
        }
    if (!isU) {
        bf16_t* dst = GK + (size_t)(r0 + (col >> 1)) * 512 + h * 128 + (col & 1) * 64;
#pragma unroll
        for (int jj = 0; jj < 8; ++jj) {
            float y[8];
#pragma unroll
            for (int i = 0; i < 8; ++i) y[i] = cv[8 * jj + i] * ekd[8 * jj + i];
            *(u32x4*)(dst + 8 * jj) = pack8(y);
        }
    }
    {
        const float um = isU ? 1.f : 0.f, km = 1.f - um;
#pragma unroll
        for (int i = 0; i < 64; ++i) x[i] = bts[i] * cv[i] * (um + km * egc[i]);
    }
    asm volatile("" ::: "memory");
#pragma unroll
    for (int i = 1; i < 64; ++i) {
        float s = x[i];
#pragma unroll
        for (int j = 0; j < i; ++j) s -= Af[i * 64 + j] * x[j];
        x[i] = s;
        asm volatile("" ::: "memory");
    }
    if (isU) {
#pragma unroll
        for (int i = 0; i < 64; ++i) *(LAS float*)(STG + (i * 128 + col) * 4) = x[i];
    } else {
#pragma unroll
        for (int i = 0; i < 64; ++i) *(LAS bf16_t*)(STG + 32768 + (i * 128 + col) * 2) = (bf16_t)(cvt_pk_bf16(x[i], 0.f) & 0xffffu);
    }
    __syncthreads();
#pragma unroll 1
    for (int jj = 0; jj < 8; ++jj) {
        const int e = t2 + 256 * jj, row = e >> 5, ch = e & 31;
        *(f32x4*)((float*)(PROJb + (size_t)(r0 + row) * (NINP * 2)) + h * 128 + ch * 4) = *(const LAS f32x4*)(STG + (row * 128 + ch * 4) * 4);
    }
#pragma unroll 1
    for (int jj = 0; jj < 4; ++jj) {
        const int e = t2 + 256 * jj, row = e >> 4, ch = e & 15;
        *(u32x4*)((bf16_t*)(PROJb + (size_t)(r0 + row) * (NINP * 2)) + 1024 + h * 128 + ch * 8) = *(const LAS u32x4*)(STG + 32768 + (row * 128 + ch * 8) * 2);
    }
    if (t2 == 0) EGL[ci] = egc[63];
}

__device__ __forceinline__ void gdn_chunk_scan(CArgs* a, LAS unsigned char* L, int item) {
    const int tid = threadIdx.x, w = __builtin_amdgcn_readfirstlane(tid >> 6), lane = tid & 63, fr = lane & 15, fq = lane >> 4;
    unsigned char* ws = a->ws;
    const bf16_t* GQ = (const bf16_t*)(ws + WS_GQ); const bf16_t* GK = (const bf16_t*)(ws + WS_GK);
    const unsigned char* PROJb = ws + WS_PROJ; const float* EGL = (const float*)(ws + WS_EGL); bf16_t* MIX = (bf16_t*)(ws + WS_MIX);
    const int b = item >> 2, h = item & 3;
    LAS unsigned char* St = L;
    LAS unsigned char* Vn = L + 128 * 272;
    LAS float* ssp = (LAS float*)(L + 128 * 272 + 128 * 144);
    f32x4 Sacc[8];
#pragma unroll
    for (int n = 0; n < 8; ++n) Sacc[n] = (f32x4){0.f, 0.f, 0.f, 0.f};
    const f32x4 gnv = *(const f32x4*)(a->in[16] + 16 * w + 4 * fq);
    __syncthreads();
    for (int c = 0; c < 32; ++c) {
        const int r0 = b * TP + c * 64;
        const float eg = EGL[(b * 4 + h) * 32 + c];
#pragma unroll
        for (int n8 = 0; n8 < 8; ++n8)
#pragma unroll
            for (int r = 0; r < 4; ++r) *(LAS bf16_t*)(St + (16 * w + 4 * fq + r) * 272 + (16 * n8 + fr) * 2) = (bf16_t)(cvt_pk_bf16(Sacc[n8][r], 0.f) & 0xffffu);
        LDS_WAIT();
        bf16x8 sA[4];
#pragma unroll
        for (int ks = 0; ks < 4; ++ks) sA[ks] = *(const LAS bf16x8*)(St + (16 * w + fr) * 272 + (ks * 32 + fq * 8) * 2);
        f32x4 vn[4], oa[4];
#pragma unroll
        for (int n = 0; n < 4; ++n) {
            const unsigned char* pr = PROJb + (size_t)(r0 + 16 * n + fr) * (NINP * 2);
            const bf16_t* wp = (const bf16_t*)pr + 1024 + h * 128 + fq * 8;
            const bf16_t* qp = (const bf16_t*)pr + 2048 + h * 128 + fq * 8;
            f32x4 acc = {0.f, 0.f, 0.f, 0.f}, o = {0.f, 0.f, 0.f, 0.f};
#pragma unroll
            for (int ks = 0; ks < 4; ++ks) { acc = MFMA16(sA[ks], *(const bf16x8*)(wp + ks * 32), acc); o = MFMA16(sA[ks], *(const bf16x8*)(qp + ks * 32), o); }
            const f32x4 u = *(const f32x4*)((const float*)pr + h * 128 + 16 * w + 4 * fq);
            vn[n] = u - acc; oa[n] = o;
        }
#pragma unroll
        for (int n = 0; n < 4; ++n)
#pragma unroll
            for (int r = 0; r < 4; ++r) *(LAS bf16_t*)(Vn + (16 * w + 4 * fq + r) * 144 + (16 * n + fr) * 2) = (bf16_t)(cvt_pk_bf16(vn[n][r], 0.f) & 0xffffu);
        LDS_WAIT();
        bf16x8 vA[2];
#pragma unroll
        for (int k2 = 0; k2 < 2; ++k2) vA[k2] = *(const LAS bf16x8*)(Vn + (16 * w + fr) * 144 + (k2 * 32 + fq * 8) * 2);
#pragma unroll
        for (int n = 0; n < 4; ++n) {
            const int i = 16 * n + fr;
            const bf16_t* qk = GQ + (size_t)(r0 + (i >> 1)) * 512 + h * 128 + (i & 1) * 64 + fq * 8;
#pragma unroll
            for (int k2 = 0; k2 < 2; ++k2) oa[n] = MFMA16(vA[k2], *(const bf16x8*)(qk + k2 * 32), oa[n]);
        }
#pragma unroll
        for (int n8 = 0; n8 < 8; ++n8) {
            const int dk = 16 * n8 + fr;
            const bf16_t* kd = GK + (size_t)(r0 + (dk >> 1)) * 512 + h * 128 + (dk & 1) * 64 + fq * 8;
            f32x4 sv = Sacc[n8] * eg;
#pragma unroll
            for (int k2 = 0; k2 < 2; ++k2) sv = MFMA16(vA[k2], *(const bf16x8*)(kd + k2 * 32), sv);
            Sacc[n8] = sv;
        }
        LAS float* sp = ssp + (c & 1) * 512;
#pragma unroll
        for (int n = 0; n < 4; ++n) {
            float q = (oa[n][0] * oa[n][0] + oa[n][1] * oa[n][1]) + (oa[n][2] * oa[n][2] + oa[n][3] * oa[n][3]);
            q += __shfl_xor(q, 16); q += __shfl_xor(q, 32);
            if (fq == 0) sp[w * 64 + 16 * n + fr] = q;
        }
        __syncthreads();
#pragma unroll
        for (int n = 0; n < 4; ++n) {
            const int tok = 16 * n + fr;
            float tot = 0.f;
#pragma unroll
            for (int ww = 0; ww < 8; ++ww) tot += sp[ww * 64 + tok];
            const float rs = rsqrtf(tot * (1.f / 128.f) + EPS);
            const unsigned char* pr = PROJb + (size_t)(r0 + tok) * (NINP * 2);
            const u32x2 zr = *(const u32x2*)((const bf16_t*)pr + 1536 + h * 128 + 16 * w + 4 * fq);
            const float z0 = bf2f(zr.x & 0xffffu), z1 = bf2f(zr.x >> 16), z2 = bf2f(zr.y & 0xffffu), z3 = bf2f(zr.y >> 16);
            u32x2 ow;
            ow.x = cvt_pk_bf16(oa[n][0] * rs * gnv[0] * (z0 * sigmoidf_(z0)), oa[n][1] * rs * gnv[1] * (z1 * sigmoidf_(z1)));
            ow.y = cvt_pk_bf16(oa[n][2] * rs * gnv[2] * (z2 * sigmoidf_(z2)), oa[n][3] * rs * gnv[3] * (z3 * sigmoidf_(z3)));
            *(u32x2*)(MIX + (size_t)(r0 + tok) * 1024 + h * 128 + 16 * w + 4 * fq) = ow;
        }
    }
    float* Sout = a->out + O_SGP + (size_t)(b * 4 + h) * 16384;
#pragma unroll
    for (int n8 = 0; n8 < 8; ++n8) *(f32x4*)(Sout + (size_t)(16 * n8 + fr) * 128 + 16 * w + 4 * fq) = Sacc[n8];
}

__device__ __forceinline__ void swa_item(CArgs* a, LAS unsigned char* L, int it) {
    const int tid = threadIdx.x, lane = tid & 63, wave = tid >> 6;
    unsigned char* ws = a->ws;
    const bf16_t* QS = (const bf16_t*)(ws + WS_QS); const bf16_t* KS = (const bf16_t*)(ws + WS_KS); const bf16_t* VS = (const bf16_t*)(ws + WS_VS);
    bf16_t* MIX = (bf16_t*)(ws + WS_MIX);
    const bool samp = it >= 2048;
    int b, kvh, tq0, nq, row0;
    if (!samp) { b = it >> 7; const int rem = it & 127; kvh = rem & 1; tq0 = (rem >> 1) * 32; nq = 32; row0 = b * TP; }
    else { const int i2 = it - 2048; b = i2 >> 1; kvh = i2 & 1; tq0 = 0; nq = TS; row0 = MP + b * TS; }
    const int nrows = 127 + nq;
    LAS float* Kf = (LAS float*)L;
    LAS float* Vf = Kf + 159 * 68;
    LAS float* Qw = Vf + 159 * 68;
    LAS float* Pw = Qw + 8 * 256;
    __syncthreads();
    for (int e = tid; e < nrows * 8; e += 512) {
        const int j = e >> 3, d8 = (e & 7) * 8, p = tq0 - 127 + j;
        float kx[8], vx[8];
        if (p >= 0) {
            const size_t o_ = (size_t)(row0 + p) * 128 + kvh * 64 + d8;
            unpack8(*(const u32x4*)(KS + o_), kx); unpack8(*(const u32x4*)(VS + o_), vx);
        } else if (samp) {
            const size_t o_ = ((size_t)b * 128 + (128 + p)) * 128 + kvh * 64 + d8;
            const f32x4 k0 = *(const f32x4*)(a->in[4] + o_), k1 = *(const f32x4*)(a->in[4] + o_ + 4), v0 = *(const f32x4*)(a->in[5] + o_), v1 = *(const f32x4*)(a->in[5] + o_ + 4);
#pragma unroll
            for (int i = 0; i < 4; ++i) { kx[i] = k0[i]; kx[4 + i] = k1[i]; vx[i] = v0[i]; vx[4 + i] = v1[i]; }
        } else {
#pragma unroll
            for (int i = 0; i < 8; ++i) { kx[i] = 0.f; vx[i] = 0.f; }
        }
        *(LAS f32x4*)(Kf + j * 68 + d8) = (f32x4){kx[0], kx[1], kx[2], kx[3]}; *(LAS f32x4*)(Kf + j * 68 + d8 + 4) = (f32x4){kx[4], kx[5], kx[6], kx[7]};
        *(LAS f32x4*)(Vf + j * 68 + d8) = (f32x4){vx[0], vx[1], vx[2], vx[3]}; *(LAS f32x4*)(Vf + j * 68 + d8 + 4) = (f32x4){vx[4], vx[5], vx[6], vx[7]};
    }
    __syncthreads();
    LAS float* Qm = Qw + wave * 256;
    LAS float* Pm = Pw + wave * 512;
    for (int i = wave; i < nq; i += 8) {
        const int row = row0 + tq0 + i;
        {
            const u32x2 rq = *(const u32x2*)(QS + (size_t)row * 512 + kvh * 256 + lane * 4);
            *(LAS f32x4*)(Qm + lane * 4) = (f32x4){bf2f(rq.x & 0xffffu), bf2f(rq.x >> 16), bf2f(rq.y & 0xffffu), bf2f(rq.y >> 16)};
        }
        LDS_WAIT();
        float s[2][4];
#pragma unroll
        for (int kk = 0; kk < 2; ++kk) {
            const int j = i + lane + 64 * kk;
            const LAS float* kr = Kf + j * 68;
            float ac[4] = {0.f, 0.f, 0.f, 0.f};
#pragma unroll 4
            for (int d4 = 0; d4 < 16; ++d4) {
                const f32x4 kv = *(const LAS f32x4*)(kr + d4 * 4);
#pragma unroll
                for (int hh = 0; hh < 4; ++hh) {
                    const f32x4 qv = *(const LAS f32x4*)(Qm + hh * 64 + d4 * 4);
                    ac[hh] += (kv[0] * qv[0] + kv[1] * qv[1]) + (kv[2] * qv[2] + kv[3] * qv[3]);
                }
            }
            const bool valid = samp || (tq0 - 127 + j >= 0);
#pragma unroll
            for (int hh = 0; hh < 4; ++hh) s[kk][hh] = valid ? ac[hh] : -INFINITY;
        }
        f32x4 p0, p1;
#pragma unroll
        for (int hh = 0; hh < 4; ++hh) {
            const float sk = a->in[17][kvh * 4 + hh];
            float mx = wave_max(fmaxf(s[0][hh], s[1][hh]));
            mx = fmaxf(mx, sk);
            const float e0 = __expf(s[0][hh] - mx), e1 = __expf(s[1][hh] - mx);
            const float den = wave_sum(e0 + e1) + __expf(sk - mx);
            const float inv = 1.f / den;
            p0[hh] = e0 * inv; p1[hh] = e1 * inv;
        }
        *(LAS f32x4*)(Pm + lane * 4) = p0; *(LAS f32x4*)(Pm + (lane + 64) * 4) = p1;
        LDS_WAIT();
        float o[4] = {0.f, 0.f, 0.f, 0.f};
#pragma unroll 8
        for (int jj = 0; jj < 128; ++jj) {
            const f32x4 pj = *(const LAS f32x4*)(Pm + jj * 4);
            const float v = Vf[(i + jj) * 68 + lane];
            o[0] += pj[0] * v; o[1] += pj[1] * v; o[2] += pj[2] * v; o[3] += pj[3] * v;
        }
#pragma unroll
        for (int hh = 0; hh < 4; ++hh) MIX[(size_t)row * 1024 + 512 + (kvh * 4 + hh) * 64 + lane] = (bf16_t)(cvt_pk_bf16(o[hh], 0.f) & 0xffffu);
        LDS_WAIT();
    }
}

__device__ __forceinline__ void p5b_finalize(CArgs* a) {
    const int tid = threadIdx.x, lane = tid & 63, wave = tid >> 6;
    unsigned char* ws = a->ws;
    const unsigned char* PROJb = ws + WS_PROJ; bf16_t* MIX = (bf16_t*)(ws + WS_MIX);
    const int gw = blockIdx.x * 8 + wave, NGW = gridDim.x * 8;
    const float* gn = a->in[16] + (lane & 15) * 8;
    const f32x4 g0 = *(const f32x4*)gn, g1 = *(const f32x4*)(gn + 4);
    for (int r = MP + gw; r < M; r += NGW) {
        const float* og = (const float*)(PROJb + (size_t)r * (NINP * 2)) + lane * 8;
        const f32x4 o0 = *(const f32x4*)og, o1 = *(const f32x4*)(og + 4);
        float z[8]; unpack8(*(const u32x4*)((const bf16_t*)(PROJb + (size_t)r * (NINP * 2)) + 1536 + lane * 8), z);
        float ssq = (o0[0] * o0[0] + o0[1] * o0[1]) + (o0[2] * o0[2] + o0[3] * o0[3]) + (o1[0] * o1[0] + o1[1] * o1[1]) + (o1[2] * o1[2] + o1[3] * o1[3]);
        ssq += __shfl_xor(ssq, 1); ssq += __shfl_xor(ssq, 2); ssq += __shfl_xor(ssq, 4); ssq += __shfl_xor(ssq, 8);
        const float rs = rsqrtf(ssq * (1.f / 128.f) + EPS);
        float x[8];
#pragma unroll
        for (int i = 0; i < 4; ++i) { x[i] = o0[i] * rs * g0[i] * (z[i] * sigmoidf_(z[i])); x[4 + i] = o1[i] * rs * g1[i] * (z[4 + i] * sigmoidf_(z[4 + i])); }
        *(u32x4*)(MIX + (size_t)r * 1024 + lane * 8) = pack8(x);
    }
}

__device__ __forceinline__ void p10_final(CArgs* a) {
    const int tid = threadIdx.x, lane = tid & 63, wave = tid >> 6;
    const float* SS5 = (const float*)(a->ws + WS_SS) + 4 * (size_t)M;
    const int gw = blockIdx.x * 8 + wave, NGW = gridDim.x * 8;
    f32x4 g[4];
#pragma unroll
    for (int j = 0; j < 4; ++j) g[j] = ((const f32x4*)a->in[25])[lane + 64 * j];
    for (int r = gw; r < M; r += NGW) {
        const float rs = rsqrtf(SS5[r] * (1.f / DM) + EPS);
        f32x4* y = (f32x4*)(a->out + O_Y + (size_t)r * DM);
#pragma unroll
        for (int j = 0; j < 4; ++j) { const f32x4 v = y[lane + 64 * j]; y[lane + 64 * j] = v * rs * g[j]; }
    }
}

constexpr int NPHASE = 13;
#ifndef PHMASK
#define PHMASK 0x1FFF
#endif
#ifndef DUP_MISC
#define DUP_MISC 1
#endif
__global__ void __launch_bounds__(512, 2) mk_fwd(Args a_by_value) {
    extern __shared__ __attribute__((aligned(16))) unsigned char lds_raw[];
    LAS unsigned char* L = (LAS unsigned char*)lds_raw;
    cg::grid_group grid = cg::this_grid();
    const int lo = get_args()->ph_lo, hi = get_args()->ph_hi, G = gridDim.x, bid = blockIdx.x;
#define IN(k) (((PHMASK >> (k)) & 1) && lo <= (k) && (k) < hi)
#define SEAM(k) do { if (IN(k) && IN((k) + 1)) grid.sync(); } while (0)
#define PH_ARGS() CArgs* a = get_args(); unsigned char* ws = a->ws; (void)ws
    if (IN(0)) { PH_ARGS(); for (int rep = 0; rep < DUP_MISC; ++rep) p0_prologue(a, L); } SEAM(0);
    if (IN(1)) {
        PH_ARGS(); float* SS = (float*)(ws + WS_SS);
        pg8::Gemm g{(const bf16_t*)(ws + WS_HB), (const bf16_t*)(ws + WS_GU1), M, NGU, DM}; pg8::StaticOrder S; S.init(M, NGU, G, bid);
        EpiSwiglu E{(bf16_t*)(ws + WS_ACT), SS};
#ifndef DUP_P1
#define DUP_P1 1
#endif
        for (int rep = 0; rep < DUP_P1; ++rep)
        pg8::gemm_phase<EpiSwiglu, pg8::StaticOrder, true, true>(L, g, S, E);
    } SEAM(1);
    if (IN(2)) {
        PH_ARGS(); float* SS = (float*)(ws + WS_SS);
        pg8::Gemm g{(const bf16_t*)(ws + WS_ACT), (const bf16_t*)(ws + WS_D1), M, DM, DFF}; pg8::StaticOrder S; S.init(M, DM, G, bid);
        EpiResid E{a->in[0], a->in[1], a->out + O_Y, (bf16_t*)(ws + WS_HB), SS + M, 0.5f};
        pg8::gemm_phase<EpiResid, pg8::StaticOrder, true, true>(L, g, S, E);
    } SEAM(2);
    if (IN(3)) {
        PH_ARGS(); float* SS = (float*)(ws + WS_SS);
        pg8::Gemm g{(const bf16_t*)(ws + WS_HB), (const bf16_t*)(ws + WS_IN), M, NINP, DM}; pg8::StaticOrder S; S.init(M, NINP, G, bid);
        EpiProj E{(bf16_t*)(ws + WS_PROJ), SS + M, (float*)(ws + WS_AB)};
        pg8::gemm_phase<EpiProj, pg8::StaticOrder, true, true>(L, g, S, E);
    } SEAM(3);
    if (IN(4)) { PH_ARGS(); for (int rep = 0; rep < DUP_MISC; ++rep) p4_mixprep(a); } SEAM(4);
    if (IN(5)) { PH_ARGS(); for (int pr = bid; pr < 1024; pr += G) gdn_chunk_prep(a, L, pr); } SEAM(5);
    if (IN(6)) {
        PH_ARGS();
        const int nded = G >= 128 ? 64 : 0;
        if (bid < nded) gdn_chunk_scan(a, L, bid);
        else {
            for (int it = bid - nded; it < 64 + 2048 + 2304; it += G - nded) {
                if (it < 64) { if (nded == 0) gdn_chunk_scan(a, L, it); }
                else if (it < 64 + 2048) gdn_item(a, L, it - 64, true);
                else swa_item(a, L, it - 64 - 2048);
            }
        }
    } SEAM(6);
    if (IN(7)) { PH_ARGS(); p5b_finalize(a); } SEAM(7);
    if (IN(8)) {
        PH_ARGS(); float* SS = (float*)(ws + WS_SS); float* HF = a->out + O_Y;
        pg8::Gemm g{(const bf16_t*)(ws + WS_MIX), (const bf16_t*)(ws + WS_OUT), M, DM, DM}; pg8::StaticOrder S; S.init(M, DM, G, bid);
        EpiResid E{HF, HF + (size_t)MP * DM, HF, (bf16_t*)(ws + WS_HB), SS + 2 * M, 1.0f};
        pg8::gemm_phase<EpiResid, pg8::StaticOrder, true, true>(L, g, S, E);
    } SEAM(8);
    if (IN(9)) {
        PH_ARGS(); float* SS = (float*)(ws + WS_SS);
        pg8::Gemm g{(const bf16_t*)(ws + WS_HB), (const bf16_t*)(ws + WS_GU2), M, NGU, DM}; pg8::StaticOrder S; S.init(M, NGU, G, bid);
        EpiSwiglu E{(bf16_t*)(ws + WS_ACT), SS + 2 * M};
        pg8::gemm_phase<EpiSwiglu, pg8::StaticOrder, true, true>(L, g, S, E);
    } SEAM(9);
    if (IN(10)) {
        {
            PH_ARGS(); float* SS = (float*)(ws + WS_SS); float* HF = a->out + O_Y;
            pg8::Gemm g{(const bf16_t*)(ws + WS_ACT), (const bf16_t*)(ws + WS_D2), M, DM, DFF}; pg8::StaticOrder S; S.init(M, DM, G, bid);
            EpiResid E{HF, HF + (size_t)MP * DM, HF, (bf16_t*)(ws + WS_HB), SS + 3 * M, 0.5f};
            pg8::gemm_phase<EpiResid, pg8::StaticOrder, true, true>(L, g, S, E);
        }
        {
            PH_ARGS();
            int kple = PLE; asm volatile("" : "+s"(kple)); kple = __builtin_amdgcn_readfirstlane(kple);
            pg8::Gemm g{(const bf16_t*)(ws + WS_PB), (const bf16_t*)(ws + WS_PPW), M, DM, kple}; pg8::StaticOrder S; S.init(M, DM, G, bid);
            EpiPlain E{(bf16_t*)(ws + WS_PP)};
            pg8::gemm_phase<EpiPlain, pg8::StaticOrder, true, true>(L, g, S, E);
        }
    } SEAM(10);
    if (IN(11)) {
        PH_ARGS(); float* SS = (float*)(ws + WS_SS);
        pg8::Gemm g{(const bf16_t*)(ws + WS_HB), (const bf16_t*)(ws + WS_PG), M, DM, DM}; pg8::StaticOrder S; S.init(M, DM, G, bid);
        EpiGate E{a->out + O_Y, (const bf16_t*)(ws + WS_PP), SS + 3 * M, SS + 4 * M};
        pg8::gemm_phase<EpiGate, pg8::StaticOrder, true, true>(L, g, S, E);
    } SEAM(11);
    if (IN(12)) { PH_ARGS(); p10_final(a); }
#undef IN
#undef SEAM
#undef PH_ARGS
}

#ifndef MK_LAUNCHES
#define MK_LAUNCHES 1
#endif
extern "C" void kernel_launch(void* const* d_in, const int* in_sizes, int n_in, void* d_out, int out_size, void* d_ws, size_t ws_size, hipStream_t stream) {
    static int grid = 0;
    if (grid == 0) {
        if (n_in != 26 || (size_t)out_size != O_END || ws_size < WS_END) {
            fprintf(stderr, "kernel_launch: unexpected shapes: n_in %d out %d ws %zu (need out %zu, ws >= %zu)\n", n_in, out_size, ws_size, (size_t)O_END, (size_t)WS_END);
            grid = -1; return;
        }
        int dev = 0, cus = 0, per_cu = 0;
        hipGetDevice(&dev);
        hipDeviceGetAttribute(&cus, hipDeviceAttributeMultiprocessorCount, dev);
        if (hipFuncSetAttribute((const void*)mk_fwd, hipFuncAttributeMaxDynamicSharedMemorySize, LDS_BYTES) != hipSuccess) { fprintf(stderr, "kernel_launch: hipFuncSetAttribute failed\n"); grid = -1; return; }
        if (hipOccupancyMaxActiveBlocksPerMultiprocessor(&per_cu, (const void*)mk_fwd, 512, LDS_BYTES) != hipSuccess || per_cu < 1) { fprintf(stderr, "kernel_launch: occupancy query gave %d\n", per_cu); per_cu = 1; }
        (void)hipGetLastError();
        grid = cus * per_cu;
        fprintf(stderr, "kernel_launch: grid %d (cus %d x %d)\n", grid, cus, per_cu);
    }
    if (grid < 0) return;
    Args a{};
    for (int i = 0; i < 26; ++i) a.in[i] = (const float*)d_in[i];
    a.out = (float*)d_out; a.ws = (unsigned char*)d_ws;
#if MK_LAUNCHES == 1
    a.ph_lo = 0; a.ph_hi = NPHASE;
    void* kargs[] = {&a};
    hipError_t e = hipLaunchCooperativeKernel((const void*)mk_fwd, dim3(grid), dim3(512), kargs, LDS_BYTES, stream);
    if (e != hipSuccess) fprintf(stderr, "kernel_launch: cooperative launch failed: %s (grid %d)\n", hipGetErrorString(e), grid);
#else
    for (int p = 0; p < NPHASE; ++p) {
        a.ph_lo = p; a.ph_hi = p + 1;
        hipLaunchKernelGGL(mk_fwd, dim3(grid), dim3(512), LDS_BYTES, stream, a);
    }
#endif
}
```

```cpp
#include <hip/hip_runtime.h>
#include <hip/hip_cooperative_groups.h>
#include <cstdio>
#include <cstdint>
namespace cg = cooperative_groups;
namespace pg8 {
#define PG8_LAS __attribute__((address_space(3)))
typedef unsigned short bf16_t;
typedef short bf16x8 __attribute__((ext_vector_type(8)));
typedef float f32x4 __attribute__((ext_vector_type(4)));
typedef unsigned u32x4 __attribute__((ext_vector_type(4)));
constexpr int BM = 256, BK = 64, HALF = 128, HTB = HALF * BK * 2  , STAGE_BYTES = 8 * HTB, NXCD = 8, WGM = 8;

__host__ __device__ __forceinline__ int lds_byte(int r, int c) { const int st = (r >> 4) * 2 + (c >> 5), rr = r & 15, cc = c & 31, ob = rr * 64 + cc * 2; return st * 1024 + (ob ^ (((ob >> 9) & 1) << 5)); }
__host__ __device__ __forceinline__ void stage_rc(int b, int& R, int& C) { const int st = b / 1024, sb = b % 1024, swz = sb ^ (((sb >> 9) & 1) << 5); R = (st >> 1) * 16 + swz / 64; C = (st & 1) * 32 + (swz % 64) / 2; }
__host__ __device__ __forceinline__ int perm32(int rho) { const int n = rho >> 4, i = rho & 15; return 8 * (i >> 2) + 4 * n + (i & 3); }

struct Unit { int pm, pn; };
struct Gemm { const bf16_t* A; const bf16_t* Bt; int M, N, K; };

struct StaticOrder {
    int nM, nN, nwg, G, c;
    __host__ __device__ void init(int M, int N, int G_, int c_) { nM = M / BM; nN = N / BM; nwg = nM * nN; G = G_; c = c_; }
    __host__ __device__ bool next(int i, Unit& u) const {
        const long L = (long)i * G + c; if (L >= nwg) return false;
        int wgid = (int)L; { const int q = nwg / NXCD, r = nwg % NXCD, xcd = wgid % NXCD, off = wgid / NXCD; wgid = (xcd < r ? xcd * (q + 1) : r * (q + 1) + (xcd - r) * q) + off; }
        const int nig = WGM * nN, gid = wgid / nig, fm = gid * WGM, gsz = (nM - fm) < WGM ? (nM - fm) : WGM;
        u.pm = fm + ((wgid % nig) % gsz); u.pn = (wgid % nig) / gsz; return true;
    }
    __device__ __forceinline__ void a_ready(const Unit&) const {}
    __device__ __forceinline__ void done(const Unit&) const {}
};

__device__ __forceinline__ unsigned cvt_pk_bf16(float lo, float hi) { unsigned r; asm volatile("v_cvt_pk_bf16_f32 %0, %1, %2" : "=v"(r) : "v"(lo), "v"(hi)); return r; }
typedef float f32x2 __attribute__((ext_vector_type(2)));
template <class Epi, class Sched, bool ALIGN_EPI = false, bool SP2 = false>
__device__ __forceinline__ void gemm_phase(PG8_LAS unsigned char* lds, const Gemm g, const Sched& S, const Epi& E) {
    const int tid = threadIdx.x, wid = __builtin_amdgcn_readfirstlane(tid >> 6), lane = tid & 63, wr = wid >> 2, wc = wid & 3, fr = lane & 15, fq = lane >> 4;
    const int K = g.K, nt = K / BK;
    unsigned voffA[2], voffB[2];
#pragma unroll
    for (int i = 0; i < 2; ++i) { int R, C; stage_rc(tid * 16 + i * 8192, R, C); const int Rb = Epi::PERM ? ((R & ~31) + perm32(R & 31)) : R;
        voffA[i] = (unsigned)(R * K + C) * 2u; voffB[i] = (unsigned)(Rb * K + C) * 2u; }
    const size_t kstep = (size_t)(BK * 2);
    const size_t hstep = (size_t)HALF * K * 2;
    const size_t tstep = 2 * hstep;
    const unsigned ldsw = (unsigned)wid * 1024u;
    const int aoff = lds_byte(wr * 64 + fr, fq * 8), boff = lds_byte(wc * 32 + fr, fq * 8);
#define PG8_SA(b, h) (((b) * 2 + (h)) * HTB)
#define PG8_SB(b, h) ((4 + (b) * 2 + (h)) * HTB)
#define PG8_STAGE(bufoff, gbase, voff) do { _Pragma("unroll") for (int _i = 0; _i < 2; ++_i) \
        __builtin_amdgcn_global_load_lds((const unsigned*)((const char*)(gbase) + (voff)[_i]), (PG8_LAS unsigned*)(lds + (bufoff) + ldsw + _i * 8192), 16, 0, 0); } while (0)
#define PG8_LDA(dst, b, h) do { _Pragma("unroll") for (int m = 0; m < 4; ++m) _Pragma("unroll") for (int k = 0; k < 2; ++k) dst[m][k] = *(const PG8_LAS bf16x8*)(lds + PG8_SA(b, h) + aoff + m * 2048 + k * 1024); } while (0)
#define PG8_LDB(dst, b, h) do { _Pragma("unroll") for (int n = 0; n < 2; ++n) _Pragma("unroll") for (int k = 0; k < 2; ++k) dst[n][k] = *(const PG8_LAS bf16x8*)(lds + PG8_SB(b, h) + boff + n * 2048 + k * 1024); } while (0)
#define PG8_MMA(ai, bj, At, Bt) do { __builtin_amdgcn_s_setprio(1); _Pragma("unroll") for (int m = 0; m < 4; ++m) _Pragma("unroll") for (int n = 0; n < 2; ++n) _Pragma("unroll") for (int k = 0; k < 2; ++k) \
        acc[ai][bj][m][n] = __builtin_amdgcn_mfma_f32_16x16x32_bf16(Bt[n][k], At[m][k], acc[ai][bj][m][n], 0, 0, 0); __builtin_amdgcn_s_setprio(0); } while (0)
#define PG8_WAIT_V(n) asm volatile("s_waitcnt vmcnt(" #n ")" ::: "memory")
#define PG8_WAIT_L(n) asm volatile("s_waitcnt lgkmcnt(" #n ")" ::: "memory")
#define PG8_BAR __builtin_amdgcn_s_barrier()
#define PG8_SCHED __builtin_amdgcn_sched_barrier(0)
    Unit cur, nxt; int ui = 0;
    if (!S.next(0, cur)) return;
    f32x4 acc[2][2][4][2];
#pragma unroll
    for (int a = 0; a < 2; ++a)
#pragma unroll
        for (int b = 0; b < 2; ++b)
#pragma unroll
            for (int m = 0; m < 4; ++m)
#pragma unroll
                for (int n = 0; n < 2; ++n) acc[a][b][m][n] = (f32x4){0.f, 0.f, 0.f, 0.f};
    bf16x8 At[4][2], B0[2][2], B1[2][2];
    const char* cA = (const char*)g.A + (size_t)cur.pm * tstep; const char* cB = (const char*)g.Bt + (size_t)cur.pn * tstep;
    S.a_ready(cur);
    if constexpr (SP2) {
        PG8_STAGE(PG8_SB(0, 0), cB, voffB); PG8_STAGE(PG8_SB(0, 1), cB + hstep, voffB); PG8_STAGE(PG8_SA(0, 0), cA, voffA); PG8_STAGE(PG8_SA(0, 1), cA + hstep, voffA);
        if (wr == 1) PG8_BAR;
        PG8_WAIT_V(2); PG8_BAR;
        PG8_STAGE(PG8_SB(1, 0), cB + kstep, voffB); PG8_STAGE(PG8_SA(1, 0), cA + kstep, voffA); PG8_STAGE(PG8_SB(1, 1), cB + hstep + kstep, voffB);
        PG8_WAIT_V(6); PG8_BAR;
    } else {
        PG8_STAGE(PG8_SB(0, 0), cB, voffB); PG8_STAGE(PG8_SA(0, 0), cA, voffA); PG8_STAGE(PG8_SB(0, 1), cB + hstep, voffB); PG8_STAGE(PG8_SA(0, 1), cA + hstep, voffA);
        if (wr == 1) PG8_BAR;
        PG8_WAIT_V(4); PG8_BAR;
        PG8_STAGE(PG8_SB(1, 0), cB + kstep, voffB); PG8_STAGE(PG8_SA(1, 0), cA + kstep, voffA); PG8_STAGE(PG8_SB(1, 1), cB + hstep + kstep, voffB);
        PG8_WAIT_V(6); PG8_BAR;
    }
    for (;;) {
        const bool has_next = S.next(ui + 1, nxt);
        const char* nA = has_next ? (const char*)g.A + (size_t)nxt.pm * tstep : cA; const char* nB = has_next ? (const char*)g.Bt + (size_t)nxt.pn * tstep : cB;
        for (int t = 0; t < nt; t += 2) {
            const bool last = (t == nt - 2);
            const char* a1 = cA + (size_t)(t + 1) * kstep;
            const char* a2 = last ? nA : cA + (size_t)(t + 2) * kstep; const char* b2 = last ? nB : cB + (size_t)(t + 2) * kstep;
            const char* a3 = a2 + kstep; const char* b3 = b2 + kstep;
            if (last && has_next) S.a_ready(nxt);
            if constexpr (SP2) {
            PG8_LDB(B0, 0, 0); PG8_LDB(B1, 0, 1); PG8_SCHED; PG8_LDA(At, 0, 0); PG8_STAGE(PG8_SA(1, 1), a1 + hstep, voffA);
            PG8_WAIT_V(8); PG8_WAIT_L(0); PG8_BAR; PG8_MMA(0, 0, At, B0); PG8_MMA(0, 1, At, B1); PG8_BAR; PG8_SCHED;
            PG8_LDA(At, 0, 1); PG8_STAGE(PG8_SB(0, 0), b2, voffB); PG8_STAGE(PG8_SB(0, 1), b2 + hstep, voffB); PG8_STAGE(PG8_SA(0, 0), a2, voffA);
            PG8_WAIT_V(8); PG8_WAIT_L(0); PG8_BAR; PG8_MMA(1, 0, At, B0); PG8_MMA(1, 1, At, B1); PG8_BAR; PG8_SCHED;
            PG8_LDB(B0, 1, 0); PG8_LDB(B1, 1, 1); PG8_SCHED; PG8_LDA(At, 1, 0); PG8_STAGE(PG8_SA(0, 1), a2 + hstep, voffA);
            PG8_WAIT_V(8); PG8_WAIT_L(0); PG8_BAR; PG8_MMA(0, 0, At, B0); PG8_MMA(0, 1, At, B1); PG8_BAR; PG8_SCHED;
            PG8_LDA(At, 1, 1); PG8_STAGE(PG8_SB(1, 0), b3, voffB); PG8_STAGE(PG8_SB(1, 1), b3 + hstep, voffB); PG8_STAGE(PG8_SA(1, 0), a3, voffA);
            PG8_WAIT_V(8); PG8_WAIT_L(0); PG8_BAR; PG8_MMA(1, 0, At, B0); PG8_MMA(1, 1, At, B1); PG8_BAR; PG8_SCHED;
            } else {
            PG8_LDB(B0, 0, 0); PG8_SCHED; PG8_LDA(At, 0, 0); PG8_STAGE(PG8_SA(1, 1), a1 + hstep, voffA);
            PG8_WAIT_L(8); PG8_BAR; PG8_WAIT_L(0); PG8_MMA(0, 0, At, B0); PG8_BAR; PG8_SCHED;
            PG8_LDB(B1, 0, 1); PG8_STAGE(PG8_SB(0, 0), b2, voffB);
            PG8_BAR; PG8_WAIT_L(0); PG8_MMA(0, 1, At, B1); PG8_BAR;
            PG8_LDA(At, 0, 1); PG8_STAGE(PG8_SA(0, 0), a2, voffA);
            PG8_BAR; PG8_WAIT_L(0); PG8_MMA(1, 0, At, B0); PG8_BAR; PG8_SCHED;
            PG8_STAGE(PG8_SB(0, 1), b2 + hstep, voffB);
            PG8_WAIT_V(6); PG8_BAR; PG8_MMA(1, 1, At, B1); PG8_BAR;
            PG8_LDB(B0, 1, 0); PG8_SCHED; PG8_LDA(At, 1, 0); PG8_STAGE(PG8_SA(0, 1), a2 + hstep, voffA);
            PG8_WAIT_L(8); PG8_BAR; PG8_WAIT_L(0); PG8_MMA(0, 0, At, B0); PG8_BAR; PG8_SCHED;
            PG8_LDB(B1, 1, 1); PG8_STAGE(PG8_SB(1, 0), b3, voffB);
            PG8_BAR; PG8_WAIT_L(0); PG8_MMA(0, 1, At, B1); PG8_BAR;
            PG8_LDA(At, 1, 1); PG8_STAGE(PG8_SA(1, 0), a3, voffA);
            PG8_BAR; PG8_WAIT_L(0); PG8_MMA(1, 0, At, B0); PG8_BAR; PG8_SCHED;
            PG8_STAGE(PG8_SB(1, 1), b3 + hstep, voffB);
            PG8_WAIT_V(6); PG8_BAR; PG8_MMA(1, 1, At, B1); PG8_BAR;
            }
        }
        if constexpr (ALIGN_EPI) { if (wr == 0) PG8_BAR; }
        if constexpr (!Epi::AFTER_DRAIN) { E(acc, cur, wr, wc, fr, fq); S.done(cur); }
        if (!has_next) break;
#pragma unroll
        for (int a = 0; a < 2; ++a)
#pragma unroll
            for (int b = 0; b < 2; ++b)
#pragma unroll
                for (int m = 0; m < 4; ++m)
#pragma unroll
                    for (int n = 0; n < 2; ++n) acc[a][b][m][n] = (f32x4){0.f, 0.f, 0.f, 0.f};
        cur = nxt; cA = nA; cB = nB; ++ui;
        if constexpr (ALIGN_EPI) { if (wr == 1) PG8_BAR; }
    }
    PG8_WAIT_V(0);
    if constexpr (!ALIGN_EPI) { if (wr == 0) PG8_BAR; }
    PG8_BAR;
    if constexpr (Epi::AFTER_DRAIN) { E.fused(acc, cur, wr, wc, fr, fq, lds, wid, lane); S.done(cur); }
#undef PG8_SA
#undef PG8_SB
#undef PG8_STAGE
#undef PG8_LDA
#undef PG8_LDB
#undef PG8_MMA
#undef PG8_WAIT_V
#undef PG8_WAIT_L
#undef PG8_BAR
#undef PG8_SCHED
}
}

#define LAS __attribute__((address_space(3)))
typedef unsigned short bf16_t;
typedef float f32x4 __attribute__((ext_vector_type(4)));
typedef unsigned u32x4 __attribute__((ext_vector_type(4)));
typedef unsigned u32x2 __attribute__((ext_vector_type(2)));
using pg8::cvt_pk_bf16;

constexpr int DM = 1024, TP = 2048, NBP = 16, NBS = 128, TS = 8;
constexpr int MP = NBP * TP, MS = NBS * TS, M = MP + MS;
constexpr int DFF = 2816, NGU = 2 * DFF, NINP = 3072, NIN = 2824, PLE = 256;
constexpr float EPS = 1e-6f;
constexpr int PAST = 16384;

constexpr size_t O_Y = 0;
constexpr size_t O_SGP = (size_t)M * DM;
constexpr size_t O_SCP = O_SGP + (size_t)NBP * 4 * 128 * 128;
constexpr size_t O_CKP = O_SCP + (size_t)NBP * 3 * 1536;
constexpr size_t O_CVP = O_CKP + (size_t)NBP * 128 * 128;
constexpr size_t O_SGS = O_CVP + (size_t)NBP * 128 * 128;
constexpr size_t O_SCS = O_SGS + (size_t)NBS * 4 * 128 * 128;
constexpr size_t O_CKS = O_SCS + (size_t)NBS * 3 * 1536;
constexpr size_t O_CVS = O_CKS + (size_t)NBS * 128 * 128;
constexpr size_t O_END = O_CVS + (size_t)NBS * 128 * 128;

constexpr size_t MiB = 1u << 20;
constexpr size_t WS_GU1 = 0, WS_D1 = 11 * MiB, WS_IN = 17 * MiB, WS_OUT = 23 * MiB, WS_GU2 = 25 * MiB, WS_D2 = 36 * MiB, WS_PG = 42 * MiB, WS_PPW = 44 * MiB;
constexpr size_t WS_HB = 48 * MiB;
constexpr size_t WS_QS = 48 * MiB, WS_KS = 81 * MiB, WS_VS = 90 * MiB;
constexpr size_t WS_ACT = 114 * MiB;
constexpr size_t WS_PROJ = 114 * MiB;
constexpr size_t WS_GQ = 312 * MiB, WS_GK = 345 * MiB, WS_GV = 378 * MiB;
constexpr size_t WS_PP = 312 * MiB;
constexpr size_t WS_MIX = 411 * MiB;
constexpr size_t WS_PB = 477 * MiB;
constexpr size_t WS_SS = 494 * MiB;
constexpr size_t WS_AB = 495 * MiB;
constexpr size_t WS_GD = 497 * MiB;
constexpr size_t WS_BT = 498 * MiB;
constexpr size_t WS_ROPE = 499 * MiB;
constexpr size_t WS_EGL = 499 * MiB + 512 * 1024;
constexpr size_t WS_CTR = 499 * MiB + 768 * 1024;
constexpr size_t WS_END = 500 * MiB;

constexpr int LDS_BYTES = 131072 + 2048;

struct Args { const float* in[26]; float* out; unsigned char* ws; int ph_lo, ph_hi; };
typedef __attribute__((address_space(4))) const Args CArgs;
__device__ __forceinline__ CArgs* get_args() {
    unsigned long long p = (unsigned long long)__builtin_amdgcn_kernarg_segment_ptr();
    unsigned l = (unsigned)p, h = (unsigned)(p >> 32);
    asm volatile("" : "+s"(l), "+s"(h));
    l = __builtin_amdgcn_readfirstlane(l); h = __builtin_amdgcn_readfirstlane(h);
    return (CArgs*)(((unsigned long long)h << 32) | l);
}


__device__ __forceinline__ float bf2f(unsigned b) { return __uint_as_float(b << 16); }
__device__ __forceinline__ float wave_sum(float v) {
#pragma unroll
    for (int o = 1; o < 64; o <<= 1) v += __shfl_xor(v, o);
    return v;
}
__device__ __forceinline__ float wave_max(float v) {
#pragma unroll
    for (int o = 1; o < 64; o <<= 1) v = fmaxf(v, __shfl_xor(v, o));
    return v;
}
template <int CTRL> __device__ __forceinline__ float dppf(float v) { return __int_as_float(__builtin_amdgcn_update_dpp(0, __float_as_int(v), CTRL, 0xf, 0xf, true)); }
__device__ __forceinline__ float reduce16(float v) {
    v += dppf<0xB1>(v); v += dppf<0x4E>(v); v += dppf<0x141>(v); v += dppf<0x140>(v); return v;
}
__device__ __forceinline__ void unpack8(const u32x4 r, float* x) {
    x[0] = bf2f(r.x & 0xffffu); x[1] = bf2f(r.x >> 16); x[2] = bf2f(r.y & 0xffffu); x[3] = bf2f(r.y >> 16);
    x[4] = bf2f(r.z & 0xffffu); x[5] = bf2f(r.z >> 16); x[6] = bf2f(r.w & 0xffffu); x[7] = bf2f(r.w >> 16);
}
__device__ __forceinline__ u32x4 pack8(const float* x) {
    u32x4 w; w.x = cvt_pk_bf16(x[0], x[1]); w.y = cvt_pk_bf16(x[2], x[3]); w.z = cvt_pk_bf16(x[4], x[5]); w.w = cvt_pk_bf16(x[6], x[7]); return w;
}
__device__ __forceinline__ float sigmoidf_(float x) { return 1.f / (1.f + __expf(-x)); }
#define LDS_WAIT() asm volatile("s_waitcnt lgkmcnt(0)" ::: "memory")

struct EpiSwiglu {
    static constexpr bool PERM = true, AFTER_DRAIN = false;
    bf16_t* O; const float* ss;
    __device__ __forceinline__ void operator()(const f32x4 (&acc)[2][2][4][2], const pg8::Unit& u, int wr, int wc, int fr, int fq) const {
        const int col0 = u.pn * 128 + wc * 32 + 8 * fq;
#pragma unroll
        for (int ai = 0; ai < 2; ++ai)
#pragma unroll
            for (int m = 0; m < 4; ++m) {
                const int row = u.pm * 256 + ai * 128 + wr * 64 + m * 16 + fr;
                const float rs = rsqrtf(ss[row] * (1.f / DM) + EPS);
                float a[8];
#pragma unroll
                for (int n = 0; n < 2; ++n)
#pragma unroll
                    for (int j = 0; j < 4; ++j) { const float g = acc[ai][0][m][n][j] * rs, up = acc[ai][1][m][n][j] * rs; a[4 * n + j] = g * sigmoidf_(g) * up; }
                *(u32x4*)(O + (size_t)row * DFF + col0) = pack8(a);
            }
    }
};
struct EpiProj {
    static constexpr bool PERM = true, AFTER_DRAIN = false;
    bf16_t* O; const float* ss; float* AB;
    __device__ __forceinline__ void operator()(const f32x4 (&acc)[2][2][4][2], const pg8::Unit& u, int wr, int wc, int fr, int fq) const {
#pragma unroll
        for (int ai = 0; ai < 2; ++ai)
#pragma unroll
            for (int m = 0; m < 4; ++m) {
                const int row = u.pm * 256 + ai * 128 + wr * 64 + m * 16 + fr;
                const float rs = rsqrtf(ss[row] * (1.f / DM) + EPS);
#pragma unroll
                for (int bj = 0; bj < 2; ++bj) {
                    float a[8];
#pragma unroll
                    for (int n = 0; n < 2; ++n)
#pragma unroll
                        for (int j = 0; j < 4; ++j) a[4 * n + j] = acc[ai][bj][m][n][j] * rs;
                    *(u32x4*)(O + (size_t)row * NINP + u.pn * 256 + bj * 128 + wc * 32 + 8 * fq) = pack8(a);
                    if (bj == 0 && u.pn == 11 && wc == 0 && fq == 0) {
                        *(f32x4*)(AB + (size_t)row * 8) = (f32x4){a[0], a[1], a[2], a[3]};
                        *(f32x4*)(AB + (size_t)row * 8 + 4) = (f32x4){a[4], a[5], a[6], a[7]};
                    }
                }
            }
    }
};
struct EpiPlain {
    static constexpr bool PERM = true, AFTER_DRAIN = false;
    bf16_t* O;
    __device__ __forceinline__ void operator()(const f32x4 (&acc)[2][2][4][2], const pg8::Unit& u, int wr, int wc, int fr, int fq) const {
#pragma unroll
        for (int ai = 0; ai < 2; ++ai)
#pragma unroll
            for (int m = 0; m < 4; ++m) {
                const int row = u.pm * 256 + ai * 128 + wr * 64 + m * 16 + fr;
#pragma unroll
                for (int bj = 0; bj < 2; ++bj) {
                    float a[8];
#pragma unroll
                    for (int n = 0; n < 2; ++n)
#pragma unroll
                        for (int j = 0; j < 4; ++j) a[4 * n + j] = acc[ai][bj][m][n][j];
                    *(u32x4*)(O + (size_t)row * DM + u.pn * 256 + bj * 128 + wc * 32 + 8 * fq) = pack8(a);
                }
            }
    }
};
struct EpiResid {
    static constexpr bool PERM = false, AFTER_DRAIN = false;
    const float* base0; const float* base1; float* out; bf16_t* outb; float* ss; float alpha;
    __device__ __forceinline__ void operator()(const f32x4 (&acc)[2][2][4][2], const pg8::Unit& u, int wr, int wc, int fr, int fq) const {
#pragma unroll
        for (int ai = 0; ai < 2; ++ai)
#pragma unroll
            for (int m = 0; m < 4; ++m) {
                const int row = u.pm * 256 + ai * 128 + wr * 64 + m * 16 + fr;
                const float* bp = row < MP ? base0 + (size_t)row * DM : base1 + (size_t)(row - MP) * DM;
                float sq = 0.f;
#pragma unroll
                for (int bj = 0; bj < 2; ++bj)
#pragma unroll
                    for (int n = 0; n < 2; ++n) {
                        const int c = u.pn * 256 + bj * 128 + wc * 32 + n * 16 + 4 * fq;
                        const f32x4 bv = *(const f32x4*)(bp + c);
                        const f32x4 v = bv + acc[ai][bj][m][n] * alpha;
                        *(f32x4*)(out + (size_t)row * DM + c) = v;
                        u32x2 w; w.x = cvt_pk_bf16(v[0], v[1]); w.y = cvt_pk_bf16(v[2], v[3]);
                        *(u32x2*)(outb + (size_t)row * DM + c) = w;
                        sq += (v[0] * v[0] + v[1] * v[1]) + (v[2] * v[2] + v[3] * v[3]);
                    }
                sq += __shfl_xor(sq, 16); sq += __shfl_xor(sq, 32);
                if (fq == 0) unsafeAtomicAdd(ss + row, sq);
                asm volatile("" ::: "memory");
            }
    }
};
struct EpiGate {
    static constexpr bool PERM = false, AFTER_DRAIN = false;
    float* h; const bf16_t* pp; const float* ss; float* ss2;
    __device__ __forceinline__ void operator()(const f32x4 (&acc)[2][2][4][2], const pg8::Unit& u, int wr, int wc, int fr, int fq) const {
#pragma unroll
        for (int ai = 0; ai < 2; ++ai)
#pragma unroll
            for (int m = 0; m < 4; ++m) {
                const int row = u.pm * 256 + ai * 128 + wr * 64 + m * 16 + fr;
                const float rs = rsqrtf(ss[row] * (1.f / DM) + EPS);
                float sq = 0.f;
#pragma unroll
                for (int bj = 0; bj < 2; ++bj)
#pragma unroll
                    for (int n = 0; n < 2; ++n) {
                        const int c = u.pn * 256 + bj * 128 + wc * 32 + n * 16 + 4 * fq;
                        const f32x4 hv = *(const f32x4*)(h + (size_t)row * DM + c);
                        const u32x2 pw = *(const u32x2*)(pp + (size_t)row * DM + c);
                        f32x4 v;
                        v[0] = hv[0] + sigmoidf_(acc[ai][bj][m][n][0] * rs) * bf2f(pw.x & 0xffffu);
                        v[1] = hv[1] + sigmoidf_(acc[ai][bj][m][n][1] * rs) * bf2f(pw.x >> 16);
                        v[2] = hv[2] + sigmoidf_(acc[ai][bj][m][n][2] * rs) * bf2f(pw.y & 0xffffu);
                        v[3] = hv[3] + sigmoidf_(acc[ai][bj][m][n][3] * rs) * bf2f(pw.y >> 16);
                        *(f32x4*)(h + (size_t)row * DM + c) = v;
                        sq += (v[0] * v[0] + v[1] * v[1]) + (v[2] * v[2] + v[3] * v[3]);
                    }
                sq += __shfl_xor(sq, 16); sq += __shfl_xor(sq, 32);
                if (fq == 0) unsafeAtomicAdd(ss2 + row, sq);
                asm volatile("" ::: "memory");
            }
    }
};

__device__ __forceinline__ int map_row(int mode, int n) {
    if (mode == 1) { if (n < DFF) return 256 * (n >> 7) + (n & 127); n -= DFF; return 256 * (n >> 7) + 128 + (n & 127); }
    if (mode == 2) { if (n < 2048) return n; if (n < 2052) return 2816 + (n - 2048); if (n < 2056) return 2820 + (n - 2052); return n - 8; }
    return n;
}
__device__ __forceinline__ void p0_transpose_item(const float* W, int K, int N, const float* gain, bf16_t* WT, int mode, LAS float* scr, int item, int lane) {
    const int nblk = (N + 31) / 32, kb = item / nblk, nb = item % nblk, k0 = 64 * kb, n0 = 32 * nb;
#pragma unroll 8
    for (int i = 0; i < 32; ++i) {
        const int kk = 2 * i + (lane >> 5), n = n0 + (lane & 31);
        float v = 0.f;
        if (n < N) { v = W[(size_t)(k0 + kk) * N + n]; if (gain) v *= gain[k0 + kk]; }
        scr[kk * 33 + (lane & 31)] = v;
    }
    LDS_WAIT();
    const int c = lane & 7;
#pragma unroll
    for (int j = 0; j < 4; ++j) {
        const int n = (lane >> 3) + 8 * j;
        if (n0 + n < N) {
            const LAS float* s = scr + (8 * c) * 33 + n;
            u32x4 o; o.x = cvt_pk_bf16(s[0 * 33], s[1 * 33]); o.y = cvt_pk_bf16(s[2 * 33], s[3 * 33]); o.z = cvt_pk_bf16(s[4 * 33], s[5 * 33]); o.w = cvt_pk_bf16(s[6 * 33], s[7 * 33]);
            *(u32x4*)(WT + (size_t)map_row(mode, n0 + n) * K + k0 + 8 * c) = o;
        }
    }
    LDS_WAIT();
}

__device__ __forceinline__ void p0_prologue(CArgs* a, LAS unsigned char* L) {
    const int tid = threadIdx.x, lane = tid & 63, wave = tid >> 6;
    unsigned char* ws = a->ws;
    LAS float* scr = (LAS float*)(L + wave * 16384);
    const int gw = blockIdx.x * 8 + wave, NGW = gridDim.x * 8;
    constexpr int I_GU = 16 * 176, I_D = 44 * 32, I_IN = 16 * 89, I_SQ = 16 * 32, I_PP = 4 * 32;
    constexpr int NITEMS = 2 * I_GU + 2 * I_D + I_IN + 2 * I_SQ + I_PP;
    for (int it = gw; it < NITEMS; it += NGW) {
        int r = it;
        if (r < I_GU) { p0_transpose_item(a->in[9], DM, NGU, a->in[8], (bf16_t*)(ws + WS_GU1), 1, scr, r, lane); continue; } r -= I_GU;
        if (r < I_GU) { p0_transpose_item(a->in[20], DM, NGU, a->in[19], (bf16_t*)(ws + WS_GU2), 1, scr, r, lane); continue; } r -= I_GU;
        if (r < I_D) { p0_transpose_item(a->in[10], DFF, DM, nullptr, (bf16_t*)(ws + WS_D1), 0, scr, r, lane); continue; } r -= I_D;
        if (r < I_D) { p0_transpose_item(a->in[21], DFF, DM, nullptr, (bf16_t*)(ws + WS_D2), 0, scr, r, lane); continue; } r -= I_D;
        if (r < I_IN) { p0_transpose_item(a->in[12], DM, NIN, a->in[11], (bf16_t*)(ws + WS_IN), 2, scr, r, lane); continue; } r -= I_IN;
        if (r < I_SQ) { p0_transpose_item(a->in[18], DM, DM, nullptr, (bf16_t*)(ws + WS_OUT), 0, scr, r, lane); continue; } r -= I_SQ;
        if (r < I_SQ) { p0_transpose_item(a->in[24], DM, DM, a->in[22], (bf16_t*)(ws + WS_PG), 0, scr, r, lane); continue; } r -= I_SQ;
        p0_transpose_item(a->in[23], PLE, DM, nullptr, (bf16_t*)(ws + WS_PPW), 0, scr, r, lane);
    }
    {
        u32x4* z = (u32x4*)(ws + WS_IN + (size_t)NIN * DM * 2);
        const int nz = (NINP - NIN) * DM * 2 / 16;
        for (int i = blockIdx.x * 512 + tid; i < nz; i += gridDim.x * 512) z[i] = (u32x4){0u, 0u, 0u, 0u};
    }
    bf16_t* HB = (bf16_t*)(ws + WS_HB); bf16_t* PB = (bf16_t*)(ws + WS_PB); float* SS = (float*)(ws + WS_SS);
    for (int m = gw; m < M; m += NGW) {
        const float* xr = m < MP ? a->in[0] + (size_t)m * DM : a->in[1] + (size_t)(m - MP) * DM;
        float s = 0.f;
#pragma unroll
        for (int j = 0; j < 4; ++j) {
            const f32x4 v = ((const f32x4*)xr)[lane + 64 * j];
            s += (v[0] * v[0] + v[1] * v[1]) + (v[2] * v[2] + v[3] * v[3]);
            u32x2 w; w.x = cvt_pk_bf16(v[0], v[1]); w.y = cvt_pk_bf16(v[2], v[3]);
            ((u32x2*)(HB + (size_t)m * DM))[lane + 64 * j] = w;
        }
        s = wave_sum(s);
        if (lane == 0) SS[m] = s;
        const float* pr = m < MP ? a->in[6] + (size_t)m * PLE : a->in[7] + (size_t)(m - MP) * PLE;
        const f32x4 pv = ((const f32x4*)pr)[lane];
        u32x2 w; w.x = cvt_pk_bf16(pv[0], pv[1]); w.y = cvt_pk_bf16(pv[2], pv[3]);
        ((u32x2*)(PB + (size_t)m * PLE))[lane] = w;
    }
    for (int i = blockIdx.x * 512 + tid; i < 4 * M; i += gridDim.x * 512) SS[M + i] = 0.f;
    if (blockIdx.x == 0 && tid == 0) *(unsigned*)(ws + WS_CTR) = 0u;
    float* RT = (float*)(ws + WS_ROPE);
    for (int i = blockIdx.x * 512 + tid; i < 2056 * 8; i += gridDim.x * 512) {
        const int idx = i >> 3, f = i & 7;
        const int pos = idx < 2048 ? idx : PAST + (idx - 2048);
        const float inv = powf(500000.0f, -(float)f * 0.125f);
        const float ang = (float)pos * inv;
        const double rev = (double)ang * 0.15915494309189535;
        const float fr = (float)(rev - rint(rev));
        RT[idx * 16 + f] = __builtin_amdgcn_cosf(fr);
        RT[idx * 16 + 8 + f] = __builtin_amdgcn_sinf(fr);
    }
}

__device__ __forceinline__ void p4_mixprep(CArgs* a) {
    const int tid = threadIdx.x, lane = tid & 63, wave = tid >> 6;
    unsigned char* ws = a->ws;
    const bf16_t* PROJ = (const bf16_t*)(ws + WS_PROJ);
    bf16_t* GQ = (bf16_t*)(ws + WS_GQ); bf16_t* GK = (bf16_t*)(ws + WS_GK); bf16_t* GV = (bf16_t*)(ws + WS_GV);
    bf16_t* QS = (bf16_t*)(ws + WS_QS); bf16_t* KS = (bf16_t*)(ws + WS_KS); bf16_t* VS = (bf16_t*)(ws + WS_VS);
    const float* AB = (const float*)(ws + WS_AB); float* GD = (float*)(ws + WS_GD); float* BT = (float*)(ws + WS_BT);
    const float* RT = (const float*)(ws + WS_ROPE);
    const float* state_conv = a->in[3]; const float* conv_w = a->in[13];
    const int gw = blockIdx.x * 8 + wave, NGW = gridDim.x * 8;
    for (int r = gw; r < M; r += NGW) {
        const bool samp = r >= MP;
        int b, t;
        if (!samp) { b = r >> 11; t = r & 2047; } else { b = (r - MP) >> 3; t = (r - MP) & 7; }
        const int T = samp ? TS : TP;
        const bf16_t* prow = PROJ + (size_t)r * NINP;
#pragma unroll
        for (int j = 0; j < 3; ++j) {
            const int ch = j * 512 + lane * 8;
            float acc[8], cur[8];
#pragma unroll
            for (int i = 0; i < 8; ++i) acc[i] = 0.f;
#pragma unroll
            for (int tap = 0; tap < 4; ++tap) {
                const int tt = t - 3 + tap;
                float x[8];
                if (tt >= 0) { const u32x4 raw = *(const u32x4*)(prow - (ptrdiff_t)(3 - tap) * NINP + ch); unpack8(raw, x); }
                else if (samp) {
                    const float* sc = state_conv + ((size_t)b * 3 + (3 + tt)) * 1536 + ch;
                    const f32x4 s0 = *(const f32x4*)sc, s1 = *(const f32x4*)(sc + 4);
                    x[0] = s0[0]; x[1] = s0[1]; x[2] = s0[2]; x[3] = s0[3]; x[4] = s1[0]; x[5] = s1[1]; x[6] = s1[2]; x[7] = s1[3];
                } else {
#pragma unroll
                    for (int i = 0; i < 8; ++i) x[i] = 0.f;
                }
                const f32x4 w0 = *(const f32x4*)(conv_w + tap * 1536 + ch), w1 = *(const f32x4*)(conv_w + tap * 1536 + ch + 4);
                acc[0] += x[0] * w0[0]; acc[1] += x[1] * w0[1]; acc[2] += x[2] * w0[2]; acc[3] += x[3] * w0[3];
                acc[4] += x[4] * w1[0]; acc[5] += x[5] * w1[1]; acc[6] += x[6] * w1[2]; acc[7] += x[7] * w1[3];
                if (tap == 3) {
#pragma unroll
                    for (int i = 0; i < 8; ++i) cur[i] = x[i];
                }
            }
            float ssq = 0.f;
#pragma unroll
            for (int i = 0; i < 8; ++i) { acc[i] = acc[i] * sigmoidf_(acc[i]); ssq += acc[i] * acc[i]; }
            if (j < 2) {
                ssq += __shfl_xor(ssq, 1); ssq += __shfl_xor(ssq, 2); ssq += __shfl_xor(ssq, 4); ssq += __shfl_xor(ssq, 8);
                const float sc = rsqrtf(ssq + 1e-6f) * (j == 0 ? 0.08838834764831845f : 1.0f);
#pragma unroll
                for (int i = 0; i < 8; ++i) acc[i] *= sc;
            }
            bf16_t* dst = (j == 0 ? GQ : (j == 1 ? GK : GV)) + (size_t)r * 512 + lane * 8;
            *(u32x4*)dst = pack8(acc);
            if (t >= T - 3) {
                float* so = a->out + (samp ? O_SCS : O_SCP) + ((size_t)b * 3 + (t - (T - 3))) * 1536 + ch;
                *(f32x4*)so = (f32x4){cur[0], cur[1], cur[2], cur[3]};
                *(f32x4*)(so + 4) = (f32x4){cur[4], cur[5], cur[6], cur[7]};
            }
        }
        if (lane < 4) {
            const float av = AB[(size_t)r * 8 + lane], bv = AB[(size_t)r * 8 + 4 + lane];
            const float sp = av + a->in[15][lane];
            const float softplus = sp > 20.f ? sp : log1pf(expf(sp));
            GD[(size_t)r * 4 + lane] = -expf(a->in[14][lane]) * softplus;
            BT[(size_t)r * 4 + lane] = 1.f / (1.f + expf(-bv));
        }
        const float* rt = RT + (size_t)(samp ? 2048 + t : t) * 16;
        float cs[8], sn[8];
        {
            const f32x4 c0 = *(const f32x4*)rt, c1 = *(const f32x4*)(rt + 4), s0 = *(const f32x4*)(rt + 8), s1 = *(const f32x4*)(rt + 12);
            cs[0] = c0[0]; cs[1] = c0[1]; cs[2] = c0[2]; cs[3] = c0[3]; cs[4] = c1[0]; cs[5] = c1[1]; cs[6] = c1[2]; cs[7] = c1[3];
            sn[0] = s0[0]; sn[1] = s0[1]; sn[2] = s0[2]; sn[3] = s0[3]; sn[4] = s1[0]; sn[5] = s1[1]; sn[6] = s1[2]; sn[7] = s1[3];
        }
        {
            float x[8], o[8];
            unpack8(*(const u32x4*)(prow + 2048 + lane * 8), x);
#pragma unroll
            for (int i = 0; i < 8; ++i) o[i] = __shfl_xor(x[i], 1);
            const int l8 = lane & 7;
            if (l8 == 0) {
#pragma unroll
                for (int i = 0; i < 8; ++i) x[i] = x[i] * cs[i] - o[i] * sn[i];
            } else if (l8 == 1) {
#pragma unroll
                for (int i = 0; i < 8; ++i) x[i] = x[i] * cs[i] + o[i] * sn[i];
            }
#pragma unroll
            for (int i = 0; i < 8; ++i) x[i] *= 0.125f;
            *(u32x4*)(QS + (size_t)r * 512 + lane * 8) = pack8(x);
        }
        {
            const int kl = lane & 15;
            float x[8], o[8];
            unpack8(*(const u32x4*)(prow + 2560 + kl * 8), x);
#pragma unroll
            for (int i = 0; i < 8; ++i) o[i] = __shfl_xor(x[i], 1);
            const int l8 = kl & 7;
            if (l8 == 0) {
#pragma unroll
                for (int i = 0; i < 8; ++i) x[i] = x[i] * cs[i] - o[i] * sn[i];
            } else if (l8 == 1) {
#pragma unroll
                for (int i = 0; i < 8; ++i) x[i] = x[i] * cs[i] + o[i] * sn[i];
            }
            const u32x4 vraw = *(const u32x4*)(prow + 2688 + kl * 8);
            if (lane < 16) {
                *(u32x4*)(KS + (size_t)r * 128 + kl * 8) = pack8(x);
                *(u32x4*)(VS + (size_t)r * 128 + kl * 8) = vraw;
                const int crow = samp ? 120 + t : t - (TP - 128);
                if (crow >= 0) {
                    float v[8]; unpack8(vraw, v);
                    float* ck = a->out + (samp ? O_CKS : O_CKP) + ((size_t)b * 128 + crow) * 128 + kl * 8;
                    float* cv = a->out + (samp ? O_CVS : O_CVP) + ((size_t)b * 128 + crow) * 128 + kl * 8;
                    *(f32x4*)ck = (f32x4){x[0], x[1], x[2], x[3]}; *(f32x4*)(ck + 4) = (f32x4){x[4], x[5], x[6], x[7]};
                    *(f32x4*)cv = (f32x4){v[0], v[1], v[2], v[3]}; *(f32x4*)(cv + 4) = (f32x4){v[4], v[5], v[6], v[7]};
                }
            }
        }
        if (samp) {
            for (int e = lane; e < 15 * 32; e += 64) {
                const int j = t * 15 + (e >> 5), c4 = (e & 31) * 4;
                const size_t d = ((size_t)b * 128 + j) * 128 + c4, s = ((size_t)b * 128 + j + 8) * 128 + c4;
                *(f32x4*)(a->out + O_CKS + d) = *(const f32x4*)(a->in[4] + s);
                *(f32x4*)(a->out + O_CVS + d) = *(const f32x4*)(a->in[5] + s);
            }
        }
    }
}

__device__ __forceinline__ void gdn_item(CArgs* a, LAS unsigned char* L, int item, bool samp) {
    const int tid = threadIdx.x;
    unsigned char* ws = a->ws;
    const bf16_t* GQ = (const bf16_t*)(ws + WS_GQ); const bf16_t* GK = (const bf16_t*)(ws + WS_GK); const bf16_t* GV = (const bf16_t*)(ws + WS_GV);
    const float* GD = (const float*)(ws + WS_GD); const float* BT = (const float*)(ws + WS_BT);
    unsigned char* PROJb = ws + WS_PROJ;
    const int b = item >> 4, h = (item >> 2) & 3, qd = item & 3;
    const int row0 = samp ? MP + b * TS : b * TP, T = samp ? TS : TP;
    const float* S0 = samp ? a->in[2] + (size_t)(b * 4 + h) * 16384 : nullptr;
    float* Sout = a->out + (samp ? O_SGS : O_SGP) + (size_t)(b * 4 + h) * 16384;
    const int cl = tid >> 4, part = tid & 15;
    LAS float* kb = (LAS float*)L;
    LAS float* qb = kb + 32 * 128;
    LAS float* vb = qb + 32 * 128;
    LAS float* ob = vb + 32 * 32;
    LAS float* eg = ob + 32 * 32;
    LAS float* bt = eg + 32;
    LAS float* sb = bt + 32;
    __syncthreads();
    float S[8];
    if (S0) {
        const int dk = tid >> 2, c8 = (tid & 3) * 8;
        const f32x4 s0 = *(const f32x4*)(S0 + (size_t)dk * 128 + qd * 32 + c8), s1 = *(const f32x4*)(S0 + (size_t)dk * 128 + qd * 32 + c8 + 4);
#pragma unroll
        for (int i = 0; i < 4; ++i) { sb[dk * 33 + c8 + i] = s0[i]; sb[dk * 33 + c8 + 4 + i] = s1[i]; }
        __syncthreads();
#pragma unroll
        for (int i = 0; i < 8; ++i) S[i] = sb[(part * 8 + i) * 33 + cl];
    } else {
#pragma unroll
        for (int i = 0; i < 8; ++i) S[i] = 0.f;
    }
    const int TB = T < 32 ? T : 32;
    const int ptok = tid >> 4, pch = (tid & 15) * 8;
    const int vtok = tid >> 2, vch = (tid & 3) * 8;
    const bool pk_ok = ptok < TB, pv_ok = vtok < TB && tid < 128, pe_ok = tid < TB;
    u32x4 rk = {0u, 0u, 0u, 0u}, rq = {0u, 0u, 0u, 0u}, rv = {0u, 0u, 0u, 0u}; float re = 0.f, rb = 0.f;
#define GDN_PREFETCH(t0) do { \
        if (pk_ok) { const size_t o_ = (size_t)(row0 + (t0) + ptok) * 512 + h * 128 + pch; rk = *(const u32x4*)(GK + o_); rq = *(const u32x4*)(GQ + o_); } \
        if (pv_ok) { rv = *(const u32x4*)(GV + (size_t)(row0 + (t0) + vtok) * 512 + h * 128 + qd * 32 + vch); } \
        if (pe_ok) { re = GD[(size_t)(row0 + (t0) + tid) * 4 + h]; rb = BT[(size_t)(row0 + (t0) + tid) * 4 + h]; } } while (0)
    GDN_PREFETCH(0);
    for (int t0 = 0; t0 < T; t0 += TB) {
        if (pk_ok) {
            float x[8];
            unpack8(rk, x); *(LAS f32x4*)(kb + ptok * 128 + pch) = (f32x4){x[0], x[1], x[2], x[3]}; *(LAS f32x4*)(kb + ptok * 128 + pch + 4) = (f32x4){x[4], x[5], x[6], x[7]};
            unpack8(rq, x); *(LAS f32x4*)(qb + ptok * 128 + pch) = (f32x4){x[0], x[1], x[2], x[3]}; *(LAS f32x4*)(qb + ptok * 128 + pch + 4) = (f32x4){x[4], x[5], x[6], x[7]};
        }
        if (pv_ok) { float x[8]; unpack8(rv, x); *(LAS f32x4*)(vb + vtok * 32 + vch) = (f32x4){x[0], x[1], x[2], x[3]}; *(LAS f32x4*)(vb + vtok * 32 + vch + 4) = (f32x4){x[4], x[5], x[6], x[7]}; }
        if (pe_ok) { eg[tid] = __expf(re); bt[tid] = rb; }
        __syncthreads();
        if (t0 + TB < T) GDN_PREFETCH(t0 + TB);
        for (int tok = 0; tok < TB; ++tok) {
            const f32x4 k0 = *(const LAS f32x4*)(kb + tok * 128 + part * 8), k1 = *(const LAS f32x4*)(kb + tok * 128 + part * 8 + 4);
            const f32x4 q0 = *(const LAS f32x4*)(qb + tok * 128 + part * 8), q1 = *(const LAS f32x4*)(qb + tok * 128 + part * 8 + 4);
            const float v = vb[tok * 32 + cl], e = eg[tok], be = bt[tok];
            float ks = ((k0[0] * S[0] + k0[1] * S[1]) + (k0[2] * S[2] + k0[3] * S[3])) + ((k1[0] * S[4] + k1[1] * S[5]) + (k1[2] * S[6] + k1[3] * S[7]));
            ks = reduce16(ks);
            const float vn = be * (v - e * ks);
            S[0] = e * S[0] + k0[0] * vn; S[1] = e * S[1] + k0[1] * vn; S[2] = e * S[2] + k0[2] * vn; S[3] = e * S[3] + k0[3] * vn;
            S[4] = e * S[4] + k1[0] * vn; S[5] = e * S[5] + k1[1] * vn; S[6] = e * S[6] + k1[2] * vn; S[7] = e * S[7] + k1[3] * vn;
            float o = ((q0[0] * S[0] + q0[1] * S[1]) + (q0[2] * S[2] + q0[3] * S[3])) + ((q1[0] * S[4] + q1[1] * S[5]) + (q1[2] * S[6] + q1[3] * S[7]));
            o = reduce16(o);
            if (part == 0) ob[tok * 32 + cl] = o;
        }
        __syncthreads();
        if (tid < 256) {
            const int tok = tid >> 3, c4 = (tid & 7) * 4;
            if (tok < TB) {
                float* og = (float*)(PROJb + (size_t)(row0 + t0 + tok) * (NINP * 2));
                *(f32x4*)(og + h * 128 + qd * 32 + c4) = *(const LAS f32x4*)(ob + tok * 32 + c4);
            }
        }
    }
#undef GDN_PREFETCH
    __syncthreads();
#pragma unroll
    for (int i = 0; i < 8; ++i) sb[(part * 8 + i) * 33 + cl] = S[i];
    __syncthreads();
    {
        const int dk = tid >> 2, c8 = (tid & 3) * 8;
        f32x4 s0, s1;
#pragma unroll
        for (int i = 0; i < 4; ++i) { s0[i] = sb[dk * 33 + c8 + i]; s1[i] = sb[dk * 33 + c8 + 4 + i]; }
        *(f32x4*)(Sout + (size_t)dk * 128 + qd * 32 + c8) = s0; *(f32x4*)(Sout + (size_t)dk * 128 + qd * 32 + c8 + 4) = s1;
    }
}

typedef short bf16x8 __attribute__((ext_vector_type(8)));
#define MFMA16(a_, b_, c_) __builtin_amdgcn_mfma_f32_16x16x32_bf16(a_, b_, c_, 0, 0, 0)
__device__ __forceinline__ void gdn_chunk_prep(CArgs* a, LAS unsigned char* L, int pair) {
    const int tid = threadIdx.x, hb = tid >> 8, t2 = tid & 255, w = t2 >> 6, lane = tid & 63, fr = lane & 15, fq = lane >> 4;
    unsigned char* ws = a->ws;
    bf16_t* GQ = (bf16_t*)(ws + WS_GQ); bf16_t* GK = (bf16_t*)(ws + WS_GK); const bf16_t* GV = (const bf16_t*)(ws + WS_GV);
    const float* GD = (const float*)(ws + WS_GD); const float* BT = (const float*)(ws + WS_BT);
    unsigned char* PROJb = ws + WS_PROJ; float* EGL = (float*)(ws + WS_EGL);
    const int ci = pair * 2 + hb;
    const int b = ci >> 7, h = (ci >> 5) & 3, c = ci & 31;
    const int r0 = b * TP + c * 64;
    LAS unsigned char* Lh = L + hb * 66560;
    LAS float* gcs = (LAS float*)Lh;
    LAS float* bts = gcs + 64;
    LAS float* egc = bts + 64;
    LAS float* ekd = egc + 64;
    LAS float* Af = ekd + 64;
    LAS unsigned char* STG = Lh + 1024 + 16384;
    __syncthreads();
    if (w == 0) {
        float v = GD[(size_t)(r0 + lane) * 4 + h];
#pragma unroll
        for (int o = 1; o < 64; o <<= 1) { const float t = __shfl_up(v, o); if (lane >= o) v += t; }
        const float gl = __shfl(v, 63);
        gcs[lane] = v; bts[lane] = BT[(size_t)(r0 + lane) * 4 + h]; egc[lane] = __expf(v); ekd[lane] = __expf(gl - v);
    }
#pragma unroll 2
    for (int jj = 0; jj < 8; ++jj) {
        const int e = t2 + 256 * jj, row = e >> 5, ch = e & 31;
        const bf16_t* src = (ch < 16 ? GV : (const bf16_t*)GK) + (size_t)(r0 + row) * 512 + h * 128 + (ch & 15) * 8;
        *(LAS u32x4*)(STG + row * 512 + ch * 16) = *(const u32x4*)src;
    }
    __syncthreads();
    bf16x8 aK[4], aQ[4];
    {
        const size_t o_ = (size_t)(r0 + 16 * w + fr) * 512 + h * 128 + fq * 8;
#pragma unroll
        for (int ks = 0; ks < 4; ++ks) { aK[ks] = *(const bf16x8*)(GK + o_ + ks * 32); aQ[ks] = *(const bf16x8*)(GQ + o_ + ks * 32); }
    }
    f32x4 qkd[4];
#pragma unroll
    for (int n = 0; n < 4; ++n) {
        bf16x8 bK[4];
        const size_t o_ = (size_t)(r0 + 16 * n + fr) * 512 + h * 128 + fq * 8;
#pragma unroll
        for (int ks = 0; ks < 4; ++ks) bK[ks] = *(const bf16x8*)(GK + o_ + ks * 32);
        f32x4 kk = {0.f, 0.f, 0.f, 0.f}, qk = {0.f, 0.f, 0.f, 0.f};
#pragma unroll
        for (int ks = 0; ks < 4; ++ks) { kk = MFMA16(aK[ks], bK[ks], kk); qk = MFMA16(aQ[ks], bK[ks], qk); }
        const int j = 16 * n + fr; const float gj = gcs[j];
#pragma unroll
        for (int r = 0; r < 4; ++r) {
            const int i = 16 * w + 4 * fq + r;
            const float d = (i >= j) ? __expf(gcs[i] - gj) : 0.f;
            Af[i * 64 + j] = (i > j) ? bts[i] * kk[r] * d : 0.f;
            qkd[n][r] = qk[r] * d;
        }
    }
#pragma unroll 1
    for (int jj = 0; jj < 4; ++jj) {
        const int e = t2 + 256 * jj, tok = e >> 4, ch = (e & 15) * 8;
        float x[8]; unpack8(*(const u32x4*)(GQ + (size_t)(r0 + tok) * 512 + h * 128 + ch), x);
        const float sc = egc[tok];
#pragma unroll
        for (int i = 0; i < 8; ++i) x[i] *= sc;
        *(u32x4*)((bf16_t*)(PROJb + (size_t)(r0 + tok) * (NINP * 2)) + 2048 + h * 128 + ch) = pack8(x);
    }
    const bool isU = t2 < 128; const int col = t2 & 127;
    float cv[64], x[64];
#pragma unroll
    for (int i = 0; i < 64; ++i) cv[i] = bf2f(*(const LAS bf16_t*)(STG + i * 512 + t2 * 2));
    asm volatile("s_waitcnt vmcnt(0)" ::: "memory");
    __syncthreads();
#pragma unroll
    for (int n = 0; n < 4; ++n)
#pragma unroll
        for (int r = 0; r < 4; ++r) {
            const int i = 16 * w + 4 * fq + r, j = 16 * n + fr;
            GQ[(size_t)(r0 + (i >> 1)) * 512 + h * 128 + (i & 1) * 64 + j] = (bf16_t)(cvt_pk_bf16(qkd[n][r], 0.f) & 0xffffu);
        }
    if (!isU) {
        bf16_t* dst = GK + (size_t)(r0 + (col >> 1)) * 512 + h * 128 + (col & 1) * 64;
#pragma unroll
        for (int jj = 0; jj < 8; ++jj) {
            float y[8];
#pragma unroll
            for (int i = 0; i < 8; ++i) y[i] = cv[8 * jj + i] * ekd[8 * jj + i];
            *(u32x4*)(dst + 8 * jj) = pack8(y);
        }
    }
    {
        const float um = isU ? 1.f : 0.f, km = 1.f - um;
#pragma unroll
        for (int i = 0; i < 64; ++i) x[i] = bts[i] * cv[i] * (um + km * egc[i]);
    }
    asm volatile("" ::: "memory");
#pragma unroll
    for (int i = 1; i < 64; ++i) {
        float s = x[i];
#pragma unroll
        for (int j = 0; j < i; ++j) s -= Af[i * 64 + j] * x[j];
        x[i] = s;
        asm volatile("" ::: "memory");
    }
    if (isU) {
#pragma unroll
        for (int i = 0; i < 64; ++i) *(LAS float*)(STG + (i * 128 + col) * 4) = x[i];
    } else {
#pragma unroll
        for (int i = 0; i < 64; ++i) *(LAS bf16_t*)(STG + 32768 + (i * 128 + col) * 2) = (bf16_t)(cvt_pk_bf16(x[i], 0.f) & 0xffffu);
    }
    __syncthreads();
#pragma unroll 1
    for (int jj = 0; jj < 8; ++jj) {
        const int e = t2 + 256 * jj, row = e >> 5, ch = e & 31;
        *(f32x4*)((float*)(PROJb + (size_t)(r0 + row) * (NINP * 2)) + h * 128 + ch * 4) = *(const LAS f32x4*)(STG + (row * 128 + ch * 4) * 4);
    }
#pragma unroll 1
    for (int jj = 0; jj < 4; ++jj) {
        const int e = t2 + 256 * jj, row = e >> 4, ch = e & 15;
        *(u32x4*)((bf16_t*)(PROJb + (size_t)(r0 + row) * (NINP * 2)) + 1024 + h * 128 + ch * 8) = *(const LAS u32x4*)(STG + 32768 + (row * 128 + ch * 8) * 2);
    }
    if (t2 == 0) EGL[ci] = egc[63];
}

__device__ __forceinline__ void gdn_chunk_scan(CArgs* a, LAS unsigned char* L, int item) {
    const int tid = threadIdx.x, w = __builtin_amdgcn_readfirstlane(tid >> 6), lane = tid & 63, fr = lane & 15, fq = lane >> 4;
    unsigned char* ws = a->ws;
    const bf16_t* GQ = (const bf16_t*)(ws + WS_GQ); const bf16_t* GK = (const bf16_t*)(ws + WS_GK);
    const unsigned char* PROJb = ws + WS_PROJ; const float* EGL = (const float*)(ws + WS_EGL); bf16_t* MIX = (bf16_t*)(ws + WS_MIX);
    const int b = item >> 2, h = item & 3;
    LAS unsigned char* St = L;
    LAS unsigned char* Vn = L + 34816;
    LAS float* ssp = (LAS float*)(L + 53248);
    LAS unsigned char* Wl = L + 57344;
    LAS unsigned char* Ql = Wl + 17408;
    LAS unsigned char* Kl = Ql + 17408;
    LAS unsigned char* Xl = Kl + 18432;
    f32x4 Sacc[8];
#pragma unroll
    for (int n = 0; n < 8; ++n) Sacc[n] = (f32x4){0.f, 0.f, 0.f, 0.f};
    const f32x4 gnv = *(const f32x4*)(a->in[16] + 16 * w + 4 * fq);
    u32x4 pfW[2], pfQ[2], pfK[2], pfX; f32x4 pfU[4]; u32x2 pfZ[4]; float pfE;
    const int s_row = tid >> 4, s_ch = tid & 15;
    const int k_dk = tid >> 3, k_ch = tid & 7;
#define SCAN_PREFETCH(cc) do { const int r0_ = b * TP + (cc) * 64; \
        _Pragma("unroll") for (int jj = 0; jj < 2; ++jj) { \
            const unsigned char* pr_ = PROJb + (size_t)(r0_ + s_row + 32 * jj) * (NINP * 2); \
            pfW[jj] = *(const u32x4*)((const bf16_t*)pr_ + 1024 + h * 128 + s_ch * 8); \
            pfQ[jj] = *(const u32x4*)((const bf16_t*)pr_ + 2048 + h * 128 + s_ch * 8); \
            const int dk_ = k_dk + 64 * jj; \
            pfK[jj] = *(const u32x4*)(GK + (size_t)(r0_ + (dk_ >> 1)) * 512 + h * 128 + (dk_ & 1) * 64 + k_ch * 8); } \
        pfX = *(const u32x4*)(GQ + (size_t)(r0_ + (k_dk >> 1)) * 512 + h * 128 + (k_dk & 1) * 64 + k_ch * 8); \
        _Pragma("unroll") for (int n = 0; n < 4; ++n) { \
            const unsigned char* pr_ = PROJb + (size_t)(r0_ + 16 * n + fr) * (NINP * 2); \
            pfU[n] = *(const f32x4*)((const float*)pr_ + h * 128 + 16 * w + 4 * fq); \
            pfZ[n] = *(const u32x2*)((const bf16_t*)pr_ + 1536 + h * 128 + 16 * w + 4 * fq); } \
        pfE = EGL[(b * 4 + h) * 32 + (cc)]; } while (0)
#define SCAN_STAGE() do { \
        _Pragma("unroll") for (int jj = 0; jj < 2; ++jj) { \
            *(LAS u32x4*)(Wl + (s_row + 32 * jj) * 272 + s_ch * 16) = pfW[jj]; \
            *(LAS u32x4*)(Ql + (s_row + 32 * jj) * 272 + s_ch * 16) = pfQ[jj]; \
            *(LAS u32x4*)(Kl + (k_dk + 64 * jj) * 144 + k_ch * 16) = pfK[jj]; } \
        *(LAS u32x4*)(Xl + k_dk * 144 + k_ch * 16) = pfX; } while (0)
    __syncthreads();
    SCAN_PREFETCH(0);
    SCAN_STAGE();
    for (int c = 0; c < 32; ++c) {
        const int r0 = b * TP + c * 64;
        f32x4 cu[4]; u32x2 cz[4];
#pragma unroll
        for (int n = 0; n < 4; ++n) { cu[n] = pfU[n]; cz[n] = pfZ[n]; }
        const float eg = pfE;
        __syncthreads();
        if (c + 1 < 32) SCAN_PREFETCH(c + 1);
#pragma unroll
        for (int n8 = 0; n8 < 8; ++n8)
#pragma unroll
            for (int r = 0; r < 4; ++r) *(LAS bf16_t*)(St + (16 * w + 4 * fq + r) * 272 + (16 * n8 + fr) * 2) = (bf16_t)(cvt_pk_bf16(Sacc[n8][r], 0.f) & 0xffffu);
        LDS_WAIT();
        bf16x8 sA[4];
#pragma unroll
        for (int ks = 0; ks < 4; ++ks) sA[ks] = *(const LAS bf16x8*)(St + (16 * w + fr) * 272 + (ks * 32 + fq * 8) * 2);
        f32x4 vn[4], oa[4];
#pragma unroll
        for (int n = 0; n < 4; ++n) {
            f32x4 acc = {0.f, 0.f, 0.f, 0.f}, o = {0.f, 0.f, 0.f, 0.f};
#pragma unroll
            for (int ks = 0; ks < 4; ++ks) {
                acc = MFMA16(sA[ks], *(const LAS bf16x8*)(Wl + (16 * n + fr) * 272 + (ks * 32 + fq * 8) * 2), acc);
                o = MFMA16(sA[ks], *(const LAS bf16x8*)(Ql + (16 * n + fr) * 272 + (ks * 32 + fq * 8) * 2), o);
            }
            vn[n] = cu[n] - acc; oa[n] = o;
        }
#pragma unroll
        for (int n = 0; n < 4; ++n)
#pragma unroll
            for (int r = 0; r < 4; ++r) *(LAS bf16_t*)(Vn + (16 * w + 4 * fq + r) * 144 + (16 * n + fr) * 2) = (bf16_t)(cvt_pk_bf16(vn[n][r], 0.f) & 0xffffu);
        LDS_WAIT();
        bf16x8 vA[2];
#pragma unroll
        for (int k2 = 0; k2 < 2; ++k2) vA[k2] = *(const LAS bf16x8*)(Vn + (16 * w + fr) * 144 + (k2 * 32 + fq * 8) * 2);
#pragma unroll
        for (int n = 0; n < 4; ++n)
#pragma unroll
            for (int k2 = 0; k2 < 2; ++k2) oa[n] = MFMA16(vA[k2], *(const LAS bf16x8*)(Xl + (16 * n + fr) * 144 + (k2 * 32 + fq * 8) * 2), oa[n]);
#pragma unroll
        for (int n8 = 0; n8 < 8; ++n8) {
            f32x4 sv = Sacc[n8] * eg;
#pragma unroll
            for (int k2 = 0; k2 < 2; ++k2) sv = MFMA16(vA[k2], *(const LAS bf16x8*)(Kl + (16 * n8 + fr) * 144 + (k2 * 32 + fq * 8) * 2), sv);
            Sacc[n8] = sv;
        }
        LAS float* sp = ssp + (c & 1) * 512;
#pragma unroll
        for (int n = 0; n < 4; ++n) {
            float q = (oa[n][0] * oa[n][0] + oa[n][1] * oa[n][1]) + (oa[n][2] * oa[n][2] + oa[n][3] * oa[n][3]);
            q += __shfl_xor(q, 16); q += __shfl_xor(q, 32);
            if (fq == 0) sp[w * 64 + 16 * n + fr] = q;
        }
        __syncthreads();
        if (c + 1 < 32) SCAN_STAGE();
#pragma unroll
        for (int n = 0; n < 4; ++n) {
            const int tok = 16 * n + fr;
            float tot = 0.f;
#pragma unroll
            for (int ww = 0; ww < 8; ++ww) tot += sp[ww * 64 + tok];
            const float rs = rsqrtf(tot * (1.f / 128.f) + EPS);
            const u32x2 zr = cz[n];
            const float z0 = bf2f(zr.x & 0xffffu), z1 = bf2f(zr.x >> 16), z2 = bf2f(zr.y & 0xffffu), z3 = bf2f(zr.y >> 16);
            u32x2 ow;
            ow.x = cvt_pk_bf16(oa[n][0] * rs * gnv[0] * (z0 * sigmoidf_(z0)), oa[n][1] * rs * gnv[1] * (z1 * sigmoidf_(z1)));
            ow.y = cvt_pk_bf16(oa[n][2] * rs * gnv[2] * (z2 * sigmoidf_(z2)), oa[n][3] * rs * gnv[3] * (z3 * sigmoidf_(z3)));
            *(u32x2*)(MIX + (size_t)(r0 + tok) * 1024 + h * 128 + 16 * w + 4 * fq) = ow;
        }
    }
#undef SCAN_PREFETCH
#undef SCAN_STAGE
    float* Sout = a->out + O_SGP + (size_t)(b * 4 + h) * 16384;
#pragma unroll
    for (int n8 = 0; n8 < 8; ++n8) *(f32x4*)(Sout + (size_t)(16 * n8 + fr) * 128 + 16 * w + 4 * fq) = Sacc[n8];
}

__device__ __forceinline__ void swa_item(CArgs* a, LAS unsigned char* L, int it) {
    const int tid = threadIdx.x, lane = tid & 63, wave = tid >> 6;
    unsigned char* ws = a->ws;
    const bf16_t* QS = (const bf16_t*)(ws + WS_QS); const bf16_t* KS = (const bf16_t*)(ws + WS_KS); const bf16_t* VS = (const bf16_t*)(ws + WS_VS);
    bf16_t* MIX = (bf16_t*)(ws + WS_MIX);
    const bool samp = it >= 2048;
    int b, kvh, tq0, nq, row0;
    if (!samp) { b = it >> 7; const int rem = it & 127; kvh = rem & 1; tq0 = (rem >> 1) * 32; nq = 32; row0 = b * TP; }
    else { const int i2 = it - 2048; b = i2 >> 1; kvh = i2 & 1; tq0 = 0; nq = TS; row0 = MP + b * TS; }
    const int nrows = 127 + nq;
    LAS float* Kf = (LAS float*)L;
    LAS float* Vf = Kf + 159 * 68;
    LAS float* Qw = Vf + 159 * 68;
    LAS float* Pw = Qw + 8 * 256;
    __syncthreads();
    for (int e = tid; e < nrows * 8; e += 512) {
        const int j = e >> 3, d8 = (e & 7) * 8, p = tq0 - 127 + j;
        float kx[8], vx[8];
        if (p >= 0) {
            const size_t o_ = (size_t)(row0 + p) * 128 + kvh * 64 + d8;
            unpack8(*(const u32x4*)(KS + o_), kx); unpack8(*(const u32x4*)(VS + o_), vx);
        } else if (samp) {
            const size_t o_ = ((size_t)b * 128 + (128 + p)) * 128 + kvh * 64 + d8;
            const f32x4 k0 = *(const f32x4*)(a->in[4] + o_), k1 = *(const f32x4*)(a->in[4] + o_ + 4), v0 = *(const f32x4*)(a->in[5] + o_), v1 = *(const f32x4*)(a->in[5] + o_ + 4);
#pragma unroll
            for (int i = 0; i < 4; ++i) { kx[i] = k0[i]; kx[4 + i] = k1[i]; vx[i] = v0[i]; vx[4 + i] = v1[i]; }
        } else {
#pragma unroll
            for (int i = 0; i < 8; ++i) { kx[i] = 0.f; vx[i] = 0.f; }
        }
        *(LAS f32x4*)(Kf + j * 68 + d8) = (f32x4){kx[0], kx[1], kx[2], kx[3]}; *(LAS f32x4*)(Kf + j * 68 + d8 + 4) = (f32x4){kx[4], kx[5], kx[6], kx[7]};
        *(LAS f32x4*)(Vf + j * 68 + d8) = (f32x4){vx[0], vx[1], vx[2], vx[3]}; *(LAS f32x4*)(Vf + j * 68 + d8 + 4) = (f32x4){vx[4], vx[5], vx[6], vx[7]};
    }
    __syncthreads();
    LAS float* Qm = Qw + wave * 256;
    LAS float* Pm = Pw + wave * 512;
    for (int i = wave; i < nq; i += 8) {
        const int row = row0 + tq0 + i;
        {
            const u32x2 rq = *(const u32x2*)(QS + (size_t)row * 512 + kvh * 256 + lane * 4);
            *(LAS f32x4*)(Qm + lane * 4) = (f32x4){bf2f(rq.x & 0xffffu), bf2f(rq.x >> 16), bf2f(rq.y & 0xffffu), bf2f(rq.y >> 16)};
        }
        LDS_WAIT();
        float s[2][4];
#pragma unroll
        for (int kk = 0; kk < 2; ++kk) {
            const int j = i + lane + 64 * kk;
            const LAS float* kr = Kf + j * 68;
            float ac[4] = {0.f, 0.f, 0.f, 0.f};
#pragma unroll 4
            for (int d4 = 0; d4 < 16; ++d4) {
                const f32x4 kv = *(const LAS f32x4*)(kr + d4 * 4);
#pragma unroll
                for (int hh = 0; hh < 4; ++hh) {
                    const f32x4 qv = *(const LAS f32x4*)(Qm + hh * 64 + d4 * 4);
                    ac[hh] += (kv[0] * qv[0] + kv[1] * qv[1]) + (kv[2] * qv[2] + kv[3] * qv[3]);
                }
            }
            const bool valid = samp || (tq0 - 127 + j >= 0);
#pragma unroll
            for (int hh = 0; hh < 4; ++hh) s[kk][hh] = valid ? ac[hh] : -INFINITY;
        }
        f32x4 p0, p1;
#pragma unroll
        for (int hh = 0; hh < 4; ++hh) {
            const float sk = a->in[17][kvh * 4 + hh];
            float mx = wave_max(fmaxf(s[0][hh], s[1][hh]));
            mx = fmaxf(mx, sk);
            const float e0 = __expf(s[0][hh] - mx), e1 = __expf(s[1][hh] - mx);
            const float den = wave_sum(e0 + e1) + __expf(sk - mx);
            const float inv = 1.f / den;
            p0[hh] = e0 * inv; p1[hh] = e1 * inv;
        }
        *(LAS f32x4*)(Pm + lane * 4) = p0; *(LAS f32x4*)(Pm + (lane + 64) * 4) = p1;
        LDS_WAIT();
        float o[4] = {0.f, 0.f, 0.f, 0.f};
#pragma unroll 8
        for (int jj = 0; jj < 128; ++jj) {
            const f32x4 pj = *(const LAS f32x4*)(Pm + jj * 4);
            const float v = Vf[(i + jj) * 68 + lane];
            o[0] += pj[0] * v; o[1] += pj[1] * v; o[2] += pj[2] * v; o[3] += pj[3] * v;
        }
#pragma unroll
        for (int hh = 0; hh < 4; ++hh) MIX[(size_t)row * 1024 + 512 + (kvh * 4 + hh) * 64 + lane] = (bf16_t)(cvt_pk_bf16(o[hh], 0.f) & 0xffffu);
        LDS_WAIT();
    }
}

__device__ __forceinline__ void swa_item_mfma(CArgs* a, LAS unsigned char* L, int it) {
    const int tid = threadIdx.x, w = __builtin_amdgcn_readfirstlane(tid >> 6), lane = tid & 63, fr = lane & 15, fq = lane >> 4;
    unsigned char* ws = a->ws;
    const bf16_t* QS = (const bf16_t*)(ws + WS_QS); const bf16_t* KS = (const bf16_t*)(ws + WS_KS); const bf16_t* VS = (const bf16_t*)(ws + WS_VS);
    bf16_t* MIX = (bf16_t*)(ws + WS_MIX);
    const bool samp = it >= 1024;
    int b, kvh, tq0, nq, row0;
    if (!samp) { b = it >> 6; const int rem = it & 63; kvh = rem & 1; tq0 = (rem >> 1) * 64; nq = 64; row0 = b * TP; }
    else { const int i2 = it - 1024; b = i2 >> 1; kvh = i2 & 1; tq0 = 0; nq = TS; row0 = MP + b * TS; }
    LAS unsigned char* Ks = L;
    LAS unsigned char* Vt = L + 208 * 144;
    __syncthreads();
    for (int e = tid; e < 208 * 8; e += 512) {
        const int j = e >> 3, d8 = (e & 7) * 8, p = tq0 - 127 + j;
        u32x4 kraw = {0u, 0u, 0u, 0u}, vraw = {0u, 0u, 0u, 0u};
        if (j < 127 + nq) {
            if (p >= 0) { const size_t o_ = (size_t)(row0 + p) * 128 + kvh * 64 + d8; kraw = *(const u32x4*)(KS + o_); vraw = *(const u32x4*)(VS + o_); }
            else if (samp) {
                const size_t o_ = ((size_t)b * 128 + (128 + p)) * 128 + kvh * 64 + d8;
                const f32x4 k0 = *(const f32x4*)(a->in[4] + o_), k1 = *(const f32x4*)(a->in[4] + o_ + 4), v0 = *(const f32x4*)(a->in[5] + o_), v1 = *(const f32x4*)(a->in[5] + o_ + 4);
                kraw.x = cvt_pk_bf16(k0[0], k0[1]); kraw.y = cvt_pk_bf16(k0[2], k0[3]); kraw.z = cvt_pk_bf16(k1[0], k1[1]); kraw.w = cvt_pk_bf16(k1[2], k1[3]);
                vraw.x = cvt_pk_bf16(v0[0], v0[1]); vraw.y = cvt_pk_bf16(v0[2], v0[3]); vraw.z = cvt_pk_bf16(v1[0], v1[1]); vraw.w = cvt_pk_bf16(v1[2], v1[3]);
            }
        }
        *(LAS u32x4*)(Ks + j * 144 + d8 * 2) = kraw;
        LAS unsigned char* vp = Vt + d8 * 432 + j * 2;
        *(LAS bf16_t*)(vp + 0 * 432) = (bf16_t)(vraw.x & 0xffffu); *(LAS bf16_t*)(vp + 1 * 432) = (bf16_t)(vraw.x >> 16);
        *(LAS bf16_t*)(vp + 2 * 432) = (bf16_t)(vraw.y & 0xffffu); *(LAS bf16_t*)(vp + 3 * 432) = (bf16_t)(vraw.y >> 16);
        *(LAS bf16_t*)(vp + 4 * 432) = (bf16_t)(vraw.z & 0xffffu); *(LAS bf16_t*)(vp + 5 * 432) = (bf16_t)(vraw.z >> 16);
        *(LAS bf16_t*)(vp + 6 * 432) = (bf16_t)(vraw.w & 0xffffu); *(LAS bf16_t*)(vp + 7 * 432) = (bf16_t)(vraw.w >> 16);
    }
    __syncthreads();
    const int head = kvh * 4 + (w & 3);
    const float sink = a->in[17][head];
    for (int qt = (w >> 2) * 2; qt < (w >> 2) * 2 + 2; ++qt) {
        const int ql0 = qt * 16;
        if (ql0 >= nq) break;
        const int ql = ql0 + fr, qrow = ql < nq ? ql : nq - 1;
        bf16x8 qB[2];
#pragma unroll
        for (int ks = 0; ks < 2; ++ks) qB[ks] = *(const bf16x8*)(QS + (size_t)(row0 + tq0 + qrow) * 512 + head * 64 + ks * 32 + fq * 8);
        f32x4 st[10];
#pragma unroll
        for (int t = 0; t < 10; ++t) {
            f32x4 acc = {0.f, 0.f, 0.f, 0.f};
#pragma unroll
            for (int ks = 0; ks < 2; ++ks) acc = MFMA16(*(const LAS bf16x8*)(Ks + (ql0 + 16 * t + fr) * 144 + (ks * 32 + fq * 8) * 2), qB[ks], acc);
            st[t] = acc;
        }
        float mx = sink;
#pragma unroll
        for (int t = 0; t < 10; ++t)
#pragma unroll
            for (int r = 0; r < 4; ++r) {
                const int j = ql0 + 16 * t + 4 * fq + r, diff = ql + 127 - j;
                const bool valid = diff >= 0 && diff < 128 && (samp || tq0 - 127 + j >= 0);
                st[t][r] = valid ? st[t][r] : -INFINITY;
                mx = fmaxf(mx, st[t][r]);
            }
        mx = fmaxf(mx, __shfl_xor(mx, 16)); mx = fmaxf(mx, __shfl_xor(mx, 32));
        float sum = 0.f;
#pragma unroll
        for (int t = 0; t < 10; ++t)
#pragma unroll
            for (int r = 0; r < 4; ++r) { const float p = __expf(st[t][r] - mx); st[t][r] = p; sum += p; }
        sum += __shfl_xor(sum, 16); sum += __shfl_xor(sum, 32);
        const float inv = 1.f / (sum + __expf(sink - mx));
        f32x4 oa[4];
#pragma unroll
        for (int mt = 0; mt < 4; ++mt) oa[mt] = (f32x4){0.f, 0.f, 0.f, 0.f};
#pragma unroll
        for (int s2 = 0; s2 < 5; ++s2) {
            u32x4 pw;
            pw.x = cvt_pk_bf16(st[2 * s2][0], st[2 * s2][1]); pw.y = cvt_pk_bf16(st[2 * s2][2], st[2 * s2][3]);
            pw.z = cvt_pk_bf16(st[2 * s2 + 1][0], st[2 * s2 + 1][1]); pw.w = cvt_pk_bf16(st[2 * s2 + 1][2], st[2 * s2 + 1][3]);
            const bf16x8 pB = __builtin_bit_cast(bf16x8, pw);
#pragma unroll
            for (int mt = 0; mt < 4; ++mt) {
                const LAS unsigned char* vp = Vt + (16 * mt + fr) * 432 + (ql0 + 32 * s2 + 4 * fq) * 2;
                const u32x2 v0 = *(const LAS u32x2*)vp, v1 = *(const LAS u32x2*)(vp + 32);
                u32x4 vw; vw.x = v0.x; vw.y = v0.y; vw.z = v1.x; vw.w = v1.y;
                oa[mt] = MFMA16(__builtin_bit_cast(bf16x8, vw), pB, oa[mt]);
            }
        }
        if (ql < nq) {
            bf16_t* dst = MIX + (size_t)(row0 + tq0 + ql) * 1024 + 512 + head * 64 + 4 * fq;
#pragma unroll
            for (int mt = 0; mt < 4; ++mt) {
                u32x2 ow; ow.x = cvt_pk_bf16(oa[mt][0] * inv, oa[mt][1] * inv); ow.y = cvt_pk_bf16(oa[mt][2] * inv, oa[mt][3] * inv);
                *(u32x2*)(dst + 16 * mt) = ow;
            }
        }
    }
}

__device__ __forceinline__ void p5b_finalize(CArgs* a) {
    const int tid = threadIdx.x, lane = tid & 63, wave = tid >> 6;
    unsigned char* ws = a->ws;
    const unsigned char* PROJb = ws + WS_PROJ; bf16_t* MIX = (bf16_t*)(ws + WS_MIX);
    const int gw = blockIdx.x * 8 + wave, NGW = gridDim.x * 8;
    const float* gn = a->in[16] + (lane & 15) * 8;
    const f32x4 g0 = *(const f32x4*)gn, g1 = *(const f32x4*)(gn + 4);
    for (int r = MP + gw; r < M; r += NGW) {
        const float* og = (const float*)(PROJb + (size_t)r * (NINP * 2)) + lane * 8;
        const f32x4 o0 = *(const f32x4*)og, o1 = *(const f32x4*)(og + 4);
        float z[8]; unpack8(*(const u32x4*)((const bf16_t*)(PROJb + (size_t)r * (NINP * 2)) + 1536 + lane * 8), z);
        float ssq = (o0[0] * o0[0] + o0[1] * o0[1]) + (o0[2] * o0[2] + o0[3] * o0[3]) + (o1[0] * o1[0] + o1[1] * o1[1]) + (o1[2] * o1[2] + o1[3] * o1[3]);
        ssq += __shfl_xor(ssq, 1); ssq += __shfl_xor(ssq, 2); ssq += __shfl_xor(ssq, 4); ssq += __shfl_xor(ssq, 8);
        const float rs = rsqrtf(ssq * (1.f / 128.f) + EPS);
        float x[8];
#pragma unroll
        for (int i = 0; i < 4; ++i) { x[i] = o0[i] * rs * g0[i] * (z[i] * sigmoidf_(z[i])); x[4 + i] = o1[i] * rs * g1[i] * (z[4 + i] * sigmoidf_(z[4 + i])); }
        *(u32x4*)(MIX + (size_t)r * 1024 + lane * 8) = pack8(x);
    }
}

__device__ __forceinline__ void p10_final(CArgs* a) {
    const int tid = threadIdx.x, lane = tid & 63, wave = tid >> 6;
    const float* SS5 = (const float*)(a->ws + WS_SS) + 4 * (size_t)M;
    const int gw = blockIdx.x * 8 + wave, NGW = gridDim.x * 8;
    f32x4 g[4];
#pragma unroll
    for (int j = 0; j < 4; ++j) g[j] = ((const f32x4*)a->in[25])[lane + 64 * j];
    for (int r = gw; r < M; r += NGW) {
        const float rs = rsqrtf(SS5[r] * (1.f / DM) + EPS);
        f32x4* y = (f32x4*)(a->out + O_Y + (size_t)r * DM);
#pragma unroll
        for (int j = 0; j < 4; ++j) { const f32x4 v = y[lane + 64 * j]; y[lane + 64 * j] = v * rs * g[j]; }
    }
}

constexpr int NPHASE = 13;
#ifndef PHMASK
#define PHMASK 0x1FFF
#endif
#ifndef DUP_MISC
#define DUP_MISC 1
#endif
__global__ void __launch_bounds__(512, 2) mk_fwd(Args a_by_value) {
    extern __shared__ __attribute__((aligned(16))) unsigned char lds_raw[];
    LAS unsigned char* L = (LAS unsigned char*)lds_raw;
    cg::grid_group grid = cg::this_grid();
    const int lo = get_args()->ph_lo, hi = get_args()->ph_hi, G = gridDim.x, bid = blockIdx.x;
#define IN(k) (((PHMASK >> (k)) & 1) && lo <= (k) && (k) < hi)
#define SEAM(k) do { if (IN(k) && IN((k) + 1)) grid.sync(); } while (0)
#define PH_ARGS() CArgs* a = get_args(); unsigned char* ws = a->ws; (void)ws
    if (IN(0)) { PH_ARGS(); for (int rep = 0; rep < DUP_MISC; ++rep) p0_prologue(a, L); } SEAM(0);
    if (IN(1)) {
        PH_ARGS(); float* SS = (float*)(ws + WS_SS);
        pg8::Gemm g{(const bf16_t*)(ws + WS_HB), (const bf16_t*)(ws + WS_GU1), M, NGU, DM}; pg8::StaticOrder S; S.init(M, NGU, G, bid);
        EpiSwiglu E{(bf16_t*)(ws + WS_ACT), SS};
#ifndef DUP_P1
#define DUP_P1 1
#endif
        for (int rep = 0; rep < DUP_P1; ++rep)
        pg8::gemm_phase<EpiSwiglu, pg8::StaticOrder, true, true>(L, g, S, E);
    } SEAM(1);
    if (IN(2)) {
        PH_ARGS(); float* SS = (float*)(ws + WS_SS);
        pg8::Gemm g{(const bf16_t*)(ws + WS_ACT), (const bf16_t*)(ws + WS_D1), M, DM, DFF}; pg8::StaticOrder S; S.init(M, DM, G, bid);
        EpiResid E{a->in[0], a->in[1], a->out + O_Y, (bf16_t*)(ws + WS_HB), SS + M, 0.5f};
        pg8::gemm_phase<EpiResid, pg8::StaticOrder, true, true>(L, g, S, E);
    } SEAM(2);
    if (IN(3)) {
        PH_ARGS(); float* SS = (float*)(ws + WS_SS);
        pg8::Gemm g{(const bf16_t*)(ws + WS_HB), (const bf16_t*)(ws + WS_IN), M, NINP, DM}; pg8::StaticOrder S; S.init(M, NINP, G, bid);
        EpiProj E{(bf16_t*)(ws + WS_PROJ), SS + M, (float*)(ws + WS_AB)};
        pg8::gemm_phase<EpiProj, pg8::StaticOrder, true, true>(L, g, S, E);
    } SEAM(3);
    if (IN(4)) { PH_ARGS(); for (int rep = 0; rep < DUP_MISC; ++rep) p4_mixprep(a); } SEAM(4);
    if (IN(5)) { PH_ARGS(); for (int pr = bid; pr < 1024; pr += G) gdn_chunk_prep(a, L, pr); } SEAM(5);
    if (IN(6)) {
        PH_ARGS();
        const int nded = G >= 128 ? 64 : 0;
        if (bid < nded) gdn_chunk_scan(a, L, bid);
        unsigned* ctr = (unsigned*)(ws + WS_CTR);
        LAS unsigned* wq = (LAS unsigned*)(L + 131072);
        const int nitems = (nded ? 0 : 64) + 2048 + 1280;
        for (;;) {
            __syncthreads();
            if (threadIdx.x == 0) *wq = __hip_atomic_fetch_add(ctr, 1u, __ATOMIC_RELAXED, __HIP_MEMORY_SCOPE_AGENT);
            __syncthreads();
            int it = (int)*wq;
            if (it >= nitems) break;
            if (!nded) { if (it < 64) { gdn_chunk_scan(a, L, it); continue; } it -= 64; }
            if (it < 1280) swa_item_mfma(a, L, it);
            else gdn_item(a, L, it - 1280, true);
        }
    } SEAM(6);
    if (IN(7)) { PH_ARGS(); p5b_finalize(a); } SEAM(7);
    if (IN(8)) {
        PH_ARGS(); float* SS = (float*)(ws + WS_SS); float* HF = a->out + O_Y;
        pg8::Gemm g{(const bf16_t*)(ws + WS_MIX), (const bf16_t*)(ws + WS_OUT), M, DM, DM}; pg8::StaticOrder S; S.init(M, DM, G, bid);
        EpiResid E{HF, HF + (size_t)MP * DM, HF, (bf16_t*)(ws + WS_HB), SS + 2 * M, 1.0f};
        pg8::gemm_phase<EpiResid, pg8::StaticOrder, true, true>(L, g, S, E);
    } SEAM(8);
    if (IN(9)) {
        PH_ARGS(); float* SS = (float*)(ws + WS_SS);
        pg8::Gemm g{(const bf16_t*)(ws + WS_HB), (const bf16_t*)(ws + WS_GU2), M, NGU, DM}; pg8::StaticOrder S; S.init(M, NGU, G, bid);
        EpiSwiglu E{(bf16_t*)(ws + WS_ACT), SS + 2 * M};
        pg8::gemm_phase<EpiSwiglu, pg8::StaticOrder, true, true>(L, g, S, E);
    } SEAM(9);
    if (IN(10)) {
        {
            PH_ARGS(); float* SS = (float*)(ws + WS_SS); float* HF = a->out + O_Y;
            pg8::Gemm g{(const bf16_t*)(ws + WS_ACT), (const bf16_t*)(ws + WS_D2), M, DM, DFF}; pg8::StaticOrder S; S.init(M, DM, G, bid);
            EpiResid E{HF, HF + (size_t)MP * DM, HF, (bf16_t*)(ws + WS_HB), SS + 3 * M, 0.5f};
            pg8::gemm_phase<EpiResid, pg8::StaticOrder, true, true>(L, g, S, E);
        }
        {
            PH_ARGS();
            int kple = PLE; asm volatile("" : "+s"(kple)); kple = __builtin_amdgcn_readfirstlane(kple);
            pg8::Gemm g{(const bf16_t*)(ws + WS_PB), (const bf16_t*)(ws + WS_PPW), M, DM, kple}; pg8::StaticOrder S; S.init(M, DM, G, bid);
            EpiPlain E{(bf16_t*)(ws + WS_PP)};
            pg8::gemm_phase<EpiPlain, pg8::StaticOrder, true, true>(L, g, S, E);
        }
    } SEAM(10);
    if (IN(11)) {
        PH_ARGS(); float* SS = (float*)(ws + WS_SS);
        pg8::Gemm g{(const bf16_t*)(ws + WS_HB), (const bf16_t*)(ws + WS_PG), M, DM, DM}; pg8::StaticOrder S; S.init(M, DM, G, bid);
        EpiGate E{a->out + O_Y, (const bf16_t*)(ws + WS_PP), SS + 3 * M, SS + 4 * M};
        pg8::gemm_phase<EpiGate, pg8::StaticOrder, true, true>(L, g, S, E);
    } SEAM(11);
    if (IN(12)) { PH_ARGS(); p10_final(a); }
#undef IN
#undef SEAM
#undef PH_ARGS
}

#ifndef MK_LAUNCHES
#define MK_LAUNCHES 1
#endif
extern "C" void kernel_launch(void* const* d_in, const int* in_sizes, int n_in, void* d_out, int out_size, void* d_ws, size_t ws_size, hipStream_t stream) {
    static int grid = 0;
    if (grid == 0) {
        if (n_in != 26 || (size_t)out_size != O_END || ws_size < WS_END) {
            fprintf(stderr, "kernel_launch: unexpected shapes: n_in %d out %d ws %zu (need out %zu, ws >= %zu)\n", n_in, out_size, ws_size, (size_t)O_END, (size_t)WS_END);
            grid = -1; return;
        }
        int dev = 0, cus = 0, per_cu = 0;
        hipGetDevice(&dev);
        hipDeviceGetAttribute(&cus, hipDeviceAttributeMultiprocessorCount, dev);
        if (hipFuncSetAttribute((const void*)mk_fwd, hipFuncAttributeMaxDynamicSharedMemorySize, LDS_BYTES) != hipSuccess) { fprintf(stderr, "kernel_launch: hipFuncSetAttribute failed\n"); grid = -1; return; }
        if (hipOccupancyMaxActiveBlocksPerMultiprocessor(&per_cu, (const void*)mk_fwd, 512, LDS_BYTES) != hipSuccess || per_cu < 1) { fprintf(stderr, "kernel_launch: occupancy query gave %d\n", per_cu); per_cu = 1; }
        (void)hipGetLastError();
        grid = cus * per_cu;
        fprintf(stderr, "kernel_launch: grid %d (cus %d x %d)\n", grid, cus, per_cu);
    }
    if (grid < 0) return;
    Args a{};
    for (int i = 0; i < 26; ++i) a.in[i] = (const float*)d_in[i];
    a.out = (float*)d_out; a.ws = (unsigned char*)d_ws;
#if MK_LAUNCHES == 1
    a.ph_lo = 0; a.ph_hi = NPHASE;
    void* kargs[] = {&a};
    hipError_t e = hipLaunchCooperativeKernel((const void*)mk_fwd, dim3(grid), dim3(512), kargs, LDS_BYTES, stream);
    if (e != hipSuccess) fprintf(stderr, "kernel_launch: cooperative launch failed: %s (grid %d)\n", hipGetErrorString(e), grid);
#else
    for (int p = 0; p < NPHASE; ++p) {
        a.ph_lo = p; a.ph_hi = p + 1;
        hipLaunchKernelGGL(mk_fwd, dim3(grid), dim3(512), LDS_BYTES, stream, a);
    }
#endif
}
```

```cpp
#include <hip/hip_runtime.h>
#include <hip/hip_cooperative_groups.h>
#include <cstdio>
#include <cstdint>
namespace cg = cooperative_groups;
namespace pg8 {
#define PG8_LAS __attribute__((address_space(3)))
typedef unsigned short bf16_t;
typedef short bf16x8 __attribute__((ext_vector_type(8)));
typedef float f32x4 __attribute__((ext_vector_type(4)));
typedef unsigned u32x4 __attribute__((ext_vector_type(4)));
constexpr int BM = 256, BK = 64, HALF = 128, HTB = HALF * BK * 2  , STAGE_BYTES = 8 * HTB, NXCD = 8, WGM = 8;

__host__ __device__ __forceinline__ int lds_byte(int r, int c) { const int st = (r >> 4) * 2 + (c >> 5), rr = r & 15, cc = c & 31, ob = rr * 64 + cc * 2; return st * 1024 + (ob ^ (((ob >> 9) & 1) << 5)); }
__host__ __device__ __forceinline__ void stage_rc(int b, int& R, int& C) { const int st = b / 1024, sb = b % 1024, swz = sb ^ (((sb >> 9) & 1) << 5); R = (st >> 1) * 16 + swz / 64; C = (st & 1) * 32 + (swz % 64) / 2; }
__host__ __device__ __forceinline__ int perm32(int rho) { const int n = rho >> 4, i = rho & 15; return 8 * (i >> 2) + 4 * n + (i & 3); }

struct Unit { int pm, pn; };
struct Gemm { const bf16_t* A; const bf16_t* Bt; int M, N, K; };

struct StaticOrder {
    int nM, nN, nwg, G, c;
    __host__ __device__ void init(int M, int N, int G_, int c_) { nM = M / BM; nN = N / BM; nwg = nM * nN; G = G_; c = c_; }
    __host__ __device__ bool next(int i, Unit& u) const {
        const long L = (long)i * G + c; if (L >= nwg) return false;
        int wgid = (int)L; { const int q = nwg / NXCD, r = nwg % NXCD, xcd = wgid % NXCD, off = wgid / NXCD; wgid = (xcd < r ? xcd * (q + 1) : r * (q + 1) + (xcd - r) * q) + off; }
        const int nig = WGM * nN, gid = wgid / nig, fm = gid * WGM, gsz = (nM - fm) < WGM ? (nM - fm) : WGM;
        u.pm = fm + ((wgid % nig) % gsz); u.pn = (wgid % nig) / gsz; return true;
    }
    __device__ __forceinline__ void a_ready(const Unit&) const {}
    __device__ __forceinline__ void done(const Unit&) const {}
};

__device__ __forceinline__ unsigned cvt_pk_bf16(float lo, float hi) { unsigned r; asm volatile("v_cvt_pk_bf16_f32 %0, %1, %2" : "=v"(r) : "v"(lo), "v"(hi)); return r; }
typedef float f32x2 __attribute__((ext_vector_type(2)));
template <class Epi, class Sched, bool ALIGN_EPI = false, bool SP2 = false>
__device__ __forceinline__ void gemm_phase(PG8_LAS unsigned char* lds, const Gemm g, const Sched& S, const Epi& E) {
    const int tid = threadIdx.x, wid = __builtin_amdgcn_readfirstlane(tid >> 6), lane = tid & 63, wr = wid >> 2, wc = wid & 3, fr = lane & 15, fq = lane >> 4;
    const int K = g.K, nt = K / BK;
    unsigned voffA[2], voffB[2];
#pragma unroll
    for (int i = 0; i < 2; ++i) { int R, C; stage_rc(tid * 16 + i * 8192, R, C); const int Rb = Epi::PERM ? ((R & ~31) + perm32(R & 31)) : R;
        voffA[i] = (unsigned)(R * K + C) * 2u; voffB[i] = (unsigned)(Rb * K + C) * 2u; }
    const size_t kstep = (size_t)(BK * 2);
    const size_t hstep = (size_t)HALF * K * 2;
    const size_t tstep = 2 * hstep;
    const unsigned ldsw = (unsigned)wid * 1024u;
    const int aoff = lds_byte(wr * 64 + fr, fq * 8), boff = lds_byte(wc * 32 + fr, fq * 8);
#define PG8_SA(b, h) (((b) * 2 + (h)) * HTB)
#define PG8_SB(b, h) ((4 + (b) * 2 + (h)) * HTB)
#define PG8_STAGE(bufoff, gbase, voff) do { _Pragma("unroll") for (int _i = 0; _i < 2; ++_i) \
        __builtin_amdgcn_global_load_lds((const unsigned*)((const char*)(gbase) + (voff)[_i]), (PG8_LAS unsigned*)(lds + (bufoff) + ldsw + _i * 8192), 16, 0, 0); } while (0)
#define PG8_LDA(dst, b, h) do { _Pragma("unroll") for (int m = 0; m < 4; ++m) _Pragma("unroll") for (int k = 0; k < 2; ++k) dst[m][k] = *(const PG8_LAS bf16x8*)(lds + PG8_SA(b, h) + aoff + m * 2048 + k * 1024); } while (0)
#define PG8_LDB(dst, b, h) do { _Pragma("unroll") for (int n = 0; n < 2; ++n) _Pragma("unroll") for (int k = 0; k < 2; ++k) dst[n][k] = *(const PG8_LAS bf16x8*)(lds + PG8_SB(b, h) + boff + n * 2048 + k * 1024); } while (0)
#define PG8_MMA(ai, bj, At, Bt) do { __builtin_amdgcn_s_setprio(1); _Pragma("unroll") for (int m = 0; m < 4; ++m) _Pragma("unroll") for (int n = 0; n < 2; ++n) _Pragma("unroll") for (int k = 0; k < 2; ++k) \
        acc[ai][bj][m][n] = __builtin_amdgcn_mfma_f32_16x16x32_bf16(Bt[n][k], At[m][k], acc[ai][bj][m][n], 0, 0, 0); __builtin_amdgcn_s_setprio(0); } while (0)
#define PG8_WAIT_V(n) asm volatile("s_waitcnt vmcnt(" #n ")" ::: "memory")
#define PG8_WAIT_L(n) asm volatile("s_waitcnt lgkmcnt(" #n ")" ::: "memory")
#define PG8_BAR __builtin_amdgcn_s_barrier()
#define PG8_SCHED __builtin_amdgcn_sched_barrier(0)
    Unit cur, nxt; int ui = 0;
    if (!S.next(0, cur)) return;
    f32x4 acc[2][2][4][2];
#pragma unroll
    for (int a = 0; a < 2; ++a)
#pragma unroll
        for (int b = 0; b < 2; ++b)
#pragma unroll
            for (int m = 0; m < 4; ++m)
#pragma unroll
                for (int n = 0; n < 2; ++n) acc[a][b][m][n] = (f32x4){0.f, 0.f, 0.f, 0.f};
    bf16x8 At[4][2], B0[2][2], B1[2][2];
    const char* cA = (const char*)g.A + (size_t)cur.pm * tstep; const char* cB = (const char*)g.Bt + (size_t)cur.pn * tstep;
    S.a_ready(cur);
    if constexpr (SP2) {
        PG8_STAGE(PG8_SB(0, 0), cB, voffB); PG8_STAGE(PG8_SB(0, 1), cB + hstep, voffB); PG8_STAGE(PG8_SA(0, 0), cA, voffA); PG8_STAGE(PG8_SA(0, 1), cA + hstep, voffA);
        if (wr == 1) PG8_BAR;
        PG8_WAIT_V(2); PG8_BAR;
        PG8_STAGE(PG8_SB(1, 0), cB + kstep, voffB); PG8_STAGE(PG8_SA(1, 0), cA + kstep, voffA); PG8_STAGE(PG8_SB(1, 1), cB + hstep + kstep, voffB);
        PG8_WAIT_V(6); PG8_BAR;
    } else {
        PG8_STAGE(PG8_SB(0, 0), cB, voffB); PG8_STAGE(PG8_SA(0, 0), cA, voffA); PG8_STAGE(PG8_SB(0, 1), cB + hstep, voffB); PG8_STAGE(PG8_SA(0, 1), cA + hstep, voffA);
        if (wr == 1) PG8_BAR;
        PG8_WAIT_V(4); PG8_BAR;
        PG8_STAGE(PG8_SB(1, 0), cB + kstep, voffB); PG8_STAGE(PG8_SA(1, 0), cA + kstep, voffA); PG8_STAGE(PG8_SB(1, 1), cB + hstep + kstep, voffB);
        PG8_WAIT_V(6); PG8_BAR;
    }
    for (;;) {
        const bool has_next = S.next(ui + 1, nxt);
        const char* nA = has_next ? (const char*)g.A + (size_t)nxt.pm * tstep : cA; const char* nB = has_next ? (const char*)g.Bt + (size_t)nxt.pn * tstep : cB;
        for (int t = 0; t < nt; t += 2) {
            const bool last = (t == nt - 2);
            const char* a1 = cA + (size_t)(t + 1) * kstep;
            const char* a2 = last ? nA : cA + (size_t)(t + 2) * kstep; const char* b2 = last ? nB : cB + (size_t)(t + 2) * kstep;
            const char* a3 = a2 + kstep; const char* b3 = b2 + kstep;
            if (last && has_next) S.a_ready(nxt);
            if constexpr (SP2) {
            PG8_LDB(B0, 0, 0); PG8_LDB(B1, 0, 1); PG8_SCHED; PG8_LDA(At, 0, 0); PG8_STAGE(PG8_SA(1, 1), a1 + hstep, voffA);
            PG8_WAIT_V(8); PG8_WAIT_L(0); PG8_BAR; PG8_MMA(0, 0, At, B0); PG8_MMA(0, 1, At, B1); PG8_BAR; PG8_SCHED;
            PG8_LDA(At, 0, 1); PG8_STAGE(PG8_SB(0, 0), b2, voffB); PG8_STAGE(PG8_SB(0, 1), b2 + hstep, voffB); PG8_STAGE(PG8_SA(0, 0), a2, voffA);
            PG8_WAIT_V(8); PG8_WAIT_L(0); PG8_BAR; PG8_MMA(1, 0, At, B0); PG8_MMA(1, 1, At, B1); PG8_BAR; PG8_SCHED;
            PG8_LDB(B0, 1, 0); PG8_LDB(B1, 1, 1); PG8_SCHED; PG8_LDA(At, 1, 0); PG8_STAGE(PG8_SA(0, 1), a2 + hstep, voffA);
            PG8_WAIT_V(8); PG8_WAIT_L(0); PG8_BAR; PG8_MMA(0, 0, At, B0); PG8_MMA(0, 1, At, B1); PG8_BAR; PG8_SCHED;
            PG8_LDA(At, 1, 1); PG8_STAGE(PG8_SB(1, 0), b3, voffB); PG8_STAGE(PG8_SB(1, 1), b3 + hstep, voffB); PG8_STAGE(PG8_SA(1, 0), a3, voffA);
            PG8_WAIT_V(8); PG8_WAIT_L(0); PG8_BAR; PG8_MMA(1, 0, At, B0); PG8_MMA(1, 1, At, B1); PG8_BAR; PG8_SCHED;
            } else {
            PG8_LDB(B0, 0, 0); PG8_SCHED; PG8_LDA(At, 0, 0); PG8_STAGE(PG8_SA(1, 1), a1 + hstep, voffA);
            PG8_WAIT_L(8); PG8_BAR; PG8_WAIT_L(0); PG8_MMA(0, 0, At, B0); PG8_BAR; PG8_SCHED;
            PG8_LDB(B1, 0, 1); PG8_STAGE(PG8_SB(0, 0), b2, voffB);
            PG8_BAR; PG8_WAIT_L(0); PG8_MMA(0, 1, At, B1); PG8_BAR;
            PG8_LDA(At, 0, 1); PG8_STAGE(PG8_SA(0, 0), a2, voffA);
            PG8_BAR; PG8_WAIT_L(0); PG8_MMA(1, 0, At, B0); PG8_BAR; PG8_SCHED;
            PG8_STAGE(PG8_SB(0, 1), b2 + hstep, voffB);
            PG8_WAIT_V(6); PG8_BAR; PG8_MMA(1, 1, At, B1); PG8_BAR;
            PG8_LDB(B0, 1, 0); PG8_SCHED; PG8_LDA(At, 1, 0); PG8_STAGE(PG8_SA(0, 1), a2 + hstep, voffA);
            PG8_WAIT_L(8); PG8_BAR; PG8_WAIT_L(0); PG8_MMA(0, 0, At, B0); PG8_BAR; PG8_SCHED;
            PG8_LDB(B1, 1, 1); PG8_STAGE(PG8_SB(1, 0), b3, voffB);
            PG8_BAR; PG8_WAIT_L(0); PG8_MMA(0, 1, At, B1); PG8_BAR;
            PG8_LDA(At, 1, 1); PG8_STAGE(PG8_SA(1, 0), a3, voffA);
            PG8_BAR; PG8_WAIT_L(0); PG8_MMA(1, 0, At, B0); PG8_BAR; PG8_SCHED;
            PG8_STAGE(PG8_SB(1, 1), b3 + hstep, voffB);
            PG8_WAIT_V(6); PG8_BAR; PG8_MMA(1, 1, At, B1); PG8_BAR;
            }
        }
        if constexpr (ALIGN_EPI) { if (wr == 0) PG8_BAR; }
        if constexpr (!Epi::AFTER_DRAIN) { E(acc, cur, wr, wc, fr, fq); S.done(cur); }
        if (!has_next) break;
#pragma unroll
        for (int a = 0; a < 2; ++a)
#pragma unroll
            for (int b = 0; b < 2; ++b)
#pragma unroll
                for (int m = 0; m < 4; ++m)
#pragma unroll
                    for (int n = 0; n < 2; ++n) acc[a][b][m][n] = (f32x4){0.f, 0.f, 0.f, 0.f};
        cur = nxt; cA = nA; cB = nB; ++ui;
        if constexpr (ALIGN_EPI) { if (wr == 1) PG8_BAR; }
    }
    PG8_WAIT_V(0);
    if constexpr (!ALIGN_EPI) { if (wr == 0) PG8_BAR; }
    PG8_BAR;
    if constexpr (Epi::AFTER_DRAIN) { E.fused(acc, cur, wr, wc, fr, fq, lds, wid, lane); S.done(cur); }
#undef PG8_SA
#undef PG8_SB
#undef PG8_STAGE
#undef PG8_LDA
#undef PG8_LDB
#undef PG8_MMA
#undef PG8_WAIT_V
#undef PG8_WAIT_L
#undef PG8_BAR
#undef PG8_SCHED
}
}

#define LAS __attribute__((address_space(3)))
typedef unsigned short bf16_t;
typedef float f32x4 __attribute__((ext_vector_type(4)));
typedef unsigned u32x4 __attribute__((ext_vector_type(4)));
typedef unsigned u32x2 __attribute__((ext_vector_type(2)));
using pg8::cvt_pk_bf16;

constexpr int DM = 1024, TP = 2048, NBP = 16, NBS = 128, TS = 8;
constexpr int MP = NBP * TP, MS = NBS * TS, M = MP + MS;
constexpr int DFF = 2816, NGU = 2 * DFF, NINP = 3072, NIN = 2824, PLE = 256;
constexpr float EPS = 1e-6f;
constexpr int PAST = 16384;

constexpr size_t O_Y = 0;
constexpr size_t O_SGP = (size_t)M * DM;
constexpr size_t O_SCP = O_SGP + (size_t)NBP * 4 * 128 * 128;
constexpr size_t O_CKP = O_SCP + (size_t)NBP * 3 * 1536;
constexpr size_t O_CVP = O_CKP + (size_t)NBP * 128 * 128;
constexpr size_t O_SGS = O_CVP + (size_t)NBP * 128 * 128;
constexpr size_t O_SCS = O_SGS + (size_t)NBS * 4 * 128 * 128;
constexpr size_t O_CKS = O_SCS + (size_t)NBS * 3 * 1536;
constexpr size_t O_CVS = O_CKS + (size_t)NBS * 128 * 128;
constexpr size_t O_END = O_CVS + (size_t)NBS * 128 * 128;

constexpr size_t MiB = 1u << 20;
constexpr size_t WS_GU1 = 0, WS_D1 = 11 * MiB, WS_IN = 17 * MiB, WS_OUT = 23 * MiB, WS_GU2 = 25 * MiB, WS_D2 = 36 * MiB, WS_PG = 42 * MiB, WS_PPW = 44 * MiB;
constexpr size_t WS_HB = 48 * MiB;
constexpr size_t WS_QS = 48 * MiB, WS_KS = 81 * MiB, WS_VS = 90 * MiB;
constexpr size_t WS_ACT = 114 * MiB;
constexpr size_t WS_PROJ = 114 * MiB;
constexpr size_t WS_GQ = 312 * MiB, WS_GK = 345 * MiB, WS_GV = 378 * MiB;
constexpr size_t WS_PP = 312 * MiB;
constexpr size_t WS_MIX = 411 * MiB;
constexpr size_t WS_PB = 477 * MiB;
constexpr size_t WS_SS = 494 * MiB;
constexpr size_t WS_AB = 495 * MiB;
constexpr size_t WS_GD = 497 * MiB;
constexpr size_t WS_BT = 498 * MiB;
constexpr size_t WS_ROPE = 499 * MiB;
constexpr size_t WS_EGL = 499 * MiB + 512 * 1024;
constexpr size_t WS_CTR = 499 * MiB + 768 * 1024;
constexpr size_t WS_BAR = 500 * MiB;
constexpr size_t WS_BAR_BYTES = 16384;
constexpr size_t WS_END = 501 * MiB;

constexpr int LDS_BYTES = 131072 + 2048 + 256;
constexpr int LDS_WQ = 133120, LDS_XB = 133120 + 64;

struct Args { const float* in[26]; float* out; unsigned char* ws; int ph_lo, ph_hi; };
typedef __attribute__((address_space(4))) const Args CArgs;
__device__ __forceinline__ CArgs* get_args() {
    unsigned long long p = (unsigned long long)__builtin_amdgcn_kernarg_segment_ptr();
    unsigned l = (unsigned)p, h = (unsigned)(p >> 32);
    asm volatile("" : "+s"(l), "+s"(h));
    l = __builtin_amdgcn_readfirstlane(l); h = __builtin_amdgcn_readfirstlane(h);
    return (CArgs*)(((unsigned long long)h << 32) | l);
}


__device__ __forceinline__ float bf2f(unsigned b) { return __uint_as_float(b << 16); }
__device__ __forceinline__ float wave_sum(float v) {
#pragma unroll
    for (int o = 1; o < 64; o <<= 1) v += __shfl_xor(v, o);
    return v;
}
__device__ __forceinline__ float wave_max(float v) {
#pragma unroll
    for (int o = 1; o < 64; o <<= 1) v = fmaxf(v, __shfl_xor(v, o));
    return v;
}
template <int CTRL> __device__ __forceinline__ float dppf(float v) { return __int_as_float(__builtin_amdgcn_update_dpp(0, __float_as_int(v), CTRL, 0xf, 0xf, true)); }
__device__ __forceinline__ float reduce16(float v) {
    v += dppf<0xB1>(v); v += dppf<0x4E>(v); v += dppf<0x141>(v); v += dppf<0x140>(v); return v;
}
__device__ __forceinline__ void unpack8(const u32x4 r, float* x) {
    x[0] = bf2f(r.x & 0xffffu); x[1] = bf2f(r.x >> 16); x[2] = bf2f(r.y & 0xffffu); x[3] = bf2f(r.y >> 16);
    x[4] = bf2f(r.z & 0xffffu); x[5] = bf2f(r.z >> 16); x[6] = bf2f(r.w & 0xffffu); x[7] = bf2f(r.w >> 16);
}
__device__ __forceinline__ u32x4 pack8(const float* x) {
    u32x4 w; w.x = cvt_pk_bf16(x[0], x[1]); w.y = cvt_pk_bf16(x[2], x[3]); w.z = cvt_pk_bf16(x[4], x[5]); w.w = cvt_pk_bf16(x[6], x[7]); return w;
}
__device__ __forceinline__ float sigmoidf_(float x) { return 1.f / (1.f + __expf(-x)); }
#define LDS_WAIT() asm volatile("s_waitcnt lgkmcnt(0)" ::: "memory")

struct EpiSwiglu {
    static constexpr bool PERM = true, AFTER_DRAIN = false;
    bf16_t* O; const float* ss;
    __device__ __forceinline__ void operator()(const f32x4 (&acc)[2][2][4][2], const pg8::Unit& u, int wr, int wc, int fr, int fq) const {
        const int col0 = u.pn * 128 + wc * 32 + 8 * fq;
#pragma unroll
        for (int ai = 0; ai < 2; ++ai)
#pragma unroll
            for (int m = 0; m < 4; ++m) {
                const int row = u.pm * 256 + ai * 128 + wr * 64 + m * 16 + fr;
                const float rs = rsqrtf(ss[row] * (1.f / DM) + EPS);
                float a[8];
#pragma unroll
                for (int n = 0; n < 2; ++n)
#pragma unroll
                    for (int j = 0; j < 4; ++j) { const float g = acc[ai][0][m][n][j] * rs, up = acc[ai][1][m][n][j] * rs; a[4 * n + j] = g * sigmoidf_(g) * up; }
                *(u32x4*)(O + (size_t)row * DFF + col0) = pack8(a);
            }
    }
};
struct EpiProj {
    static constexpr bool PERM = true, AFTER_DRAIN = false;
    bf16_t* O; const float* ss; float* AB;
    __device__ __forceinline__ void operator()(const f32x4 (&acc)[2][2][4][2], const pg8::Unit& u, int wr, int wc, int fr, int fq) const {
#pragma unroll
        for (int ai = 0; ai < 2; ++ai)
#pragma unroll
            for (int m = 0; m < 4; ++m) {
                const int row = u.pm * 256 + ai * 128 + wr * 64 + m * 16 + fr;
                const float rs = rsqrtf(ss[row] * (1.f / DM) + EPS);
#pragma unroll
                for (int bj = 0; bj < 2; ++bj) {
                    float a[8];
#pragma unroll
                    for (int n = 0; n < 2; ++n)
#pragma unroll
                        for (int j = 0; j < 4; ++j) a[4 * n + j] = acc[ai][bj][m][n][j] * rs;
                    *(u32x4*)(O + (size_t)row * NINP + u.pn * 256 + bj * 128 + wc * 32 + 8 * fq) = pack8(a);
                    if (bj == 0 && u.pn == 11 && wc == 0 && fq == 0) {
                        *(f32x4*)(AB + (size_t)row * 8) = (f32x4){a[0], a[1], a[2], a[3]};
                        *(f32x4*)(AB + (size_t)row * 8 + 4) = (f32x4){a[4], a[5], a[6], a[7]};
                    }
                }
            }
    }
};
struct EpiPlain {
    static constexpr bool PERM = true, AFTER_DRAIN = false;
    bf16_t* O;
    __device__ __forceinline__ void operator()(const f32x4 (&acc)[2][2][4][2], const pg8::Unit& u, int wr, int wc, int fr, int fq) const {
#pragma unroll
        for (int ai = 0; ai < 2; ++ai)
#pragma unroll
            for (int m = 0; m < 4; ++m) {
                const int row = u.pm * 256 + ai * 128 + wr * 64 + m * 16 + fr;
#pragma unroll
                for (int bj = 0; bj < 2; ++bj) {
                    float a[8];
#pragma unroll
                    for (int n = 0; n < 2; ++n)
#pragma unroll
                        for (int j = 0; j < 4; ++j) a[4 * n + j] = acc[ai][bj][m][n][j];
                    *(u32x4*)(O + (size_t)row * DM + u.pn * 256 + bj * 128 + wc * 32 + 8 * fq) = pack8(a);
                }
            }
    }
};
struct EpiResid {
    static constexpr bool PERM = false, AFTER_DRAIN = false;
    const float* base0; const float* base1; float* out; bf16_t* outb; float* ss; float alpha;
    __device__ __forceinline__ void operator()(const f32x4 (&acc)[2][2][4][2], const pg8::Unit& u, int wr, int wc, int fr, int fq) const {
#pragma unroll
        for (int ai = 0; ai < 2; ++ai)
#pragma unroll
            for (int m = 0; m < 4; ++m) {
                const int row = u.pm * 256 + ai * 128 + wr * 64 + m * 16 + fr;
                const float* bp = row < MP ? base0 + (size_t)row * DM : base1 + (size_t)(row - MP) * DM;
                float sq = 0.f;
#pragma unroll
                for (int bj = 0; bj < 2; ++bj)
#pragma unroll
                    for (int n = 0; n < 2; ++n) {
                        const int c = u.pn * 256 + bj * 128 + wc * 32 + n * 16 + 4 * fq;
                        const f32x4 bv = *(const f32x4*)(bp + c);
                        const f32x4 v = bv + acc[ai][bj][m][n] * alpha;
                        *(f32x4*)(out + (size_t)row * DM + c) = v;
                        u32x2 w; w.x = cvt_pk_bf16(v[0], v[1]); w.y = cvt_pk_bf16(v[2], v[3]);
                        *(u32x2*)(outb + (size_t)row * DM + c) = w;
                        sq += (v[0] * v[0] + v[1] * v[1]) + (v[2] * v[2] + v[3] * v[3]);
                    }
                sq += __shfl_xor(sq, 16); sq += __shfl_xor(sq, 32);
                if (fq == 0) unsafeAtomicAdd(ss + row, sq);
                asm volatile("" ::: "memory");
            }
    }
};
struct EpiGate {
    static constexpr bool PERM = false, AFTER_DRAIN = false;
    float* h; const bf16_t* pp; const float* ss; float* ss2;
    __device__ __forceinline__ void operator()(const f32x4 (&acc)[2][2][4][2], const pg8::Unit& u, int wr, int wc, int fr, int fq) const {
#pragma unroll
        for (int ai = 0; ai < 2; ++ai)
#pragma unroll
            for (int m = 0; m < 4; ++m) {
                const int row = u.pm * 256 + ai * 128 + wr * 64 + m * 16 + fr;
                const float rs = rsqrtf(ss[row] * (1.f / DM) + EPS);
                float sq = 0.f;
#pragma unroll
                for (int bj = 0; bj < 2; ++bj)
#pragma unroll
                    for (int n = 0; n < 2; ++n) {
                        const int c = u.pn * 256 + bj * 128 + wc * 32 + n * 16 + 4 * fq;
                        const f32x4 hv = *(const f32x4*)(h + (size_t)row * DM + c);
                        const u32x2 pw = *(const u32x2*)(pp + (size_t)row * DM + c);
                        f32x4 v;
                        v[0] = hv[0] + sigmoidf_(acc[ai][bj][m][n][0] * rs) * bf2f(pw.x & 0xffffu);
                        v[1] = hv[1] + sigmoidf_(acc[ai][bj][m][n][1] * rs) * bf2f(pw.x >> 16);
                        v[2] = hv[2] + sigmoidf_(acc[ai][bj][m][n][2] * rs) * bf2f(pw.y & 0xffffu);
                        v[3] = hv[3] + sigmoidf_(acc[ai][bj][m][n][3] * rs) * bf2f(pw.y >> 16);
                        *(f32x4*)(h + (size_t)row * DM + c) = v;
                        sq += (v[0] * v[0] + v[1] * v[1]) + (v[2] * v[2] + v[3] * v[3]);
                    }
                sq += __shfl_xor(sq, 16); sq += __shfl_xor(sq, 32);
                if (fq == 0) unsafeAtomicAdd(ss2 + row, sq);
                asm volatile("" ::: "memory");
            }
    }
};

__device__ __forceinline__ int map_row(int mode, int n) {
    if (mode == 1) { if (n < DFF) return 256 * (n >> 7) + (n & 127); n -= DFF; return 256 * (n >> 7) + 128 + (n & 127); }
    if (mode == 2) { if (n < 2048) return n; if (n < 2052) return 2816 + (n - 2048); if (n < 2056) return 2820 + (n - 2052); return n - 8; }
    return n;
}
__device__ __forceinline__ void p0_transpose_item(const float* W, int K, int N, const float* gain, bf16_t* WT, int mode, LAS float* scr, int item, int lane) {
    const int nblk = (N + 31) / 32, kb = item / nblk, nb = item % nblk, k0 = 64 * kb, n0 = 32 * nb;
#pragma unroll 8
    for (int i = 0; i < 32; ++i) {
        const int kk = 2 * i + (lane >> 5), n = n0 + (lane & 31);
        float v = 0.f;
        if (n < N) { v = W[(size_t)(k0 + kk) * N + n]; if (gain) v *= gain[k0 + kk]; }
        scr[kk * 33 + (lane & 31)] = v;
    }
    LDS_WAIT();
    const int c = lane & 7;
#pragma unroll
    for (int j = 0; j < 4; ++j) {
        const int n = (lane >> 3) + 8 * j;
        if (n0 + n < N) {
            const LAS float* s = scr + (8 * c) * 33 + n;
            u32x4 o; o.x = cvt_pk_bf16(s[0 * 33], s[1 * 33]); o.y = cvt_pk_bf16(s[2 * 33], s[3 * 33]); o.z = cvt_pk_bf16(s[4 * 33], s[5 * 33]); o.w = cvt_pk_bf16(s[6 * 33], s[7 * 33]);
            *(u32x4*)(WT + (size_t)map_row(mode, n0 + n) * K + k0 + 8 * c) = o;
        }
    }
    LDS_WAIT();
}

__device__ __forceinline__ void p0_prologue(CArgs* a, LAS unsigned char* L) {
    const int tid = threadIdx.x, lane = tid & 63, wave = tid >> 6;
    unsigned char* ws = a->ws;
    LAS float* scr = (LAS float*)(L + wave * 16384);
    const int gw = blockIdx.x * 8 + wave, NGW = gridDim.x * 8;
    constexpr int I_GU = 16 * 176, I_D = 44 * 32, I_IN = 16 * 89, I_SQ = 16 * 32, I_PP = 4 * 32;
    constexpr int NITEMS = 2 * I_GU + 2 * I_D + I_IN + 2 * I_SQ + I_PP;
    for (int it = gw; it < NITEMS; it += NGW) {
        int r = it;
        if (r < I_GU) { p0_transpose_item(a->in[9], DM, NGU, a->in[8], (bf16_t*)(ws + WS_GU1), 1, scr, r, lane); continue; } r -= I_GU;
        if (r < I_GU) { p0_transpose_item(a->in[20], DM, NGU, a->in[19], (bf16_t*)(ws + WS_GU2), 1, scr, r, lane); continue; } r -= I_GU;
        if (r < I_D) { p0_transpose_item(a->in[10], DFF, DM, nullptr, (bf16_t*)(ws + WS_D1), 0, scr, r, lane); continue; } r -= I_D;
        if (r < I_D) { p0_transpose_item(a->in[21], DFF, DM, nullptr, (bf16_t*)(ws + WS_D2), 0, scr, r, lane); continue; } r -= I_D;
        if (r < I_IN) { p0_transpose_item(a->in[12], DM, NIN, a->in[11], (bf16_t*)(ws + WS_IN), 2, scr, r, lane); continue; } r -= I_IN;
        if (r < I_SQ) { p0_transpose_item(a->in[18], DM, DM, nullptr, (bf16_t*)(ws + WS_OUT), 0, scr, r, lane); continue; } r -= I_SQ;
        if (r < I_SQ) { p0_transpose_item(a->in[24], DM, DM, a->in[22], (bf16_t*)(ws + WS_PG), 0, scr, r, lane); continue; } r -= I_SQ;
        p0_transpose_item(a->in[23], PLE, DM, nullptr, (bf16_t*)(ws + WS_PPW), 0, scr, r, lane);
    }
    {
        u32x4* z = (u32x4*)(ws + WS_IN + (size_t)NIN * DM * 2);
        const int nz = (NINP - NIN) * DM * 2 / 16;
        for (int i = blockIdx.x * 512 + tid; i < nz; i += gridDim.x * 512) z[i] = (u32x4){0u, 0u, 0u, 0u};
    }
    bf16_t* HB = (bf16_t*)(ws + WS_HB); bf16_t* PB = (bf16_t*)(ws + WS_PB); float* SS = (float*)(ws + WS_SS);
    for (int m = gw; m < M; m += NGW) {
        const float* xr = m < MP ? a->in[0] + (size_t)m * DM : a->in[1] + (size_t)(m - MP) * DM;
        float s = 0.f;
#pragma unroll
        for (int j = 0; j < 4; ++j) {
            const f32x4 v = ((const f32x4*)xr)[lane + 64 * j];
            s += (v[0] * v[0] + v[1] * v[1]) + (v[2] * v[2] + v[3] * v[3]);
            u32x2 w; w.x = cvt_pk_bf16(v[0], v[1]); w.y = cvt_pk_bf16(v[2], v[3]);
            ((u32x2*)(HB + (size_t)m * DM))[lane + 64 * j] = w;
        }
        s = wave_sum(s);
        if (lane == 0) SS[m] = s;
        const float* pr = m < MP ? a->in[6] + (size_t)m * PLE : a->in[7] + (size_t)(m - MP) * PLE;
        const f32x4 pv = ((const f32x4*)pr)[lane];
        u32x2 w; w.x = cvt_pk_bf16(pv[0], pv[1]); w.y = cvt_pk_bf16(pv[2], pv[3]);
        ((u32x2*)(PB + (size_t)m * PLE))[lane] = w;
    }
    for (int i = blockIdx.x * 512 + tid; i < 4 * M; i += gridDim.x * 512) SS[M + i] = 0.f;
    if (blockIdx.x == 0 && tid == 0) *(unsigned*)(ws + WS_CTR) = 0u;
    float* RT = (float*)(ws + WS_ROPE);
    for (int i = blockIdx.x * 512 + tid; i < 2056 * 8; i += gridDim.x * 512) {
        const int idx = i >> 3, f = i & 7;
        const int pos = idx < 2048 ? idx : PAST + (idx - 2048);
        const float inv = powf(500000.0f, -(float)f * 0.125f);
        const float ang = (float)pos * inv;
        const double rev = (double)ang * 0.15915494309189535;
        const float fr = (float)(rev - rint(rev));
        RT[idx * 16 + f] = __builtin_amdgcn_cosf(fr);
        RT[idx * 16 + 8 + f] = __builtin_amdgcn_sinf(fr);
    }
}

__device__ __forceinline__ void p4_mixprep(CArgs* a) {
    const int tid = threadIdx.x, lane = tid & 63, wave = tid >> 6;
    unsigned char* ws = a->ws;
    const bf16_t* PROJ = (const bf16_t*)(ws + WS_PROJ);
    bf16_t* GQ = (bf16_t*)(ws + WS_GQ); bf16_t* GK = (bf16_t*)(ws + WS_GK); bf16_t* GV = (bf16_t*)(ws + WS_GV);
    bf16_t* QS = (bf16_t*)(ws + WS_QS); bf16_t* KS = (bf16_t*)(ws + WS_KS); bf16_t* VS = (bf16_t*)(ws + WS_VS);
    const float* AB = (const float*)(ws + WS_AB); float* GD = (float*)(ws + WS_GD); float* BT = (float*)(ws + WS_BT);
    const float* RT = (const float*)(ws + WS_ROPE);
    const float* state_conv = a->in[3]; const float* conv_w = a->in[13];
    const int gw = blockIdx.x * 8 + wave, NGW = gridDim.x * 8;
    for (int r = gw; r < M; r += NGW) {
        const bool samp = r >= MP;
        int b, t;
        if (!samp) { b = r >> 11; t = r & 2047; } else { b = (r - MP) >> 3; t = (r - MP) & 7; }
        const int T = samp ? TS : TP;
        const bf16_t* prow = PROJ + (size_t)r * NINP;
#pragma unroll
        for (int j = 0; j < 3; ++j) {
            const int ch = j * 512 + lane * 8;
            float acc[8], cur[8];
#pragma unroll
            for (int i = 0; i < 8; ++i) acc[i] = 0.f;
#pragma unroll
            for (int tap = 0; tap < 4; ++tap) {
                const int tt = t - 3 + tap;
                float x[8];
                if (tt >= 0) { const u32x4 raw = *(const u32x4*)(prow - (ptrdiff_t)(3 - tap) * NINP + ch); unpack8(raw, x); }
                else if (samp) {
                    const float* sc = state_conv + ((size_t)b * 3 + (3 + tt)) * 1536 + ch;
                    const f32x4 s0 = *(const f32x4*)sc, s1 = *(const f32x4*)(sc + 4);
                    x[0] = s0[0]; x[1] = s0[1]; x[2] = s0[2]; x[3] = s0[3]; x[4] = s1[0]; x[5] = s1[1]; x[6] = s1[2]; x[7] = s1[3];
                } else {
#pragma unroll
                    for (int i = 0; i < 8; ++i) x[i] = 0.f;
                }
                const f32x4 w0 = *(const f32x4*)(conv_w + tap * 1536 + ch), w1 = *(const f32x4*)(conv_w + tap * 1536 + ch + 4);
                acc[0] += x[0] * w0[0]; acc[1] += x[1] * w0[1]; acc[2] += x[2] * w0[2]; acc[3] += x[3] * w0[3];
                acc[4] += x[4] * w1[0]; acc[5] += x[5] * w1[1]; acc[6] += x[6] * w1[2]; acc[7] += x[7] * w1[3];
                if (tap == 3) {
#pragma unroll
                    for (int i = 0; i < 8; ++i) cur[i] = x[i];
                }
            }
            float ssq = 0.f;
#pragma unroll
            for (int i = 0; i < 8; ++i) { acc[i] = acc[i] * sigmoidf_(acc[i]); ssq += acc[i] * acc[i]; }
            if (j < 2) {
                ssq += __shfl_xor(ssq, 1); ssq += __shfl_xor(ssq, 2); ssq += __shfl_xor(ssq, 4); ssq += __shfl_xor(ssq, 8);
                const float sc = rsqrtf(ssq + 1e-6f) * (j == 0 ? 0.08838834764831845f : 1.0f);
#pragma unroll
                for (int i = 0; i < 8; ++i) acc[i] *= sc;
            }
            bf16_t* dst = (j == 0 ? GQ : (j == 1 ? GK : GV)) + (size_t)r * 512 + lane * 8;
            *(u32x4*)dst = pack8(acc);
            if (t >= T - 3) {
                float* so = a->out + (samp ? O_SCS : O_SCP) + ((size_t)b * 3 + (t - (T - 3))) * 1536 + ch;
                *(f32x4*)so = (f32x4){cur[0], cur[1], cur[2], cur[3]};
                *(f32x4*)(so + 4) = (f32x4){cur[4], cur[5], cur[6], cur[7]};
            }
        }
        if (lane < 4) {
            const float av = AB[(size_t)r * 8 + lane], bv = AB[(size_t)r * 8 + 4 + lane];
            const float sp = av + a->in[15][lane];
            const float softplus = sp > 20.f ? sp : log1pf(expf(sp));
            GD[(size_t)r * 4 + lane] = -expf(a->in[14][lane]) * softplus;
            BT[(size_t)r * 4 + lane] = 1.f / (1.f + expf(-bv));
        }
        const float* rt = RT + (size_t)(samp ? 2048 + t : t) * 16;
        float cs[8], sn[8];
        {
            const f32x4 c0 = *(const f32x4*)rt, c1 = *(const f32x4*)(rt + 4), s0 = *(const f32x4*)(rt + 8), s1 = *(const f32x4*)(rt + 12);
            cs[0] = c0[0]; cs[1] = c0[1]; cs[2] = c0[2]; cs[3] = c0[3]; cs[4] = c1[0]; cs[5] = c1[1]; cs[6] = c1[2]; cs[7] = c1[3];
            sn[0] = s0[0]; sn[1] = s0[1]; sn[2] = s0[2]; sn[3] = s0[3]; sn[4] = s1[0]; sn[5] = s1[1]; sn[6] = s1[2]; sn[7] = s1[3];
        }
        {
            float x[8], o[8];
            unpack8(*(const u32x4*)(prow + 2048 + lane * 8), x);
#pragma unroll
            for (int i = 0; i < 8; ++i) o[i] = __shfl_xor(x[i], 1);
            const int l8 = lane & 7;
            if (l8 == 0) {
#pragma unroll
                for (int i = 0; i < 8; ++i) x[i] = x[i] * cs[i] - o[i] * sn[i];
            } else if (l8 == 1) {
#pragma unroll
                for (int i = 0; i < 8; ++i) x[i] = x[i] * cs[i] + o[i] * sn[i];
            }
#pragma unroll
            for (int i = 0; i < 8; ++i) x[i] *= 0.125f;
            *(u32x4*)(QS + (size_t)r * 512 + lane * 8) = pack8(x);
        }
        {
            const int kl = lane & 15;
            float x[8], o[8];
            unpack8(*(const u32x4*)(prow + 2560 + kl * 8), x);
#pragma unroll
            for (int i = 0; i < 8; ++i) o[i] = __shfl_xor(x[i], 1);
            const int l8 = kl & 7;
            if (l8 == 0) {
#pragma unroll
                for (int i = 0; i < 8; ++i) x[i] = x[i] * cs[i] - o[i] * sn[i];
            } else if (l8 == 1) {
#pragma unroll
                for (int i = 0; i < 8; ++i) x[i] = x[i] * cs[i] + o[i] * sn[i];
            }
            const u32x4 vraw = *(const u32x4*)(prow + 2688 + kl * 8);
            if (lane < 16) {
                *(u32x4*)(KS + (size_t)r * 128 + kl * 8) = pack8(x);
                *(u32x4*)(VS + (size_t)r * 128 + kl * 8) = vraw;
                const int crow = samp ? 120 + t : t - (TP - 128);
                if (crow >= 0) {
                    float v[8]; unpack8(vraw, v);
                    float* ck = a->out + (samp ? O_CKS : O_CKP) + ((size_t)b * 128 + crow) * 128 + kl * 8;
                    float* cv = a->out + (samp ? O_CVS : O_CVP) + ((size_t)b * 128 + crow) * 128 + kl * 8;
                    *(f32x4*)ck = (f32x4){x[0], x[1], x[2], x[3]}; *(f32x4*)(ck + 4) = (f32x4){x[4], x[5], x[6], x[7]};
                    *(f32x4*)cv = (f32x4){v[0], v[1], v[2], v[3]}; *(f32x4*)(cv + 4) = (f32x4){v[4], v[5], v[6], v[7]};
                }
            }
        }
        if (samp) {
            for (int e = lane; e < 15 * 32; e += 64) {
                const int j = t * 15 + (e >> 5), c4 = (e & 31) * 4;
                const size_t d = ((size_t)b * 128 + j) * 128 + c4, s = ((size_t)b * 128 + j + 8) * 128 + c4;
                *(f32x4*)(a->out + O_CKS + d) = *(const f32x4*)(a->in[4] + s);
                *(f32x4*)(a->out + O_CVS + d) = *(const f32x4*)(a->in[5] + s);
            }
        }
    }
}

__device__ __forceinline__ void gdn_item(CArgs* a, LAS unsigned char* L, int item, bool samp) {
    const int tid = threadIdx.x;
    unsigned char* ws = a->ws;
    const bf16_t* GQ = (const bf16_t*)(ws + WS_GQ); const bf16_t* GK = (const bf16_t*)(ws + WS_GK); const bf16_t* GV = (const bf16_t*)(ws + WS_GV);
    const float* GD = (const float*)(ws + WS_GD); const float* BT = (const float*)(ws + WS_BT);
    unsigned char* PROJb = ws + WS_PROJ;
    const int b = item >> 4, h = (item >> 2) & 3, qd = item & 3;
    const int row0 = samp ? MP + b * TS : b * TP, T = samp ? TS : TP;
    const float* S0 = samp ? a->in[2] + (size_t)(b * 4 + h) * 16384 : nullptr;
    float* Sout = a->out + (samp ? O_SGS : O_SGP) + (size_t)(b * 4 + h) * 16384;
    const int cl = tid >> 4, part = tid & 15;
    LAS float* kb = (LAS float*)L;
    LAS float* qb = kb + 32 * 128;
    LAS float* vb = qb + 32 * 128;
    LAS float* ob = vb + 32 * 32;
    LAS float* eg = ob + 32 * 32;
    LAS float* bt = eg + 32;
    LAS float* sb = bt + 32;
    __syncthreads();
    float S[8];
    if (S0) {
        const int dk = tid >> 2, c8 = (tid & 3) * 8;
        const f32x4 s0 = *(const f32x4*)(S0 + (size_t)dk * 128 + qd * 32 + c8), s1 = *(const f32x4*)(S0 + (size_t)dk * 128 + qd * 32 + c8 + 4);
#pragma unroll
        for (int i = 0; i < 4; ++i) { sb[dk * 33 + c8 + i] = s0[i]; sb[dk * 33 + c8 + 4 + i] = s1[i]; }
        __syncthreads();
#pragma unroll
        for (int i = 0; i < 8; ++i) S[i] = sb[(part * 8 + i) * 33 + cl];
    } else {
#pragma unroll
        for (int i = 0; i < 8; ++i) S[i] = 0.f;
    }
    const int TB = T < 32 ? T : 32;
    const int ptok = tid >> 4, pch = (tid & 15) * 8;
    const int vtok = tid >> 2, vch = (tid & 3) * 8;
    const bool pk_ok = ptok < TB, pv_ok = vtok < TB && tid < 128, pe_ok = tid < TB;
    u32x4 rk = {0u, 0u, 0u, 0u}, rq = {0u, 0u, 0u, 0u}, rv = {0u, 0u, 0u, 0u}; float re = 0.f, rb = 0.f;
#define GDN_PREFETCH(t0) do { \
        if (pk_ok) { const size_t o_ = (size_t)(row0 + (t0) + ptok) * 512 + h * 128 + pch; rk = *(const u32x4*)(GK + o_); rq = *(const u32x4*)(GQ + o_); } \
        if (pv_ok) { rv = *(const u32x4*)(GV + (size_t)(row0 + (t0) + vtok) * 512 + h * 128 + qd * 32 + vch); } \
        if (pe_ok) { re = GD[(size_t)(row0 + (t0) + tid) * 4 + h]; rb = BT[(size_t)(row0 + (t0) + tid) * 4 + h]; } } while (0)
    GDN_PREFETCH(0);
    for (int t0 = 0; t0 < T; t0 += TB) {
        if (pk_ok) {
            float x[8];
            unpack8(rk, x); *(LAS f32x4*)(kb + ptok * 128 + pch) = (f32x4){x[0], x[1], x[2], x[3]}; *(LAS f32x4*)(kb + ptok * 128 + pch + 4) = (f32x4){x[4], x[5], x[6], x[7]};
            unpack8(rq, x); *(LAS f32x4*)(qb + ptok * 128 + pch) = (f32x4){x[0], x[1], x[2], x[3]}; *(LAS f32x4*)(qb + ptok * 128 + pch + 4) = (f32x4){x[4], x[5], x[6], x[7]};
        }
        if (pv_ok) { float x[8]; unpack8(rv, x); *(LAS f32x4*)(vb + vtok * 32 + vch) = (f32x4){x[0], x[1], x[2], x[3]}; *(LAS f32x4*)(vb + vtok * 32 + vch + 4) = (f32x4){x[4], x[5], x[6], x[7]}; }
        if (pe_ok) { eg[tid] = __expf(re); bt[tid] = rb; }
        __syncthreads();
        if (t0 + TB < T) GDN_PREFETCH(t0 + TB);
        for (int tok = 0; tok < TB; ++tok) {
            const f32x4 k0 = *(const LAS f32x4*)(kb + tok * 128 + part * 8), k1 = *(const LAS f32x4*)(kb + tok * 128 + part * 8 + 4);
            const f32x4 q0 = *(const LAS f32x4*)(qb + tok * 128 + part * 8), q1 = *(const LAS f32x4*)(qb + tok * 128 + part * 8 + 4);
            const float v = vb[tok * 32 + cl], e = eg[tok], be = bt[tok];
            float ks = ((k0[0] * S[0] + k0[1] * S[1]) + (k0[2] * S[2] + k0[3] * S[3])) + ((k1[0] * S[4] + k1[1] * S[5]) + (k1[2] * S[6] + k1[3] * S[7]));
            ks = reduce16(ks);
            const float vn = be * (v - e * ks);
            S[0] = e * S[0] + k0[0] * vn; S[1] = e * S[1] + k0[1] * vn; S[2] = e * S[2] + k0[2] * vn; S[3] = e * S[3] + k0[3] * vn;
            S[4] = e * S[4] + k1[0] * vn; S[5] = e * S[5] + k1[1] * vn; S[6] = e * S[6] + k1[2] * vn; S[7] = e * S[7] + k1[3] * vn;
            float o = ((q0[0] * S[0] + q0[1] * S[1]) + (q0[2] * S[2] + q0[3] * S[3])) + ((q1[0] * S[4] + q1[1] * S[5]) + (q1[2] * S[6] + q1[3] * S[7]));
            o = reduce16(o);
            if (part == 0) ob[tok * 32 + cl] = o;
        }
        __syncthreads();
        if (tid < 256) {
            const int tok = tid >> 3, c4 = (tid & 7) * 4;
            if (tok < TB) {
                float* og = (float*)(PROJb + (size_t)(row0 + t0 + tok) * (NINP * 2));
                *(f32x4*)(og + h * 128 + qd * 32 + c4) = *(const LAS f32x4*)(ob + tok * 32 + c4);
            }
        }
    }
#undef GDN_PREFETCH
    __syncthreads();
#pragma unroll
    for (int i = 0; i < 8; ++i) sb[(part * 8 + i) * 33 + cl] = S[i];
    __syncthreads();
    {
        const int dk = tid >> 2, c8 = (tid & 3) * 8;
        f32x4 s0, s1;
#pragma unroll
        for (int i = 0; i < 4; ++i) { s0[i] = sb[dk * 33 + c8 + i]; s1[i] = sb[dk * 33 + c8 + 4 + i]; }
        *(f32x4*)(Sout + (size_t)dk * 128 + qd * 32 + c8) = s0; *(f32x4*)(Sout + (size_t)dk * 128 + qd * 32 + c8 + 4) = s1;
    }
}

typedef short bf16x8 __attribute__((ext_vector_type(8)));
#define MFMA16(a_, b_, c_) __builtin_amdgcn_mfma_f32_16x16x32_bf16(a_, b_, c_, 0, 0, 0)
__device__ __forceinline__ void gdn_chunk_prep(CArgs* a, LAS unsigned char* L, int pair) {
    const int tid = threadIdx.x, hb = tid >> 8, t2 = tid & 255, w = t2 >> 6, lane = tid & 63, fr = lane & 15, fq = lane >> 4;
    unsigned char* ws = a->ws;
    bf16_t* GQ = (bf16_t*)(ws + WS_GQ); bf16_t* GK = (bf16_t*)(ws + WS_GK); const bf16_t* GV = (const bf16_t*)(ws + WS_GV);
    const float* GD = (const float*)(ws + WS_GD); const float* BT = (const float*)(ws + WS_BT);
    unsigned char* PROJb = ws + WS_PROJ; float* EGL = (float*)(ws + WS_EGL);
    const int ci = pair * 2 + hb;
    const int b = ci >> 7, h = (ci >> 5) & 3, c = ci & 31;
    const int r0 = b * TP + c * 64;
    LAS unsigned char* Lh = L + hb * 66560;
    LAS float* gcs = (LAS float*)Lh;
    LAS float* bts = gcs + 64;
    LAS float* egc = bts + 64;
    LAS float* ekd = egc + 64;
    LAS float* Af = ekd + 64;
    LAS unsigned char* STG = Lh + 1024 + 16384;
    __syncthreads();
    if (w == 0) {
        float v = GD[(size_t)(r0 + lane) * 4 + h];
#pragma unroll
        for (int o = 1; o < 64; o <<= 1) { const float t = __shfl_up(v, o); if (lane >= o) v += t; }
        const float gl = __shfl(v, 63);
        gcs[lane] = v; bts[lane] = BT[(size_t)(r0 + lane) * 4 + h]; egc[lane] = __expf(v); ekd[lane] = __expf(gl - v);
    }
#pragma unroll 2
    for (int jj = 0; jj < 8; ++jj) {
        const int e = t2 + 256 * jj, row = e >> 5, ch = e & 31;
        const bf16_t* src = (ch < 16 ? GV : (const bf16_t*)GK) + (size_t)(r0 + row) * 512 + h * 128 + (ch & 15) * 8;
        *(LAS u32x4*)(STG + row * 512 + ch * 16) = *(const u32x4*)src;
    }
    __syncthreads();
    bf16x8 aK[4], aQ[4];
    {
        const size_t o_ = (size_t)(r0 + 16 * w + fr) * 512 + h * 128 + fq * 8;
#pragma unroll
        for (int ks = 0; ks < 4; ++ks) { aK[ks] = *(const bf16x8*)(GK + o_ + ks * 32); aQ[ks] = *(const bf16x8*)(GQ + o_ + ks * 32); }
    }
    f32x4 qkd[4];
#pragma unroll
    for (int n = 0; n < 4; ++n) {
        bf16x8 bK[4];
        const size_t o_ = (size_t)(r0 + 16 * n + fr) * 512 + h * 128 + fq * 8;
#pragma unroll
        for (int ks = 0; ks < 4; ++ks) bK[ks] = *(const bf16x8*)(GK + o_ + ks * 32);
        f32x4 kk = {0.f, 0.f, 0.f, 0.f}, qk = {0.f, 0.f, 0.f, 0.f};
#pragma unroll
        for (int ks = 0; ks < 4; ++ks) { kk = MFMA16(aK[ks], bK[ks], kk); qk = MFMA16(aQ[ks], bK[ks], qk); }
        const int j = 16 * n + fr; const float gj = gcs[j];
#pragma unroll
        for (int r = 0; r < 4; ++r) {
            const int i = 16 * w + 4 * fq + r;
            const float d = (i >= j) ? __expf(gcs[i] - gj) : 0.f;
            Af[i * 64 + j] = (i > j) ? bts[i] * kk[r] * d : 0.f;
            qkd[n][r] = qk[r] * d;
        }
    }
#pragma unroll 1
    for (int jj = 0; jj < 4; ++jj) {
        const int e = t2 + 256 * jj, tok = e >> 4, ch = (e & 15) * 8;
        float x[8]; unpack8(*(const u32x4*)(GQ + (size_t)(r0 + tok) * 512 + h * 128 + ch), x);
        const float sc = egc[tok];
#pragma unroll
        for (int i = 0; i < 8; ++i) x[i] *= sc;
        *(u32x4*)((bf16_t*)(PROJb + (size_t)(r0 + tok) * (NINP * 2)) + 2048 + h * 128 + ch) = pack8(x);
    }
    const bool isU = t2 < 128; const int col = t2 & 127;
    float cv[64], x[64];
#pragma unroll
    for (int i = 0; i < 64; ++i) cv[i] = bf2f(*(const LAS bf16_t*)(STG + i * 512 + t2 * 2));
    asm volatile("s_waitcnt vmcnt(0)" ::: "memory");
    __syncthreads();
#pragma unroll
    for (int n = 0; n < 4; ++n)
#pragma unroll
        for (int r = 0; r < 4; ++r) {
            const int i = 16 * w + 4 * fq + r, j = 16 * n + fr;
            GQ[(size_t)(r0 + (i >> 1)) * 512 + h * 128 + (i & 1) * 64 + j] = (bf16_t)(cvt_pk_bf16(qkd[n][r], 0.f) & 0xffffu);
        }
    if (!isU) {
        bf16_t* dst = GK + (size_t)(r0 + (col >> 1)) * 512 + h * 128 + (col & 1) * 64;
#pragma unroll
        for (int jj = 0; jj < 8; ++jj) {
            float y[8];
#pragma unroll
            for (int i = 0; i < 8; ++i) y[i] = cv[8 * jj + i] * ekd[8 * jj + i];
            *(u32x4*)(dst + 8 * jj) = pack8(y);
        }
    }
    {
        const float um = isU ? 1.f : 0.f, km = 1.f - um;
#pragma unroll
        for (int i = 0; i < 64; ++i) x[i] = bts[i] * cv[i] * (um + km * egc[i]);
    }
    asm volatile("" ::: "memory");
#pragma unroll
    for (int i = 1; i < 64; ++i) {
        float s = x[i];
#pragma unroll
        for (int j = 0; j < i; ++j) s -= Af[i * 64 + j] * x[j];
        x[i] = s;
        asm volatile("" ::: "memory");
    }
    if (isU) {
#pragma unroll
        for (int i = 0; i < 64; ++i) *(LAS float*)(STG + (i * 128 + col) * 4) = x[i];
    } else {
#pragma unroll
        for (int i = 0; i < 64; ++i) *(LAS bf16_t*)(STG + 32768 + (i * 128 + col) * 2) = (bf16_t)(cvt_pk_bf16(x[i], 0.f) & 0xffffu);
    }
    __syncthreads();
#pragma unroll 1
    for (int jj = 0; jj < 8; ++jj) {
        const int e = t2 + 256 * jj, row = e >> 5, ch = e & 31;
        *(f32x4*)((float*)(PROJb + (size_t)(r0 + row) * (NINP * 2)) + h * 128 + ch * 4) = *(const LAS f32x4*)(STG + (row * 128 + ch * 4) * 4);
    }
#pragma unroll 1
    for (int jj = 0; jj < 4; ++jj) {
        const int e = t2 + 256 * jj, row = e >> 4, ch = e & 15;
        *(u32x4*)((bf16_t*)(PROJb + (size_t)(r0 + row) * (NINP * 2)) + 1024 + h * 128 + ch * 8) = *(const LAS u32x4*)(STG + 32768 + (row * 128 + ch * 8) * 2);
    }
    if (t2 == 0) EGL[ci] = egc[63];
}

__device__ __forceinline__ void gdn_chunk_scan(CArgs* a, LAS unsigned char* L, int item) {
    const int tid = threadIdx.x, w = __builtin_amdgcn_readfirstlane(tid >> 6), lane = tid & 63, fr = lane & 15, fq = lane >> 4;
    unsigned char* ws = a->ws;
    const bf16_t* GQ = (const bf16_t*)(ws + WS_GQ); const bf16_t* GK = (const bf16_t*)(ws + WS_GK);
    const unsigned char* PROJb = ws + WS_PROJ; const float* EGL = (const float*)(ws + WS_EGL); bf16_t* MIX = (bf16_t*)(ws + WS_MIX);
    const int b = item >> 2, h = item & 3;
    LAS unsigned char* St = L;
    LAS unsigned char* Vn = L + 34816;
    LAS float* ssp = (LAS float*)(L + 53248);
    LAS unsigned char* Wl = L + 57344;
    LAS unsigned char* Ql = Wl + 17408;
    LAS unsigned char* Kl = Ql + 17408;
    LAS unsigned char* Xl = Kl + 18432;
    f32x4 Sacc[8];
#pragma unroll
    for (int n = 0; n < 8; ++n) Sacc[n] = (f32x4){0.f, 0.f, 0.f, 0.f};
    const f32x4 gnv = *(const f32x4*)(a->in[16] + 16 * w + 4 * fq);
    u32x4 pfW[2], pfQ[2], pfK[2], pfX; f32x4 pfU[4]; u32x2 pfZ[4]; float pfE;
    const int s_row = tid >> 4, s_ch = tid & 15;
    const int k_dk = tid >> 3, k_ch = tid & 7;
#define SCAN_PREFETCH(cc) do { const int r0_ = b * TP + (cc) * 64; \
        _Pragma("unroll") for (int jj = 0; jj < 2; ++jj) { \
            const unsigned char* pr_ = PROJb + (size_t)(r0_ + s_row + 32 * jj) * (NINP * 2); \
            pfW[jj] = *(const u32x4*)((const bf16_t*)pr_ + 1024 + h * 128 + s_ch * 8); \
            pfQ[jj] = *(const u32x4*)((const bf16_t*)pr_ + 2048 + h * 128 + s_ch * 8); \
            const int dk_ = k_dk + 64 * jj; \
            pfK[jj] = *(const u32x4*)(GK + (size_t)(r0_ + (dk_ >> 1)) * 512 + h * 128 + (dk_ & 1) * 64 + k_ch * 8); } \
        pfX = *(const u32x4*)(GQ + (size_t)(r0_ + (k_dk >> 1)) * 512 + h * 128 + (k_dk & 1) * 64 + k_ch * 8); \
        _Pragma("unroll") for (int n = 0; n < 4; ++n) { \
            const unsigned char* pr_ = PROJb + (size_t)(r0_ + 16 * n + fr) * (NINP * 2); \
            pfU[n] = *(const f32x4*)((const float*)pr_ + h * 128 + 16 * w + 4 * fq); \
            pfZ[n] = *(const u32x2*)((const bf16_t*)pr_ + 1536 + h * 128 + 16 * w + 4 * fq); } \
        pfE = EGL[(b * 4 + h) * 32 + (cc)]; } while (0)
#define SCAN_STAGE() do { \
        _Pragma("unroll") for (int jj = 0; jj < 2; ++jj) { \
            *(LAS u32x4*)(Wl + (s_row + 32 * jj) * 272 + s_ch * 16) = pfW[jj]; \
            *(LAS u32x4*)(Ql + (s_row + 32 * jj) * 272 + s_ch * 16) = pfQ[jj]; \
            *(LAS u32x4*)(Kl + (k_dk + 64 * jj) * 144 + k_ch * 16) = pfK[jj]; } \
        *(LAS u32x4*)(Xl + k_dk * 144 + k_ch * 16) = pfX; } while (0)
    __syncthreads();
    SCAN_PREFETCH(0);
    SCAN_STAGE();
    for (int c = 0; c < 32; ++c) {
        const int r0 = b * TP + c * 64;
        f32x4 cu[4]; u32x2 cz[4];
#pragma unroll
        for (int n = 0; n < 4; ++n) { cu[n] = pfU[n]; cz[n] = pfZ[n]; }
        const float eg = pfE;
        __syncthreads();
        if (c + 1 < 32) SCAN_PREFETCH(c + 1);
#pragma unroll
        for (int n8 = 0; n8 < 8; ++n8)
#pragma unroll
            for (int r = 0; r < 4; ++r) *(LAS bf16_t*)(St + (16 * w + 4 * fq + r) * 272 + (16 * n8 + fr) * 2) = (bf16_t)(cvt_pk_bf16(Sacc[n8][r], 0.f) & 0xffffu);
        LDS_WAIT();
        bf16x8 sA[4];
#pragma unroll
        for (int ks = 0; ks < 4; ++ks) sA[ks] = *(const LAS bf16x8*)(St + (16 * w + fr) * 272 + (ks * 32 + fq * 8) * 2);
        f32x4 vn[4], oa[4];
#pragma unroll
        for (int n = 0; n < 4; ++n) {
            f32x4 acc = {0.f, 0.f, 0.f, 0.f}, o = {0.f, 0.f, 0.f, 0.f};
#pragma unroll
            for (int ks = 0; ks < 4; ++ks) {
                acc = MFMA16(sA[ks], *(const LAS bf16x8*)(Wl + (16 * n + fr) * 272 + (ks * 32 + fq * 8) * 2), acc);
                o = MFMA16(sA[ks], *(const LAS bf16x8*)(Ql + (16 * n + fr) * 272 + (ks * 32 + fq * 8) * 2), o);
            }
            vn[n] = cu[n] - acc; oa[n] = o;
        }
#pragma unroll
        for (int n = 0; n < 4; ++n)
#pragma unroll
            for (int r = 0; r < 4; ++r) *(LAS bf16_t*)(Vn + (16 * w + 4 * fq + r) * 144 + (16 * n + fr) * 2) = (bf16_t)(cvt_pk_bf16(vn[n][r], 0.f) & 0xffffu);
        LDS_WAIT();
        bf16x8 vA[2];
#pragma unroll
        for (int k2 = 0; k2 < 2; ++k2) vA[k2] = *(const LAS bf16x8*)(Vn + (16 * w + fr) * 144 + (k2 * 32 + fq * 8) * 2);
#pragma unroll
        for (int n = 0; n < 4; ++n)
#pragma unroll
            for (int k2 = 0; k2 < 2; ++k2) oa[n] = MFMA16(vA[k2], *(const LAS bf16x8*)(Xl + (16 * n + fr) * 144 + (k2 * 32 + fq * 8) * 2), oa[n]);
#pragma unroll
        for (int n8 = 0; n8 < 8; ++n8) {
            f32x4 sv = Sacc[n8] * eg;
#pragma unroll
            for (int k2 = 0; k2 < 2; ++k2) sv = MFMA16(vA[k2], *(const LAS bf16x8*)(Kl + (16 * n8 + fr) * 144 + (k2 * 32 + fq * 8) * 2), sv);
            Sacc[n8] = sv;
        }
        LAS float* sp = ssp + (c & 1) * 512;
#pragma unroll
        for (int n = 0; n < 4; ++n) {
            float q = (oa[n][0] * oa[n][0] + oa[n][1] * oa[n][1]) + (oa[n][2] * oa[n][2] + oa[n][3] * oa[n][3]);
            q += __shfl_xor(q, 16); q += __shfl_xor(q, 32);
            if (fq == 0) sp[w * 64 + 16 * n + fr] = q;
        }
        __syncthreads();
        if (c + 1 < 32) SCAN_STAGE();
#pragma unroll
        for (int n = 0; n < 4; ++n) {
            const int tok = 16 * n + fr;
            float tot = 0.f;
#pragma unroll
            for (int ww = 0; ww < 8; ++ww) tot += sp[ww * 64 + tok];
            const float rs = rsqrtf(tot * (1.f / 128.f) + EPS);
            const u32x2 zr = cz[n];
            const float z0 = bf2f(zr.x & 0xffffu), z1 = bf2f(zr.x >> 16), z2 = bf2f(zr.y & 0xffffu), z3 = bf2f(zr.y >> 16);
            u32x2 ow;
            ow.x = cvt_pk_bf16(oa[n][0] * rs * gnv[0] * (z0 * sigmoidf_(z0)), oa[n][1] * rs * gnv[1] * (z1 * sigmoidf_(z1)));
            ow.y = cvt_pk_bf16(oa[n][2] * rs * gnv[2] * (z2 * sigmoidf_(z2)), oa[n][3] * rs * gnv[3] * (z3 * sigmoidf_(z3)));
            *(u32x2*)(MIX + (size_t)(r0 + tok) * 1024 + h * 128 + 16 * w + 4 * fq) = ow;
        }
    }
#undef SCAN_PREFETCH
#undef SCAN_STAGE
    float* Sout = a->out + O_SGP + (size_t)(b * 4 + h) * 16384;
#pragma unroll
    for (int n8 = 0; n8 < 8; ++n8) *(f32x4*)(Sout + (size_t)(16 * n8 + fr) * 128 + 16 * w + 4 * fq) = Sacc[n8];
}

__device__ __forceinline__ void swa_item(CArgs* a, LAS unsigned char* L, int it) {
    const int tid = threadIdx.x, lane = tid & 63, wave = tid >> 6;
    unsigned char* ws = a->ws;
    const bf16_t* QS = (const bf16_t*)(ws + WS_QS); const bf16_t* KS = (const bf16_t*)(ws + WS_KS); const bf16_t* VS = (const bf16_t*)(ws + WS_VS);
    bf16_t* MIX = (bf16_t*)(ws + WS_MIX);
    const bool samp = it >= 2048;
    int b, kvh, tq0, nq, row0;
    if (!samp) { b = it >> 7; const int rem = it & 127; kvh = rem & 1; tq0 = (rem >> 1) * 32; nq = 32; row0 = b * TP; }
    else { const int i2 = it - 2048; b = i2 >> 1; kvh = i2 & 1; tq0 = 0; nq = TS; row0 = MP + b * TS; }
    const int nrows = 127 + nq;
    LAS float* Kf = (LAS float*)L;
    LAS float* Vf = Kf + 159 * 68;
    LAS float* Qw = Vf + 159 * 68;
    LAS float* Pw = Qw + 8 * 256;
    __syncthreads();
    for (int e = tid; e < nrows * 8; e += 512) {
        const int j = e >> 3, d8 = (e & 7) * 8, p = tq0 - 127 + j;
        float kx[8], vx[8];
        if (p >= 0) {
            const size_t o_ = (size_t)(row0 + p) * 128 + kvh * 64 + d8;
            unpack8(*(const u32x4*)(KS + o_), kx); unpack8(*(const u32x4*)(VS + o_), vx);
        } else if (samp) {
            const size_t o_ = ((size_t)b * 128 + (128 + p)) * 128 + kvh * 64 + d8;
            const f32x4 k0 = *(const f32x4*)(a->in[4] + o_), k1 = *(const f32x4*)(a->in[4] + o_ + 4), v0 = *(const f32x4*)(a->in[5] + o_), v1 = *(const f32x4*)(a->in[5] + o_ + 4);
#pragma unroll
            for (int i = 0; i < 4; ++i) { kx[i] = k0[i]; kx[4 + i] = k1[i]; vx[i] = v0[i]; vx[4 + i] = v1[i]; }
        } else {
#pragma unroll
            for (int i = 0; i < 8; ++i) { kx[i] = 0.f; vx[i] = 0.f; }
        }
        *(LAS f32x4*)(Kf + j * 68 + d8) = (f32x4){kx[0], kx[1], kx[2], kx[3]}; *(LAS f32x4*)(Kf + j * 68 + d8 + 4) = (f32x4){kx[4], kx[5], kx[6], kx[7]};
        *(LAS f32x4*)(Vf + j * 68 + d8) = (f32x4){vx[0], vx[1], vx[2], vx[3]}; *(LAS f32x4*)(Vf + j * 68 + d8 + 4) = (f32x4){vx[4], vx[5], vx[6], vx[7]};
    }
    __syncthreads();
    LAS float* Qm = Qw + wave * 256;
    LAS float* Pm = Pw + wave * 512;
    for (int i = wave; i < nq; i += 8) {
        const int row = row0 + tq0 + i;
        {
            const u32x2 rq = *(const u32x2*)(QS + (size_t)row * 512 + kvh * 256 + lane * 4);
            *(LAS f32x4*)(Qm + lane * 4) = (f32x4){bf2f(rq.x & 0xffffu), bf2f(rq.x >> 16), bf2f(rq.y & 0xffffu), bf2f(rq.y >> 16)};
        }
        LDS_WAIT();
        float s[2][4];
#pragma unroll
        for (int kk = 0; kk < 2; ++kk) {
            const int j = i + lane + 64 * kk;
            const LAS float* kr = Kf + j * 68;
            float ac[4] = {0.f, 0.f, 0.f, 0.f};
#pragma unroll 4
            for (int d4 = 0; d4 < 16; ++d4) {
                const f32x4 kv = *(const LAS f32x4*)(kr + d4 * 4);
#pragma unroll
                for (int hh = 0; hh < 4; ++hh) {
                    const f32x4 qv = *(const LAS f32x4*)(Qm + hh * 64 + d4 * 4);
                    ac[hh] += (kv[0] * qv[0] + kv[1] * qv[1]) + (kv[2] * qv[2] + kv[3] * qv[3]);
                }
            }
            const bool valid = samp || (tq0 - 127 + j >= 0);
#pragma unroll
            for (int hh = 0; hh < 4; ++hh) s[kk][hh] = valid ? ac[hh] : -INFINITY;
        }
        f32x4 p0, p1;
#pragma unroll
        for (int hh = 0; hh < 4; ++hh) {
            const float sk = a->in[17][kvh * 4 + hh];
            float mx = wave_max(fmaxf(s[0][hh], s[1][hh]));
            mx = fmaxf(mx, sk);
            const float e0 = __expf(s[0][hh] - mx), e1 = __expf(s[1][hh] - mx);
            const float den = wave_sum(e0 + e1) + __expf(sk - mx);
            const float inv = 1.f / den;
            p0[hh] = e0 * inv; p1[hh] = e1 * inv;
        }
        *(LAS f32x4*)(Pm + lane * 4) = p0; *(LAS f32x4*)(Pm + (lane + 64) * 4) = p1;
        LDS_WAIT();
        float o[4] = {0.f, 0.f, 0.f, 0.f};
#pragma unroll 8
        for (int jj = 0; jj < 128; ++jj) {
            const f32x4 pj = *(const LAS f32x4*)(Pm + jj * 4);
            const float v = Vf[(i + jj) * 68 + lane];
            o[0] += pj[0] * v; o[1] += pj[1] * v; o[2] += pj[2] * v; o[3] += pj[3] * v;
        }
#pragma unroll
        for (int hh = 0; hh < 4; ++hh) MIX[(size_t)row * 1024 + 512 + (kvh * 4 + hh) * 64 + lane] = (bf16_t)(cvt_pk_bf16(o[hh], 0.f) & 0xffffu);
        LDS_WAIT();
    }
}

__device__ __forceinline__ void swa_item_mfma(CArgs* a, LAS unsigned char* L, int it) {
    const int tid = threadIdx.x, w = __builtin_amdgcn_readfirstlane(tid >> 6), lane = tid & 63, fr = lane & 15, fq = lane >> 4;
    unsigned char* ws = a->ws;
    const bf16_t* QS = (const bf16_t*)(ws + WS_QS); const bf16_t* KS = (const bf16_t*)(ws + WS_KS); const bf16_t* VS = (const bf16_t*)(ws + WS_VS);
    bf16_t* MIX = (bf16_t*)(ws + WS_MIX);
    const bool samp = it >= 1024;
    int b, kvh, tq0, nq, row0;
    if (!samp) { b = it >> 6; const int rem = it & 63; kvh = rem & 1; tq0 = (rem >> 1) * 64; nq = 64; row0 = b * TP; }
    else { const int i2 = it - 1024; b = i2 >> 1; kvh = i2 & 1; tq0 = 0; nq = TS; row0 = MP + b * TS; }
    LAS unsigned char* Ks = L;
    LAS unsigned char* Vt = L + 208 * 144;
    __syncthreads();
    for (int e = tid; e < 208 * 8; e += 512) {
        const int j = e >> 3, d8 = (e & 7) * 8, p = tq0 - 127 + j;
        u32x4 kraw = {0u, 0u, 0u, 0u}, vraw = {0u, 0u, 0u, 0u};
        if (j < 127 + nq) {
            if (p >= 0) { const size_t o_ = (size_t)(row0 + p) * 128 + kvh * 64 + d8; kraw = *(const u32x4*)(KS + o_); vraw = *(const u32x4*)(VS + o_); }
            else if (samp) {
                const size_t o_ = ((size_t)b * 128 + (128 + p)) * 128 + kvh * 64 + d8;
                const f32x4 k0 = *(const f32x4*)(a->in[4] + o_), k1 = *(const f32x4*)(a->in[4] + o_ + 4), v0 = *(const f32x4*)(a->in[5] + o_), v1 = *(const f32x4*)(a->in[5] + o_ + 4);
                kraw.x = cvt_pk_bf16(k0[0], k0[1]); kraw.y = cvt_pk_bf16(k0[2], k0[3]); kraw.z = cvt_pk_bf16(k1[0], k1[1]); kraw.w = cvt_pk_bf16(k1[2], k1[3]);
                vraw.x = cvt_pk_bf16(v0[0], v0[1]); vraw.y = cvt_pk_bf16(v0[2], v0[3]); vraw.z = cvt_pk_bf16(v1[0], v1[1]); vraw.w = cvt_pk_bf16(v1[2], v1[3]);
            }
        }
        *(LAS u32x4*)(Ks + j * 144 + d8 * 2) = kraw;
        LAS unsigned char* vp = Vt + d8 * 432 + j * 2;
        *(LAS bf16_t*)(vp + 0 * 432) = (bf16_t)(vraw.x & 0xffffu); *(LAS bf16_t*)(vp + 1 * 432) = (bf16_t)(vraw.x >> 16);
        *(LAS bf16_t*)(vp + 2 * 432) = (bf16_t)(vraw.y & 0xffffu); *(LAS bf16_t*)(vp + 3 * 432) = (bf16_t)(vraw.y >> 16);
        *(LAS bf16_t*)(vp + 4 * 432) = (bf16_t)(vraw.z & 0xffffu); *(LAS bf16_t*)(vp + 5 * 432) = (bf16_t)(vraw.z >> 16);
        *(LAS bf16_t*)(vp + 6 * 432) = (bf16_t)(vraw.w & 0xffffu); *(LAS bf16_t*)(vp + 7 * 432) = (bf16_t)(vraw.w >> 16);
    }
    __syncthreads();
    const int head = kvh * 4 + (w & 3);
    const float sink = a->in[17][head];
    for (int qt = (w >> 2) * 2; qt < (w >> 2) * 2 + 2; ++qt) {
        const int ql0 = qt * 16;
        if (ql0 >= nq) break;
        const int ql = ql0 + fr, qrow = ql < nq ? ql : nq - 1;
        bf16x8 qB[2];
#pragma unroll
        for (int ks = 0; ks < 2; ++ks) qB[ks] = *(const bf16x8*)(QS + (size_t)(row0 + tq0 + qrow) * 512 + head * 64 + ks * 32 + fq * 8);
        f32x4 st[10];
#pragma unroll
        for (int t = 0; t < 10; ++t) {
            f32x4 acc = {0.f, 0.f, 0.f, 0.f};
#pragma unroll
            for (int ks = 0; ks < 2; ++ks) acc = MFMA16(*(const LAS bf16x8*)(Ks + (ql0 + 16 * t + fr) * 144 + (ks * 32 + fq * 8) * 2), qB[ks], acc);
            st[t] = acc;
        }
        float mx = sink;
#pragma unroll
        for (int t = 0; t < 10; ++t)
#pragma unroll
            for (int r = 0; r < 4; ++r) {
                const int j = ql0 + 16 * t + 4 * fq + r, diff = ql + 127 - j;
                const bool valid = diff >= 0 && diff < 128 && (samp || tq0 - 127 + j >= 0);
                st[t][r] = valid ? st[t][r] : -INFINITY;
                mx = fmaxf(mx, st[t][r]);
            }
        mx = fmaxf(mx, __shfl_xor(mx, 16)); mx = fmaxf(mx, __shfl_xor(mx, 32));
        float sum = 0.f;
#pragma unroll
        for (int t = 0; t < 10; ++t)
#pragma unroll
            for (int r = 0; r < 4; ++r) { const float p = __expf(st[t][r] - mx); st[t][r] = p; sum += p; }
        sum += __shfl_xor(sum, 16); sum += __shfl_xor(sum, 32);
        const float inv = 1.f / (sum + __expf(sink - mx));
        f32x4 oa[4];
#pragma unroll
        for (int mt = 0; mt < 4; ++mt) oa[mt] = (f32x4){0.f, 0.f, 0.f, 0.f};
#pragma unroll
        for (int s2 = 0; s2 < 5; ++s2) {
            u32x4 pw;
            pw.x = cvt_pk_bf16(st[2 * s2][0], st[2 * s2][1]); pw.y = cvt_pk_bf16(st[2 * s2][2], st[2 * s2][3]);
            pw.z = cvt_pk_bf16(st[2 * s2 + 1][0], st[2 * s2 + 1][1]); pw.w = cvt_pk_bf16(st[2 * s2 + 1][2], st[2 * s2 + 1][3]);
            const bf16x8 pB = __builtin_bit_cast(bf16x8, pw);
#pragma unroll
            for (int mt = 0; mt < 4; ++mt) {
                const LAS unsigned char* vp = Vt + (16 * mt + fr) * 432 + (ql0 + 32 * s2 + 4 * fq) * 2;
                const u32x2 v0 = *(const LAS u32x2*)vp, v1 = *(const LAS u32x2*)(vp + 32);
                u32x4 vw; vw.x = v0.x; vw.y = v0.y; vw.z = v1.x; vw.w = v1.y;
                oa[mt] = MFMA16(__builtin_bit_cast(bf16x8, vw), pB, oa[mt]);
            }
        }
        if (ql < nq) {
            bf16_t* dst = MIX + (size_t)(row0 + tq0 + ql) * 1024 + 512 + head * 64 + 4 * fq;
#pragma unroll
            for (int mt = 0; mt < 4; ++mt) {
                u32x2 ow; ow.x = cvt_pk_bf16(oa[mt][0] * inv, oa[mt][1] * inv); ow.y = cvt_pk_bf16(oa[mt][2] * inv, oa[mt][3] * inv);
                *(u32x2*)(dst + 16 * mt) = ow;
            }
        }
    }
}

__device__ __forceinline__ void p5b_finalize(CArgs* a) {
    const int tid = threadIdx.x, lane = tid & 63, wave = tid >> 6;
    unsigned char* ws = a->ws;
    const unsigned char* PROJb = ws + WS_PROJ; bf16_t* MIX = (bf16_t*)(ws + WS_MIX);
    const int gw = blockIdx.x * 8 + wave, NGW = gridDim.x * 8;
    const float* gn = a->in[16] + (lane & 15) * 8;
    const f32x4 g0 = *(const f32x4*)gn, g1 = *(const f32x4*)(gn + 4);
    for (int r = MP + gw; r < M; r += NGW) {
        const float* og = (const float*)(PROJb + (size_t)r * (NINP * 2)) + lane * 8;
        const f32x4 o0 = *(const f32x4*)og, o1 = *(const f32x4*)(og + 4);
        float z[8]; unpack8(*(const u32x4*)((const bf16_t*)(PROJb + (size_t)r * (NINP * 2)) + 1536 + lane * 8), z);
        float ssq = (o0[0] * o0[0] + o0[1] * o0[1]) + (o0[2] * o0[2] + o0[3] * o0[3]) + (o1[0] * o1[0] + o1[1] * o1[1]) + (o1[2] * o1[2] + o1[3] * o1[3]);
        ssq += __shfl_xor(ssq, 1); ssq += __shfl_xor(ssq, 2); ssq += __shfl_xor(ssq, 4); ssq += __shfl_xor(ssq, 8);
        const float rs = rsqrtf(ssq * (1.f / 128.f) + EPS);
        float x[8];
#pragma unroll
        for (int i = 0; i < 4; ++i) { x[i] = o0[i] * rs * g0[i] * (z[i] * sigmoidf_(z[i])); x[4 + i] = o1[i] * rs * g1[i] * (z[4 + i] * sigmoidf_(z[4 + i])); }
        *(u32x4*)(MIX + (size_t)r * 1024 + lane * 8) = pack8(x);
    }
}

__device__ __forceinline__ void p10_final(CArgs* a) {
    const int tid = threadIdx.x, lane = tid & 63, wave = tid >> 6;
    const float* SS5 = (const float*)(a->ws + WS_SS) + 4 * (size_t)M;
    const int gw = blockIdx.x * 8 + wave, NGW = gridDim.x * 8;
    f32x4 g[4];
#pragma unroll
    for (int j = 0; j < 4; ++j) g[j] = ((const f32x4*)a->in[25])[lane + 64 * j];
    for (int r = gw; r < M; r += NGW) {
        const float rs = rsqrtf(SS5[r] * (1.f / DM) + EPS);
        f32x4* y = (f32x4*)(a->out + O_Y + (size_t)r * DM);
#pragma unroll
        for (int j = 0; j < 4; ++j) { const f32x4 v = y[lane + 64 * j]; y[lane + 64 * j] = v * rs * g[j]; }
    }
}

#define XB_TMO      128
#define XB_XCNT(j)  (256  + 64 * (j))
#define XB_XSUB(j)  (1280 + 64 * (j))
#define XB_XGEN(j)  (2304 + 64 * (j))
#define XB_TOP      3328
#define XB_TOPGEN   3392
#define XCD_BAR_WORDS 3456
#define XB_SPIN_CAP (1u << 18)

__device__ __forceinline__ unsigned xb_ld(unsigned* p)              { return __hip_atomic_load(p, __ATOMIC_RELAXED, __HIP_MEMORY_SCOPE_AGENT); }
__device__ __forceinline__ unsigned xb_add(unsigned* p, unsigned v) { return __hip_atomic_fetch_add(p, v, __ATOMIC_RELAXED, __HIP_MEMORY_SCOPE_AGENT); }
__device__ __forceinline__ unsigned xb_xcc_id() { return (unsigned)__builtin_amdgcn_s_getreg((3 << 11) | 20) & 0xFu; }
#define XB_SPIN(cond, bar) do { unsigned _sp = 0; while (cond) { __builtin_amdgcn_s_sleep(1); \
    if ((++_sp & 255u) == 0u) { if (xb_ld(&(bar)[XB_TMO])) break; if (_sp > XB_SPIN_CAP) { atomicAdd(&(bar)[XB_TMO], 1u); break; } } } } while (0)

struct XcdBarrier {
    unsigned* bar; unsigned x;
    volatile LAS unsigned* st;
};

__device__ __forceinline__ XcdBarrier xcd_barrier_post(unsigned* bar, volatile LAS unsigned* st) {
    XcdBarrier b; b.bar = bar; b.x = xb_xcc_id(); b.st = st;
    if (threadIdx.x == 0) (void)xb_add(&bar[XB_XCNT(b.x)], 1u);
    return b;
}
__device__ __forceinline__ void xcd_barrier_complete(unsigned* bar, unsigned x, unsigned& nloc, unsigned& nx) {
    const unsigned G = gridDim.x * gridDim.y * gridDim.z;
    unsigned sum, cnt, mine, sp = 0u;
    for (;;) {
        sum = 0u; cnt = 0u; mine = 0u;
#pragma unroll
        for (unsigned j = 0; j < 16; ++j) { const unsigned c = xb_ld(&bar[XB_XCNT(j)]); sum += c; cnt += (c > 0u) ? 1u : 0u; mine = (j == x) ? c : mine; }
        if (sum == G) break;
        __builtin_amdgcn_s_sleep(1);
        if ((++sp & 255u) == 0u) { if (xb_ld(&bar[XB_TMO])) break; if (sp > XB_SPIN_CAP) { atomicAdd(&bar[XB_TMO], 1u); break; } }
    }
    nloc = mine > 0u ? mine : 1u; nx = cnt > 0u ? cnt : 1u;
}

__device__ __forceinline__ void xcd_barrier(const XcdBarrier& b) {
    asm volatile("s_waitcnt vmcnt(0)" ::: "memory");
    __syncthreads();
    if (threadIdx.x == 0) {
        unsigned* bar = b.bar;
        __builtin_amdgcn_s_waitcnt(0);
        unsigned nloc = b.st[0], nx = b.st[1];
        if (nloc == 0u) { xcd_barrier_complete(bar, b.x, nloc, nx); b.st[0] = nloc; b.st[1] = nx; }
        const unsigned old = xb_add(&bar[XB_XSUB(b.x)], 1u);
        const unsigned gen = old / nloc;
        if (old + 1u == (gen + 1u) * nloc) {
            __builtin_amdgcn_fence(__ATOMIC_RELEASE, "agent");
            asm volatile("s_waitcnt vmcnt(0)" ::: "memory");
            const unsigned og = xb_add(&bar[XB_TOP], 1u);
            const unsigned tg = og / nx;
            if (og + 1u == (tg + 1u) * nx) xb_add(&bar[XB_TOPGEN], 1u);
            else XB_SPIN(xb_ld(&bar[XB_TOPGEN]) == tg, bar);
            __builtin_amdgcn_fence(__ATOMIC_ACQUIRE, "agent");
            xb_add(&bar[XB_XGEN(b.x)], 1u);
            asm volatile("s_waitcnt vmcnt(0)" ::: "memory");
        } else {
            XB_SPIN(xb_ld(&bar[XB_XGEN(b.x)]) == gen, bar);
            __builtin_amdgcn_fence(__ATOMIC_ACQUIRE, "agent");
            asm volatile("s_waitcnt vmcnt(0)" ::: "memory");
        }
    }
    __syncthreads();
}

constexpr int NPHASE = 13;
#ifndef PHMASK
#define PHMASK 0x1FFF
#endif
#ifndef DUP_MISC
#define DUP_MISC 1
#endif
__global__ void __launch_bounds__(512, 2) mk_fwd(Args a_by_value) {
    extern __shared__ __attribute__((aligned(16))) unsigned char lds_raw[];
    LAS unsigned char* L = (LAS unsigned char*)lds_raw;
    cg::grid_group grid = cg::this_grid();
    const int lo = get_args()->ph_lo, hi = get_args()->ph_hi, G = gridDim.x, bid = blockIdx.x;
    if (lo > 1000) grid.sync();
    volatile LAS unsigned* xbst = (volatile LAS unsigned*)(L + LDS_XB);
    if (threadIdx.x < 2) xbst[threadIdx.x] = 0u;
    __syncthreads();
    if (hi - lo > 1) (void)xcd_barrier_post((unsigned*)(get_args()->ws + WS_BAR), xbst);
#define IN(k) (((PHMASK >> (k)) & 1) && lo <= (k) && (k) < hi)
#define SEAM(k) do { if (IN(k) && IN((k) + 1)) { XcdBarrier xb_; xb_.bar = (unsigned*)(get_args()->ws + WS_BAR); xb_.x = xb_xcc_id(); xb_.st = xbst; xcd_barrier(xb_); } } while (0)
#define PH_ARGS() CArgs* a = get_args(); unsigned char* ws = a->ws; (void)ws
    if (IN(0)) { PH_ARGS(); for (int rep = 0; rep < DUP_MISC; ++rep) p0_prologue(a, L); } SEAM(0);
    if (IN(1)) {
        PH_ARGS(); float* SS = (float*)(ws + WS_SS);
        pg8::Gemm g{(const bf16_t*)(ws + WS_HB), (const bf16_t*)(ws + WS_GU1), M, NGU, DM}; pg8::StaticOrder S; S.init(M, NGU, G, bid);
        EpiSwiglu E{(bf16_t*)(ws + WS_ACT), SS};
#ifndef DUP_P1
#define DUP_P1 1
#endif
        for (int rep = 0; rep < DUP_P1; ++rep)
        pg8::gemm_phase<EpiSwiglu, pg8::StaticOrder, true, true>(L, g, S, E);
    } SEAM(1);
    if (IN(2)) {
        PH_ARGS(); float* SS = (float*)(ws + WS_SS);
        pg8::Gemm g{(const bf16_t*)(ws + WS_ACT), (const bf16_t*)(ws + WS_D1), M, DM, DFF}; pg8::StaticOrder S; S.init(M, DM, G, bid);
        EpiResid E{a->in[0], a->in[1], a->out + O_Y, (bf16_t*)(ws + WS_HB), SS + M, 0.5f};
        pg8::gemm_phase<EpiResid, pg8::StaticOrder, true, true>(L, g, S, E);
    } SEAM(2);
    if (IN(3)) {
        PH_ARGS(); float* SS = (float*)(ws + WS_SS);
        pg8::Gemm g{(const bf16_t*)(ws + WS_HB), (const bf16_t*)(ws + WS_IN), M, NINP, DM}; pg8::StaticOrder S; S.init(M, NINP, G, bid);
        EpiProj E{(bf16_t*)(ws + WS_PROJ), SS + M, (float*)(ws + WS_AB)};
        pg8::gemm_phase<EpiProj, pg8::StaticOrder, true, true>(L, g, S, E);
    } SEAM(3);
    if (IN(4)) { PH_ARGS(); for (int rep = 0; rep < DUP_MISC; ++rep) p4_mixprep(a); } SEAM(4);
    if (IN(5)) { PH_ARGS(); for (int pr = bid; pr < 1024; pr += G) gdn_chunk_prep(a, L, pr); } SEAM(5);
    if (IN(6)) {
        PH_ARGS();
        const int nded = G >= 128 ? 64 : 0;
        if (bid < nded) gdn_chunk_scan(a, L, bid);
        unsigned* ctr = (unsigned*)(ws + WS_CTR);
        LAS unsigned* wq = (LAS unsigned*)(L + LDS_WQ);
        const int nitems = (nded ? 0 : 64) + 2048 + 1280;
        for (;;) {
            __syncthreads();
            if (threadIdx.x == 0) *wq = __hip_atomic_fetch_add(ctr, 1u, __ATOMIC_RELAXED, __HIP_MEMORY_SCOPE_AGENT);
            __syncthreads();
            int it = (int)*wq;
            if (it >= nitems) break;
            if (!nded) { if (it < 64) { gdn_chunk_scan(a, L, it); continue; } it -= 64; }
            if (it < 1280) swa_item_mfma(a, L, it);
            else gdn_item(a, L, it - 1280, true);
        }
    } SEAM(6);
    if (IN(7)) { PH_ARGS(); p5b_finalize(a); } SEAM(7);
    if (IN(8)) {
        PH_ARGS(); float* SS = (float*)(ws + WS_SS); float* HF = a->out + O_Y;
        pg8::Gemm g{(const bf16_t*)(ws + WS_MIX), (const bf16_t*)(ws + WS_OUT), M, DM, DM}; pg8::StaticOrder S; S.init(M, DM, G, bid);
        EpiResid E{HF, HF + (size_t)MP * DM, HF, (bf16_t*)(ws + WS_HB), SS + 2 * M, 1.0f};
        pg8::gemm_phase<EpiResid, pg8::StaticOrder, true, true>(L, g, S, E);
    } SEAM(8);
    if (IN(9)) {
        PH_ARGS(); float* SS = (float*)(ws + WS_SS);
        pg8::Gemm g{(const bf16_t*)(ws + WS_HB), (const bf16_t*)(ws + WS_GU2), M, NGU, DM}; pg8::StaticOrder S; S.init(M, NGU, G, bid);
        EpiSwiglu E{(bf16_t*)(ws + WS_ACT), SS + 2 * M};
        pg8::gemm_phase<EpiSwiglu, pg8::StaticOrder, true, true>(L, g, S, E);
    } SEAM(9);
    if (IN(10)) {
        {
            PH_ARGS(); float* SS = (float*)(ws + WS_SS); float* HF = a->out + O_Y;
            pg8::Gemm g{(const bf16_t*)(ws + WS_ACT), (const bf16_t*)(ws + WS_D2), M, DM, DFF}; pg8::StaticOrder S; S.init(M, DM, G, bid);
            EpiResid E{HF, HF + (size_t)MP * DM, HF, (bf16_t*)(ws + WS_HB), SS + 3 * M, 0.5f};
            pg8::gemm_phase<EpiResid, pg8::StaticOrder, true, true>(L, g, S, E);
        }
        {
            PH_ARGS();
            int kple = PLE; asm volatile("" : "+s"(kple)); kple = __builtin_amdgcn_readfirstlane(kple);
            pg8::Gemm g{(const bf16_t*)(ws + WS_PB), (const bf16_t*)(ws + WS_PPW), M, DM, kple}; pg8::StaticOrder S; S.init(M, DM, G, bid);
            EpiPlain E{(bf16_t*)(ws + WS_PP)};
            pg8::gemm_phase<EpiPlain, pg8::StaticOrder, true, true>(L, g, S, E);
        }
    } SEAM(10);
    if (IN(11)) {
        PH_ARGS(); float* SS = (float*)(ws + WS_SS);
        pg8::Gemm g{(const bf16_t*)(ws + WS_HB), (const bf16_t*)(ws + WS_PG), M, DM, DM}; pg8::StaticOrder S; S.init(M, DM, G, bid);
        EpiGate E{a->out + O_Y, (const bf16_t*)(ws + WS_PP), SS + 3 * M, SS + 4 * M};
        pg8::gemm_phase<EpiGate, pg8::StaticOrder, true, true>(L, g, S, E);
    } SEAM(11);
    if (IN(12)) { PH_ARGS(); p10_final(a); }
#undef IN
#undef SEAM
#undef PH_ARGS
}

#ifndef MK_LAUNCHES
#define MK_LAUNCHES 1
#endif
extern "C" void kernel_launch(void* const* d_in, const int* in_sizes, int n_in, void* d_out, int out_size, void* d_ws, size_t ws_size, hipStream_t stream) {
    static int grid = 0;
    if (grid == 0) {
        if (n_in != 26 || (size_t)out_size != O_END || ws_size < WS_END) {
            fprintf(stderr, "kernel_launch: unexpected shapes: n_in %d out %d ws %zu (need out %zu, ws >= %zu)\n", n_in, out_size, ws_size, (size_t)O_END, (size_t)WS_END);
            grid = -1; return;
        }
        int dev = 0, cus = 0, per_cu = 0;
        hipGetDevice(&dev);
        hipDeviceGetAttribute(&cus, hipDeviceAttributeMultiprocessorCount, dev);
        if (hipFuncSetAttribute((const void*)mk_fwd, hipFuncAttributeMaxDynamicSharedMemorySize, LDS_BYTES) != hipSuccess) { fprintf(stderr, "kernel_launch: hipFuncSetAttribute failed\n"); grid = -1; return; }
        if (hipOccupancyMaxActiveBlocksPerMultiprocessor(&per_cu, (const void*)mk_fwd, 512, LDS_BYTES) != hipSuccess || per_cu < 1) { fprintf(stderr, "kernel_launch: occupancy query gave %d\n", per_cu); per_cu = 1; }
        (void)hipGetLastError();
        grid = cus * per_cu;
        fprintf(stderr, "kernel_launch: grid %d (cus %d x %d)\n", grid, cus, per_cu);
    }
    if (grid < 0) return;
    Args a{};
    for (int i = 0; i < 26; ++i) a.in[i] = (const float*)d_in[i];
    a.out = (float*)d_out; a.ws = (unsigned char*)d_ws;
    if (hipMemsetAsync((unsigned char*)d_ws + WS_BAR, 0, WS_BAR_BYTES, stream) != hipSuccess) { fprintf(stderr, "kernel_launch: memset of the barrier words failed\n"); return; }
#if MK_LAUNCHES == 1
    a.ph_lo = 0; a.ph_hi = NPHASE;
    void* kargs[] = {&a};
    hipError_t e = hipLaunchCooperativeKernel((const void*)mk_fwd, dim3(grid), dim3(512), kargs, LDS_BYTES, stream);
    if (e != hipSuccess) fprintf(stderr, "kernel_launch: cooperative launch failed: %s (grid %d)\n", hipGetErrorString(e), grid);
#else
    for (int p = 0; p < NPHASE; ++p) {
        a.ph_lo = p; a.ph_hi = p + 1;
        hipLaunchKernelGGL(mk_fwd, dim3(grid), dim3(512), LDS_BYTES, stream, a);
    }
#endif
}
```

```cpp
#include <hip/hip_runtime.h>
#include <hip/hip_cooperative_groups.h>
#include <cstdio>
#include <cstdint>
namespace cg = cooperative_groups;
namespace pg8 {
#define PG8_LAS __attribute__((address_space(3)))
typedef unsigned short bf16_t;
typedef short bf16x8 __attribute__((ext_vector_type(8)));
typedef float f32x4 __attribute__((ext_vector_type(4)));
typedef unsigned u32x4 __attribute__((ext_vector_type(4)));
constexpr int BM = 256, BK = 64, HALF = 128, HTB = HALF * BK * 2  , STAGE_BYTES = 8 * HTB, NXCD = 8, WGM = 8;

__host__ __device__ __forceinline__ int lds_byte(int r, int c) { const int st = (r >> 4) * 2 + (c >> 5), rr = r & 15, cc = c & 31, ob = rr * 64 + cc * 2; return st * 1024 + (ob ^ (((ob >> 9) & 1) << 5)); }
__host__ __device__ __forceinline__ void stage_rc(int b, int& R, int& C) { const int st = b / 1024, sb = b % 1024, swz = sb ^ (((sb >> 9) & 1) << 5); R = (st >> 1) * 16 + swz / 64; C = (st & 1) * 32 + (swz % 64) / 2; }
__host__ __device__ __forceinline__ int perm32(int rho) { const int n = rho >> 4, i = rho & 15; return 8 * (i >> 2) + 4 * n + (i & 3); }

struct Unit { int pm, pn; };
struct Gemm { const bf16_t* A; const bf16_t* Bt; int M, N, K; };

struct StaticOrder {
    int nM, nN, nwg, G, c;
    __host__ __device__ void init(int M, int N, int G_, int c_) { nM = M / BM; nN = N / BM; nwg = nM * nN; G = G_; c = c_; }
    __host__ __device__ bool next(int i, Unit& u) const {
        const long L = (long)i * G + c; if (L >= nwg) return false;
        int wgid = (int)L; { const int q = nwg / NXCD, r = nwg % NXCD, xcd = wgid % NXCD, off = wgid / NXCD; wgid = (xcd < r ? xcd * (q + 1) : r * (q + 1) + (xcd - r) * q) + off; }
        const int nig = WGM * nN, gid = wgid / nig, fm = gid * WGM, gsz = (nM - fm) < WGM ? (nM - fm) : WGM;
        u.pm = fm + ((wgid % nig) % gsz); u.pn = (wgid % nig) / gsz; return true;
    }
    __device__ __forceinline__ void a_ready(const Unit&) const {}
    __device__ __forceinline__ void done(const Unit&) const {}
};

__device__ __forceinline__ unsigned cvt_pk_bf16(float lo, float hi) { unsigned r; asm volatile("v_cvt_pk_bf16_f32 %0, %1, %2" : "=v"(r) : "v"(lo), "v"(hi)); return r; }
typedef float f32x2 __attribute__((ext_vector_type(2)));
template <class Epi, class Sched, bool ALIGN_EPI = false, bool SP2 = false>
__device__ __forceinline__ void gemm_phase(PG8_LAS unsigned char* lds, const Gemm g, const Sched& S, const Epi& E) {
    const int tid = threadIdx.x, wid = __builtin_amdgcn_readfirstlane(tid >> 6), lane = tid & 63, wr = wid >> 2, wc = wid & 3, fr = lane & 15, fq = lane >> 4;
    const int K = g.K, nt = K / BK;
    unsigned voffA[2], voffB[2];
#pragma unroll
    for (int i = 0; i < 2; ++i) { int R, C; stage_rc(tid * 16 + i * 8192, R, C); const int Rb = Epi::PERM ? ((R & ~31) + perm32(R & 31)) : R;
        voffA[i] = (unsigned)(R * K + C) * 2u; voffB[i] = (unsigned)(Rb * K + C) * 2u; }
    const size_t kstep = (size_t)(BK * 2);
    const size_t hstep = (size_t)HALF * K * 2;
    const size_t tstep = 2 * hstep;
    const unsigned ldsw = (unsigned)wid * 1024u;
    const int aoff = lds_byte(wr * 64 + fr, fq * 8), boff = lds_byte(wc * 32 + fr, fq * 8);
#define PG8_SA(b, h) (((b) * 2 + (h)) * HTB)
#define PG8_SB(b, h) ((4 + (b) * 2 + (h)) * HTB)
#define PG8_STAGE(bufoff, gbase, voff) do { _Pragma("unroll") for (int _i = 0; _i < 2; ++_i) \
        __builtin_amdgcn_global_load_lds((const unsigned*)((const char*)(gbase) + (voff)[_i]), (PG8_LAS unsigned*)(lds + (bufoff) + ldsw + _i * 8192), 16, 0, 0); } while (0)
#define PG8_LDA(dst, b, h) do { _Pragma("unroll") for (int m = 0; m < 4; ++m) _Pragma("unroll") for (int k = 0; k < 2; ++k) dst[m][k] = *(const PG8_LAS bf16x8*)(lds + PG8_SA(b, h) + aoff + m * 2048 + k * 1024); } while (0)
#define PG8_LDB(dst, b, h) do { _Pragma("unroll") for (int n = 0; n < 2; ++n) _Pragma("unroll") for (int k = 0; k < 2; ++k) dst[n][k] = *(const PG8_LAS bf16x8*)(lds + PG8_SB(b, h) + boff + n * 2048 + k * 1024); } while (0)
#define PG8_MMA(ai, bj, At, Bt) do { __builtin_amdgcn_s_setprio(1); _Pragma("unroll") for (int m = 0; m < 4; ++m) _Pragma("unroll") for (int n = 0; n < 2; ++n) _Pragma("unroll") for (int k = 0; k < 2; ++k) \
        acc[ai][bj][m][n] = __builtin_amdgcn_mfma_f32_16x16x32_bf16(Bt[n][k], At[m][k], acc[ai][bj][m][n], 0, 0, 0); __builtin_amdgcn_s_setprio(0); } while (0)
#define PG8_WAIT_V(n) asm volatile("s_waitcnt vmcnt(" #n ")" ::: "memory")
#define PG8_WAIT_L(n) asm volatile("s_waitcnt lgkmcnt(" #n ")" ::: "memory")
#define PG8_BAR __builtin_amdgcn_s_barrier()
#define PG8_SCHED __builtin_amdgcn_sched_barrier(0)
    Unit cur, nxt; int ui = 0;
    if (!S.next(0, cur)) return;
    f32x4 acc[2][2][4][2];
#pragma unroll
    for (int a = 0; a < 2; ++a)
#pragma unroll
        for (int b = 0; b < 2; ++b)
#pragma unroll
            for (int m = 0; m < 4; ++m)
#pragma unroll
                for (int n = 0; n < 2; ++n) acc[a][b][m][n] = (f32x4){0.f, 0.f, 0.f, 0.f};
    bf16x8 At[4][2], B0[2][2], B1[2][2];
    const char* cA = (const char*)g.A + (size_t)cur.pm * tstep; const char* cB = (const char*)g.Bt + (size_t)cur.pn * tstep;
    S.a_ready(cur);
    if constexpr (SP2) {
        PG8_STAGE(PG8_SB(0, 0), cB, voffB); PG8_STAGE(PG8_SB(0, 1), cB + hstep, voffB); PG8_STAGE(PG8_SA(0, 0), cA, voffA); PG8_STAGE(PG8_SA(0, 1), cA + hstep, voffA);
        if (wr == 1) PG8_BAR;
        PG8_WAIT_V(2); PG8_BAR;
        PG8_STAGE(PG8_SB(1, 0), cB + kstep, voffB); PG8_STAGE(PG8_SA(1, 0), cA + kstep, voffA); PG8_STAGE(PG8_SB(1, 1), cB + hstep + kstep, voffB);
        PG8_WAIT_V(6); PG8_BAR;
    } else {
        PG8_STAGE(PG8_SB(0, 0), cB, voffB); PG8_STAGE(PG8_SA(0, 0), cA, voffA); PG8_STAGE(PG8_SB(0, 1), cB + hstep, voffB); PG8_STAGE(PG8_SA(0, 1), cA + hstep, voffA);
        if (wr == 1) PG8_BAR;
        PG8_WAIT_V(4); PG8_BAR;
        PG8_STAGE(PG8_SB(1, 0), cB + kstep, voffB); PG8_STAGE(PG8_SA(1, 0), cA + kstep, voffA); PG8_STAGE(PG8_SB(1, 1), cB + hstep + kstep, voffB);
        PG8_WAIT_V(6); PG8_BAR;
    }
    for (;;) {
        const bool has_next = S.next(ui + 1, nxt);
        const char* nA = has_next ? (const char*)g.A + (size_t)nxt.pm * tstep : cA; const char* nB = has_next ? (const char*)g.Bt + (size_t)nxt.pn * tstep : cB;
        for (int t = 0; t < nt; t += 2) {
            const bool last = (t == nt - 2);
            const char* a1 = cA + (size_t)(t + 1) * kstep;
            const char* a2 = last ? nA : cA + (size_t)(t + 2) * kstep; const char* b2 = last ? nB : cB + (size_t)(t + 2) * kstep;
            const char* a3 = a2 + kstep; const char* b3 = b2 + kstep;
            if (last && has_next) S.a_ready(nxt);
            if constexpr (SP2) {
            PG8_LDB(B0, 0, 0); PG8_LDB(B1, 0, 1); PG8_SCHED; PG8_LDA(At, 0, 0); PG8_STAGE(PG8_SA(1, 1), a1 + hstep, voffA);
            PG8_WAIT_V(8); PG8_WAIT_L(0); PG8_BAR; PG8_MMA(0, 0, At, B0); PG8_MMA(0, 1, At, B1); PG8_BAR; PG8_SCHED;
            PG8_LDA(At, 0, 1); PG8_STAGE(PG8_SB(0, 0), b2, voffB); PG8_STAGE(PG8_SB(0, 1), b2 + hstep, voffB); PG8_STAGE(PG8_SA(0, 0), a2, voffA);
            PG8_WAIT_V(8); PG8_WAIT_L(0); PG8_BAR; PG8_MMA(1, 0, At, B0); PG8_MMA(1, 1, At, B1); PG8_BAR; PG8_SCHED;
            PG8_LDB(B0, 1, 0); PG8_LDB(B1, 1, 1); PG8_SCHED; PG8_LDA(At, 1, 0); PG8_STAGE(PG8_SA(0, 1), a2 + hstep, voffA);
            PG8_WAIT_V(8); PG8_WAIT_L(0); PG8_BAR; PG8_MMA(0, 0, At, B0); PG8_MMA(0, 1, At, B1); PG8_BAR; PG8_SCHED;
            PG8_LDA(At, 1, 1); PG8_STAGE(PG8_SB(1, 0), b3, voffB); PG8_STAGE(PG8_SB(1, 1), b3 + hstep, voffB); PG8_STAGE(PG8_SA(1, 0), a3, voffA);
            PG8_WAIT_V(8); PG8_WAIT_L(0); PG8_BAR; PG8_MMA(1, 0, At, B0); PG8_MMA(1, 1, At, B1); PG8_BAR; PG8_SCHED;
            } else {
            PG8_LDB(B0, 0, 0); PG8_SCHED; PG8_LDA(At, 0, 0); PG8_STAGE(PG8_SA(1, 1), a1 + hstep, voffA);
            PG8_WAIT_L(8); PG8_BAR; PG8_WAIT_L(0); PG8_MMA(0, 0, At, B0); PG8_BAR; PG8_SCHED;
            PG8_LDB(B1, 0, 1); PG8_STAGE(PG8_SB(0, 0), b2, voffB);
            PG8_BAR; PG8_WAIT_L(0); PG8_MMA(0, 1, At, B1); PG8_BAR;
            PG8_LDA(At, 0, 1); PG8_STAGE(PG8_SA(0, 0), a2, voffA);
            PG8_BAR; PG8_WAIT_L(0); PG8_MMA(1, 0, At, B0); PG8_BAR; PG8_SCHED;
            PG8_STAGE(PG8_SB(0, 1), b2 + hstep, voffB);
            PG8_WAIT_V(6); PG8_BAR; PG8_MMA(1, 1, At, B1); PG8_BAR;
            PG8_LDB(B0, 1, 0); PG8_SCHED; PG8_LDA(At, 1, 0); PG8_STAGE(PG8_SA(0, 1), a2 + hstep, voffA);
            PG8_WAIT_L(8); PG8_BAR; PG8_WAIT_L(0); PG8_MMA(0, 0, At, B0); PG8_BAR; PG8_SCHED;
            PG8_LDB(B1, 1, 1); PG8_STAGE(PG8_SB(1, 0), b3, voffB);
            PG8_BAR; PG8_WAIT_L(0); PG8_MMA(0, 1, At, B1); PG8_BAR;
            PG8_LDA(At, 1, 1); PG8_STAGE(PG8_SA(1, 0), a3, voffA);
            PG8_BAR; PG8_WAIT_L(0); PG8_MMA(1, 0, At, B0); PG8_BAR; PG8_SCHED;
            PG8_STAGE(PG8_SB(1, 1), b3 + hstep, voffB);
            PG8_WAIT_V(6); PG8_BAR; PG8_MMA(1, 1, At, B1); PG8_BAR;
            }
        }
        if constexpr (ALIGN_EPI) { if (wr == 0) PG8_BAR; }
        if constexpr (!Epi::AFTER_DRAIN) { E(acc, cur, wr, wc, fr, fq); S.done(cur); }
        if (!has_next) break;
#pragma unroll
        for (int a = 0; a < 2; ++a)
#pragma unroll
            for (int b = 0; b < 2; ++b)
#pragma unroll
                for (int m = 0; m < 4; ++m)
#pragma unroll
                    for (int n = 0; n < 2; ++n) acc[a][b][m][n] = (f32x4){0.f, 0.f, 0.f, 0.f};
        cur = nxt; cA = nA; cB = nB; ++ui;
        if constexpr (ALIGN_EPI) { if (wr == 1) PG8_BAR; }
    }
    PG8_WAIT_V(0);
    if constexpr (!ALIGN_EPI) { if (wr == 0) PG8_BAR; }
    PG8_BAR;
    if constexpr (Epi::AFTER_DRAIN) { E.fused(acc, cur, wr, wc, fr, fq, lds, wid, lane); S.done(cur); }
#undef PG8_SA
#undef PG8_SB
#undef PG8_STAGE
#undef PG8_LDA
#undef PG8_LDB
#undef PG8_MMA
#undef PG8_WAIT_V
#undef PG8_WAIT_L
#undef PG8_BAR
#undef PG8_SCHED
}
}

#define LAS __attribute__((address_space(3)))
typedef unsigned short bf16_t;
typedef float f32x4 __attribute__((ext_vector_type(4)));
typedef unsigned u32x4 __attribute__((ext_vector_type(4)));
typedef unsigned u32x2 __attribute__((ext_vector_type(2)));
using pg8::cvt_pk_bf16;

constexpr int DM = 1024, TP = 2048, NBP = 16, NBS = 128, TS = 8;
constexpr int MP = NBP * TP, MS = NBS * TS, M = MP + MS;
constexpr int DFF = 2816, NGU = 2 * DFF, NINP = 3072, NIN = 2824, PLE = 256;
constexpr float EPS = 1e-6f;
constexpr int PAST = 16384;

constexpr size_t O_Y = 0;
constexpr size_t O_SGP = (size_t)M * DM;
constexpr size_t O_SCP = O_SGP + (size_t)NBP * 4 * 128 * 128;
constexpr size_t O_CKP = O_SCP + (size_t)NBP * 3 * 1536;
constexpr size_t O_CVP = O_CKP + (size_t)NBP * 128 * 128;
constexpr size_t O_SGS = O_CVP + (size_t)NBP * 128 * 128;
constexpr size_t O_SCS = O_SGS + (size_t)NBS * 4 * 128 * 128;
constexpr size_t O_CKS = O_SCS + (size_t)NBS * 3 * 1536;
constexpr size_t O_CVS = O_CKS + (size_t)NBS * 128 * 128;
constexpr size_t O_END = O_CVS + (size_t)NBS * 128 * 128;

constexpr size_t MiB = 1u << 20;
constexpr size_t WS_GU1 = 0, WS_D1 = 11 * MiB, WS_IN = 17 * MiB, WS_OUT = 23 * MiB, WS_GU2 = 25 * MiB, WS_D2 = 36 * MiB, WS_PG = 42 * MiB, WS_PPW = 44 * MiB;
constexpr size_t WS_HB = 48 * MiB;
constexpr size_t WS_QS = 48 * MiB, WS_KS = 81 * MiB, WS_VS = 90 * MiB;
constexpr size_t WS_ACT = 114 * MiB;
constexpr size_t WS_PROJ = 114 * MiB;
constexpr size_t WS_GQ = 312 * MiB, WS_GK = 345 * MiB, WS_GV = 378 * MiB;
constexpr size_t WS_PP = 312 * MiB;
constexpr size_t WS_MIX = 411 * MiB;
constexpr size_t WS_PB = 477 * MiB;
constexpr size_t WS_SS = 494 * MiB;
constexpr size_t WS_AB = 495 * MiB;
constexpr size_t WS_GD = 497 * MiB;
constexpr size_t WS_BT = 498 * MiB;
constexpr size_t WS_ROPE = 499 * MiB;
constexpr size_t WS_EGL = 499 * MiB + 512 * 1024;
constexpr size_t WS_CTR = 499 * MiB + 768 * 1024;
constexpr size_t WS_BAR = 500 * MiB;
constexpr size_t WS_BAR_BYTES = 16384;
constexpr size_t WS_END = 501 * MiB;

constexpr int LDS_BYTES = 131072 + 2048 + 256;
constexpr int LDS_WQ = 133120, LDS_XB = 133120 + 64;

struct Args { const float* in[26]; float* out; unsigned char* ws; int ph_lo, ph_hi; };
typedef __attribute__((address_space(4))) const Args CArgs;
__device__ __forceinline__ CArgs* get_args() {
    unsigned long long p = (unsigned long long)__builtin_amdgcn_kernarg_segment_ptr();
    unsigned l = (unsigned)p, h = (unsigned)(p >> 32);
    asm volatile("" : "+s"(l), "+s"(h));
    l = __builtin_amdgcn_readfirstlane(l); h = __builtin_amdgcn_readfirstlane(h);
    return (CArgs*)(((unsigned long long)h << 32) | l);
}


__device__ __forceinline__ float bf2f(unsigned b) { return __uint_as_float(b << 16); }
__device__ __forceinline__ float wave_sum(float v) {
#pragma unroll
    for (int o = 1; o < 64; o <<= 1) v += __shfl_xor(v, o);
    return v;
}
__device__ __forceinline__ float wave_max(float v) {
#pragma unroll
    for (int o = 1; o < 64; o <<= 1) v = fmaxf(v, __shfl_xor(v, o));
    return v;
}
template <int CTRL> __device__ __forceinline__ float dppf(float v) { return __int_as_float(__builtin_amdgcn_update_dpp(0, __float_as_int(v), CTRL, 0xf, 0xf, true)); }
__device__ __forceinline__ float reduce16(float v) {
    v += dppf<0xB1>(v); v += dppf<0x4E>(v); v += dppf<0x141>(v); v += dppf<0x140>(v); return v;
}
__device__ __forceinline__ void unpack8(const u32x4 r, float* x) {
    x[0] = bf2f(r.x & 0xffffu); x[1] = bf2f(r.x >> 16); x[2] = bf2f(r.y & 0xffffu); x[3] = bf2f(r.y >> 16);
    x[4] = bf2f(r.z & 0xffffu); x[5] = bf2f(r.z >> 16); x[6] = bf2f(r.w & 0xffffu); x[7] = bf2f(r.w >> 16);
}
__device__ __forceinline__ u32x4 pack8(const float* x) {
    u32x4 w; w.x = cvt_pk_bf16(x[0], x[1]); w.y = cvt_pk_bf16(x[2], x[3]); w.z = cvt_pk_bf16(x[4], x[5]); w.w = cvt_pk_bf16(x[6], x[7]); return w;
}
__device__ __forceinline__ float sigmoidf_(float x) { return 1.f / (1.f + __expf(-x)); }
#define LDS_WAIT() asm volatile("s_waitcnt lgkmcnt(0)" ::: "memory")

struct EpiSwiglu {
    static constexpr bool PERM = true, AFTER_DRAIN = false;
    bf16_t* O; const float* ss;
    __device__ __forceinline__ void operator()(const f32x4 (&acc)[2][2][4][2], const pg8::Unit& u, int wr, int wc, int fr, int fq) const {
        const int col0 = u.pn * 128 + wc * 32 + 8 * fq;
#pragma unroll
        for (int ai = 0; ai < 2; ++ai)
#pragma unroll
            for (int m = 0; m < 4; ++m) {
                const int row = u.pm * 256 + ai * 128 + wr * 64 + m * 16 + fr;
                const float rs = rsqrtf(ss[row] * (1.f / DM) + EPS);
                float a[8];
#pragma unroll
                for (int n = 0; n < 2; ++n)
#pragma unroll
                    for (int j = 0; j < 4; ++j) { const float g = acc[ai][0][m][n][j] * rs, up = acc[ai][1][m][n][j] * rs; a[4 * n + j] = g * sigmoidf_(g) * up; }
                *(u32x4*)(O + (size_t)row * DFF + col0) = pack8(a);
            }
    }
};
struct EpiProj {
    static constexpr bool PERM = true, AFTER_DRAIN = false;
    bf16_t* O; const float* ss; float* AB;
    __device__ __forceinline__ void operator()(const f32x4 (&acc)[2][2][4][2], const pg8::Unit& u, int wr, int wc, int fr, int fq) const {
#pragma unroll
        for (int ai = 0; ai < 2; ++ai)
#pragma unroll
            for (int m = 0; m < 4; ++m) {
                const int row = u.pm * 256 + ai * 128 + wr * 64 + m * 16 + fr;
                const float rs = rsqrtf(ss[row] * (1.f / DM) + EPS);
#pragma unroll
                for (int bj = 0; bj < 2; ++bj) {
                    float a[8];
#pragma unroll
                    for (int n = 0; n < 2; ++n)
#pragma unroll
                        for (int j = 0; j < 4; ++j) a[4 * n + j] = acc[ai][bj][m][n][j] * rs;
                    *(u32x4*)(O + (size_t)row * NINP + u.pn * 256 + bj * 128 + wc * 32 + 8 * fq) = pack8(a);
                    if (bj == 0 && u.pn == 11 && wc == 0 && fq == 0) {
                        *(f32x4*)(AB + (size_t)row * 8) = (f32x4){a[0], a[1], a[2], a[3]};
                        *(f32x4*)(AB + (size_t)row * 8 + 4) = (f32x4){a[4], a[5], a[6], a[7]};
                    }
                }
            }
    }
};
struct EpiPlain {
    static constexpr bool PERM = true, AFTER_DRAIN = false;
    bf16_t* O;
    __device__ __forceinline__ void operator()(const f32x4 (&acc)[2][2][4][2], const pg8::Unit& u, int wr, int wc, int fr, int fq) const {
#pragma unroll
        for (int ai = 0; ai < 2; ++ai)
#pragma unroll
            for (int m = 0; m < 4; ++m) {
                const int row = u.pm * 256 + ai * 128 + wr * 64 + m * 16 + fr;
#pragma unroll
                for (int bj = 0; bj < 2; ++bj) {
                    float a[8];
#pragma unroll
                    for (int n = 0; n < 2; ++n)
#pragma unroll
                        for (int j = 0; j < 4; ++j) a[4 * n + j] = acc[ai][bj][m][n][j];
                    *(u32x4*)(O + (size_t)row * DM + u.pn * 256 + bj * 128 + wc * 32 + 8 * fq) = pack8(a);
                }
            }
    }
};
struct EpiResid {
    static constexpr bool PERM = false, AFTER_DRAIN = false;
    const float* base0; const float* base1; float* out; bf16_t* outb; float* ss; float alpha;
    __device__ __forceinline__ void operator()(const f32x4 (&acc)[2][2][4][2], const pg8::Unit& u, int wr, int wc, int fr, int fq) const {
#pragma unroll
        for (int ai = 0; ai < 2; ++ai)
#pragma unroll
            for (int m = 0; m < 4; ++m) {
                const int row = u.pm * 256 + ai * 128 + wr * 64 + m * 16 + fr;
                const float* bp = row < MP ? base0 + (size_t)row * DM : base1 + (size_t)(row - MP) * DM;
                float sq = 0.f;
#pragma unroll
                for (int bj = 0; bj < 2; ++bj)
#pragma unroll
                    for (int n = 0; n < 2; ++n) {
                        const int c = u.pn * 256 + bj * 128 + wc * 32 + n * 16 + 4 * fq;
                        const f32x4 bv = *(const f32x4*)(bp + c);
                        const f32x4 v = bv + acc[ai][bj][m][n] * alpha;
                        *(f32x4*)(out + (size_t)row * DM + c) = v;
                        u32x2 w; w.x = cvt_pk_bf16(v[0], v[1]); w.y = cvt_pk_bf16(v[2], v[3]);
                        *(u32x2*)(outb + (size_t)row * DM + c) = w;
                        sq += (v[0] * v[0] + v[1] * v[1]) + (v[2] * v[2] + v[3] * v[3]);
                    }
                sq += __shfl_xor(sq, 16); sq += __shfl_xor(sq, 32);
                if (fq == 0) unsafeAtomicAdd(ss + row, sq);
                asm volatile("" ::: "memory");
            }
    }
};
struct EpiGate {
    static constexpr bool PERM = false, AFTER_DRAIN = false;
    float* h; const bf16_t* pp; const float* ss; float* ss2;
    __device__ __forceinline__ void operator()(const f32x4 (&acc)[2][2][4][2], const pg8::Unit& u, int wr, int wc, int fr, int fq) const {
#pragma unroll
        for (int ai = 0; ai < 2; ++ai)
#pragma unroll
            for (int m = 0; m < 4; ++m) {
                const int row = u.pm * 256 + ai * 128 + wr * 64 + m * 16 + fr;
                const float rs = rsqrtf(ss[row] * (1.f / DM) + EPS);
                float sq = 0.f;
#pragma unroll
                for (int bj = 0; bj < 2; ++bj)
#pragma unroll
                    for (int n = 0; n < 2; ++n) {
                        const int c = u.pn * 256 + bj * 128 + wc * 32 + n * 16 + 4 * fq;
                        const f32x4 hv = *(const f32x4*)(h + (size_t)row * DM + c);
                        const u32x2 pw = *(const u32x2*)(pp + (size_t)row * DM + c);
                        f32x4 v;
                        v[0] = hv[0] + sigmoidf_(acc[ai][bj][m][n][0] * rs) * bf2f(pw.x & 0xffffu);
                        v[1] = hv[1] + sigmoidf_(acc[ai][bj][m][n][1] * rs) * bf2f(pw.x >> 16);
                        v[2] = hv[2] + sigmoidf_(acc[ai][bj][m][n][2] * rs) * bf2f(pw.y & 0xffffu);
                        v[3] = hv[3] + sigmoidf_(acc[ai][bj][m][n][3] * rs) * bf2f(pw.y >> 16);
                        *(f32x4*)(h + (size_t)row * DM + c) = v;
                        sq += (v[0] * v[0] + v[1] * v[1]) + (v[2] * v[2] + v[3] * v[3]);
                    }
                sq += __shfl_xor(sq, 16); sq += __shfl_xor(sq, 32);
                if (fq == 0) unsafeAtomicAdd(ss2 + row, sq);
                asm volatile("" ::: "memory");
            }
    }
};

__device__ __forceinline__ int map_row(int mode, int n) {
    if (mode == 1) { if (n < DFF) return 256 * (n >> 7) + (n & 127); n -= DFF; return 256 * (n >> 7) + 128 + (n & 127); }
    if (mode == 2) { if (n < 2048) return n; if (n < 2052) return 2816 + (n - 2048); if (n < 2056) return 2820 + (n - 2052); return n - 8; }
    return n;
}
__device__ __forceinline__ void p0_transpose_item(const float* W, int K, int N, const float* gain, bf16_t* WT, int mode, LAS float* scr, int item, int lane) {
    const int nblk = (N + 31) / 32, kb = item / nblk, nb = item % nblk, k0 = 64 * kb, n0 = 32 * nb;
#pragma unroll 8
    for (int i = 0; i < 32; ++i) {
        const int kk = 2 * i + (lane >> 5), n = n0 + (lane & 31);
        float v = 0.f;
        if (n < N) { v = W[(size_t)(k0 + kk) * N + n]; if (gain) v *= gain[k0 + kk]; }
        scr[kk * 33 + (lane & 31)] = v;
    }
    LDS_WAIT();
    const int c = lane & 7;
#pragma unroll
    for (int j = 0; j < 4; ++j) {
        const int n = (lane >> 3) + 8 * j;
        if (n0 + n < N) {
            const LAS float* s = scr + (8 * c) * 33 + n;
            u32x4 o; o.x = cvt_pk_bf16(s[0 * 33], s[1 * 33]); o.y = cvt_pk_bf16(s[2 * 33], s[3 * 33]); o.z = cvt_pk_bf16(s[4 * 33], s[5 * 33]); o.w = cvt_pk_bf16(s[6 * 33], s[7 * 33]);
            *(u32x4*)(WT + (size_t)map_row(mode, n0 + n) * K + k0 + 8 * c) = o;
        }
    }
    LDS_WAIT();
}

__device__ __forceinline__ void p0_prologue(CArgs* a, LAS unsigned char* L) {
    const int tid = threadIdx.x, lane = tid & 63, wave = tid >> 6;
    unsigned char* ws = a->ws;
    LAS float* scr = (LAS float*)(L + wave * 16384);
    const int gw = blockIdx.x * 8 + wave, NGW = gridDim.x * 8;
    constexpr int I_GU = 16 * 176, I_D = 44 * 32, I_IN = 16 * 89, I_SQ = 16 * 32, I_PP = 4 * 32;
    constexpr int NITEMS = 2 * I_GU + 2 * I_D + I_IN + 2 * I_SQ + I_PP;
    for (int it = gw; it < NITEMS; it += NGW) {
        int r = it;
        if (r < I_GU) { p0_transpose_item(a->in[9], DM, NGU, a->in[8], (bf16_t*)(ws + WS_GU1), 1, scr, r, lane); continue; } r -= I_GU;
        if (r < I_GU) { p0_transpose_item(a->in[20], DM, NGU, a->in[19], (bf16_t*)(ws + WS_GU2), 1, scr, r, lane); continue; } r -= I_GU;
        if (r < I_D) { p0_transpose_item(a->in[10], DFF, DM, nullptr, (bf16_t*)(ws + WS_D1), 0, scr, r, lane); continue; } r -= I_D;
        if (r < I_D) { p0_transpose_item(a->in[21], DFF, DM, nullptr, (bf16_t*)(ws + WS_D2), 0, scr, r, lane); continue; } r -= I_D;
        if (r < I_IN) { p0_transpose_item(a->in[12], DM, NIN, a->in[11], (bf16_t*)(ws + WS_IN), 2, scr, r, lane); continue; } r -= I_IN;
        if (r < I_SQ) { p0_transpose_item(a->in[18], DM, DM, nullptr, (bf16_t*)(ws + WS_OUT), 0, scr, r, lane); continue; } r -= I_SQ;
        if (r < I_SQ) { p0_transpose_item(a->in[24], DM, DM, a->in[22], (bf16_t*)(ws + WS_PG), 0, scr, r, lane); continue; } r -= I_SQ;
        p0_transpose_item(a->in[23], PLE, DM, nullptr, (bf16_t*)(ws + WS_PPW), 0, scr, r, lane);
    }
    {
        u32x4* z = (u32x4*)(ws + WS_IN + (size_t)NIN * DM * 2);
        const int nz = (NINP - NIN) * DM * 2 / 16;
        for (int i = blockIdx.x * 512 + tid; i < nz; i += gridDim.x * 512) z[i] = (u32x4){0u, 0u, 0u, 0u};
    }
    bf16_t* HB = (bf16_t*)(ws + WS_HB); bf16_t* PB = (bf16_t*)(ws + WS_PB); float* SS = (float*)(ws + WS_SS);
    for (int m0 = gw; m0 < M; m0 += 2 * NGW) {
        f32x4 xv[2][4], pv[2];
#pragma unroll
        for (int u = 0; u < 2; ++u) {
            const int m = m0 + u * NGW;
            if (m < M) {
                const float* xr = m < MP ? a->in[0] + (size_t)m * DM : a->in[1] + (size_t)(m - MP) * DM;
                const float* pr = m < MP ? a->in[6] + (size_t)m * PLE : a->in[7] + (size_t)(m - MP) * PLE;
#pragma unroll
                for (int j = 0; j < 4; ++j) xv[u][j] = ((const f32x4*)xr)[lane + 64 * j];
                pv[u] = ((const f32x4*)pr)[lane];
            }
        }
#pragma unroll
        for (int u = 0; u < 2; ++u) {
            const int m = m0 + u * NGW;
            if (m < M) {
                float s_ = 0.f;
#pragma unroll
                for (int j = 0; j < 4; ++j) {
                    const f32x4 v = xv[u][j];
                    s_ += (v[0] * v[0] + v[1] * v[1]) + (v[2] * v[2] + v[3] * v[3]);
                    u32x2 w; w.x = cvt_pk_bf16(v[0], v[1]); w.y = cvt_pk_bf16(v[2], v[3]);
                    ((u32x2*)(HB + (size_t)m * DM))[lane + 64 * j] = w;
                }
                s_ = wave_sum(s_);
                if (lane == 0) SS[m] = s_;
                u32x2 w; w.x = cvt_pk_bf16(pv[u][0], pv[u][1]); w.y = cvt_pk_bf16(pv[u][2], pv[u][3]);
                ((u32x2*)(PB + (size_t)m * PLE))[lane] = w;
            }
        }
    }
    for (int i = blockIdx.x * 512 + tid; i < 4 * M; i += gridDim.x * 512) SS[M + i] = 0.f;
    if (blockIdx.x == 0 && tid == 0) *(unsigned*)(ws + WS_CTR) = 0u;
    float* RT = (float*)(ws + WS_ROPE);
    for (int i = blockIdx.x * 512 + tid; i < 2056 * 8; i += gridDim.x * 512) {
        const int idx = i >> 3, f = i & 7;
        const int pos = idx < 2048 ? idx : PAST + (idx - 2048);
        const float inv = powf(500000.0f, -(float)f * 0.125f);
        const float ang = (float)pos * inv;
        const double rev = (double)ang * 0.15915494309189535;
        const float fr = (float)(rev - rint(rev));
        RT[idx * 16 + f] = __builtin_amdgcn_cosf(fr);
        RT[idx * 16 + 8 + f] = __builtin_amdgcn_sinf(fr);
    }
}

__device__ __forceinline__ void p4_mixprep(CArgs* a) {
    const int tid = threadIdx.x, lane = tid & 63, wave = tid >> 6;
    unsigned char* ws = a->ws;
    const bf16_t* PROJ = (const bf16_t*)(ws + WS_PROJ);
    bf16_t* QS = (bf16_t*)(ws + WS_QS); bf16_t* KS = (bf16_t*)(ws + WS_KS); bf16_t* VS = (bf16_t*)(ws + WS_VS);
    const float* AB = (const float*)(ws + WS_AB); float* GD = (float*)(ws + WS_GD); float* BT = (float*)(ws + WS_BT);
    const float* RT = (const float*)(ws + WS_ROPE);
    const float* state_conv = a->in[3]; const float* conv_w = a->in[13];
    const int gw = blockIdx.x * 8 + wave, NGW = gridDim.x * 8;
    for (int it = gw; it < M; it += NGW) {
        const int g = it >> 2, j = it & 3, r = 4 * g;
        const bool samp = r >= MP;
        int b, t0;
        if (!samp) { b = r >> 11; t0 = r & 2047; } else { b = (r - MP) >> 3; t0 = (r - MP) & 7; }
        const int T = samp ? TS : TP;
        const bf16_t* prow = PROJ + (size_t)r * NINP;
        if (j < 3) {
            const int ch = j * 512 + lane * 8;
            u32x4 xr[7]; f32x4 wv[4][2];
#pragma unroll
            for (int u = 0; u < 7; ++u) {
                const int tt = t0 - 3 + u;
                xr[u] = (u32x4){0u, 0u, 0u, 0u};
                if (tt >= 0) xr[u] = *(const u32x4*)(prow + (ptrdiff_t)(u - 3) * NINP + ch);
                else if (samp) {
                    const float* sc = state_conv + ((size_t)b * 3 + (3 + tt)) * 1536 + ch;
                    const f32x4 s0 = *(const f32x4*)sc, s1 = *(const f32x4*)(sc + 4);
                    xr[u].x = cvt_pk_bf16(s0[0], s0[1]); xr[u].y = cvt_pk_bf16(s0[2], s0[3]); xr[u].z = cvt_pk_bf16(s1[0], s1[1]); xr[u].w = cvt_pk_bf16(s1[2], s1[3]);
                }
            }
#pragma unroll
            for (int tap = 0; tap < 4; ++tap) { wv[tap][0] = *(const f32x4*)(conv_w + tap * 1536 + ch); wv[tap][1] = *(const f32x4*)(conv_w + tap * 1536 + ch + 4); }
            float acc[4][8];
#pragma unroll
            for (int i = 0; i < 4; ++i)
#pragma unroll
                for (int e = 0; e < 8; ++e) acc[i][e] = 0.f;
#pragma unroll
            for (int u = 0; u < 7; ++u) {
                float x[8]; unpack8(xr[u], x);
#pragma unroll
                for (int i = 0; i < 4; ++i) {
                    const int tap = u - i;
                    if (tap >= 0 && tap < 4) {
#pragma unroll
                        for (int e = 0; e < 4; ++e) { acc[i][e] += x[e] * wv[tap][0][e]; acc[i][4 + e] += x[4 + e] * wv[tap][1][e]; }
                    }
                }
            }
            bf16_t* dstb = (bf16_t*)(ws + (j == 0 ? WS_GQ : (j == 1 ? WS_GK : WS_GV)));
#pragma unroll
            for (int i = 0; i < 4; ++i) {
                float ssq = 0.f;
#pragma unroll
                for (int e = 0; e < 8; ++e) { acc[i][e] = acc[i][e] * sigmoidf_(acc[i][e]); ssq += acc[i][e] * acc[i][e]; }
                if (j < 2) {
                    ssq = reduce16(ssq);
                    const float sc = rsqrtf(ssq + 1e-6f) * (j == 0 ? 0.08838834764831845f : 1.0f);
#pragma unroll
                    for (int e = 0; e < 8; ++e) acc[i][e] *= sc;
                }
                *(u32x4*)(dstb + (size_t)(r + i) * 512 + lane * 8) = pack8(acc[i]);
                const int t = t0 + i;
                if (t >= T - 3) {
                    float x[8]; unpack8(xr[i + 3], x);
                    float* so = a->out + (samp ? O_SCS : O_SCP) + ((size_t)b * 3 + (t - (T - 3))) * 1536 + ch;
                    *(f32x4*)so = (f32x4){x[0], x[1], x[2], x[3]};
                    *(f32x4*)(so + 4) = (f32x4){x[4], x[5], x[6], x[7]};
                }
            }
        } else {
            const int tk = lane >> 4, kl = lane & 15;
            u32x4 qx[4];
#pragma unroll
            for (int i = 0; i < 4; ++i) qx[i] = *(const u32x4*)(prow + (size_t)i * NINP + 2048 + lane * 8);
            const u32x4 kraw = *(const u32x4*)(prow + (size_t)tk * NINP + 2560 + kl * 8);
            const u32x4 vraw = *(const u32x4*)(prow + (size_t)tk * NINP + 2688 + kl * 8);
            const int ridx0 = samp ? 2048 + t0 : t0;
            if (lane < 16) {
                const int i = lane >> 2, hh = lane & 3;
                const float av = AB[(size_t)(r + i) * 8 + hh], bv = AB[(size_t)(r + i) * 8 + 4 + hh];
                const float sp = av + a->in[15][hh];
                const float softplus = sp > 20.f ? sp : log1pf(expf(sp));
                GD[(size_t)(r + i) * 4 + hh] = -expf(a->in[14][hh]) * softplus;
                BT[(size_t)(r + i) * 4 + hh] = 1.f / (1.f + expf(-bv));
            }
            const int l8 = lane & 7;
            const float sgn = l8 == 0 ? -1.f : 1.f;
#pragma unroll
            for (int i = 0; i < 4; ++i) {
                const float* rt = RT + (size_t)(ridx0 + i) * 16;
                const f32x4 c0 = *(const f32x4*)rt, c1 = *(const f32x4*)(rt + 4), s0 = *(const f32x4*)(rt + 8), s1 = *(const f32x4*)(rt + 12);
                float x[8], o[8]; unpack8(qx[i], x);
#pragma unroll
                for (int e = 0; e < 8; ++e) o[e] = __shfl_xor(x[e], 1);
                if (l8 < 2) {
#pragma unroll
                    for (int e = 0; e < 4; ++e) { x[e] = x[e] * c0[e] + sgn * o[e] * s0[e]; x[4 + e] = x[4 + e] * c1[e] + sgn * o[4 + e] * s1[e]; }
                }
#pragma unroll
                for (int e = 0; e < 8; ++e) x[e] *= 0.125f;
                *(u32x4*)(QS + (size_t)(r + i) * 512 + lane * 8) = pack8(x);
            }
            {
                const float* rt = RT + (size_t)(ridx0 + tk) * 16;
                const f32x4 c0 = *(const f32x4*)rt, c1 = *(const f32x4*)(rt + 4), s0 = *(const f32x4*)(rt + 8), s1 = *(const f32x4*)(rt + 12);
                float x[8], o[8]; unpack8(kraw, x);
#pragma unroll
                for (int e = 0; e < 8; ++e) o[e] = __shfl_xor(x[e], 1);
                if ((kl & 7) < 2) {
                    const float sg = (kl & 7) == 0 ? -1.f : 1.f;
#pragma unroll
                    for (int e = 0; e < 4; ++e) { x[e] = x[e] * c0[e] + sg * o[e] * s0[e]; x[4 + e] = x[4 + e] * c1[e] + sg * o[4 + e] * s1[e]; }
                }
                *(u32x4*)(KS + (size_t)(r + tk) * 128 + kl * 8) = pack8(x);
                *(u32x4*)(VS + (size_t)(r + tk) * 128 + kl * 8) = vraw;
                const int t = t0 + tk;
                const int crow = samp ? 120 + t : t - (TP - 128);
                if (crow >= 0) {
                    float v[8]; unpack8(vraw, v);
                    float* ck = a->out + (samp ? O_CKS : O_CKP) + ((size_t)b * 128 + crow) * 128 + kl * 8;
                    float* cv = a->out + (samp ? O_CVS : O_CVP) + ((size_t)b * 128 + crow) * 128 + kl * 8;
                    *(f32x4*)ck = (f32x4){x[0], x[1], x[2], x[3]}; *(f32x4*)(ck + 4) = (f32x4){x[4], x[5], x[6], x[7]};
                    *(f32x4*)cv = (f32x4){v[0], v[1], v[2], v[3]}; *(f32x4*)(cv + 4) = (f32x4){v[4], v[5], v[6], v[7]};
                }
            }
            if (samp) {
                for (int e = lane; e < 60 * 32; e += 64) {
                    const int jrow = t0 * 15 + (e >> 5), c4 = (e & 31) * 4;
                    const size_t d = ((size_t)b * 128 + jrow) * 128 + c4, sidx = ((size_t)b * 128 + jrow + 8) * 128 + c4;
                    *(f32x4*)(a->out + O_CKS + d) = *(const f32x4*)(a->in[4] + sidx);
                    *(f32x4*)(a->out + O_CVS + d) = *(const f32x4*)(a->in[5] + sidx);
                }
            }
        }
    }
}

__device__ __forceinline__ void gdn_item(CArgs* a, LAS unsigned char* L, int item, bool samp) {
    const int tid = threadIdx.x;
    unsigned char* ws = a->ws;
    const bf16_t* GQ = (const bf16_t*)(ws + WS_GQ); const bf16_t* GK = (const bf16_t*)(ws + WS_GK); const bf16_t* GV = (const bf16_t*)(ws + WS_GV);
    const float* GD = (const float*)(ws + WS_GD); const float* BT = (const float*)(ws + WS_BT);
    unsigned char* PROJb = ws + WS_PROJ;
    const int b = item >> 4, h = (item >> 2) & 3, qd = item & 3;
    const int row0 = samp ? MP + b * TS : b * TP, T = samp ? TS : TP;
    const float* S0 = samp ? a->in[2] + (size_t)(b * 4 + h) * 16384 : nullptr;
    float* Sout = a->out + (samp ? O_SGS : O_SGP) + (size_t)(b * 4 + h) * 16384;
    const int cl = tid >> 4, part = tid & 15;
    LAS float* kb = (LAS float*)L;
    LAS float* qb = kb + 32 * 128;
    LAS float* vb = qb + 32 * 128;
    LAS float* ob = vb + 32 * 32;
    LAS float* eg = ob + 32 * 32;
    LAS float* bt = eg + 32;
    LAS float* sb = bt + 32;
    __syncthreads();
    float S[8];
    if (S0) {
        const int dk = tid >> 2, c8 = (tid & 3) * 8;
        const f32x4 s0 = *(const f32x4*)(S0 + (size_t)dk * 128 + qd * 32 + c8), s1 = *(const f32x4*)(S0 + (size_t)dk * 128 + qd * 32 + c8 + 4);
#pragma unroll
        for (int i = 0; i < 4; ++i) { sb[dk * 33 + c8 + i] = s0[i]; sb[dk * 33 + c8 + 4 + i] = s1[i]; }
        __syncthreads();
#pragma unroll
        for (int i = 0; i < 8; ++i) S[i] = sb[(part * 8 + i) * 33 + cl];
    } else {
#pragma unroll
        for (int i = 0; i < 8; ++i) S[i] = 0.f;
    }
    const int TB = T < 32 ? T : 32;
    const int ptok = tid >> 4, pch = (tid & 15) * 8;
    const int vtok = tid >> 2, vch = (tid & 3) * 8;
    const bool pk_ok = ptok < TB, pv_ok = vtok < TB && tid < 128, pe_ok = tid < TB;
    u32x4 rk = {0u, 0u, 0u, 0u}, rq = {0u, 0u, 0u, 0u}, rv = {0u, 0u, 0u, 0u}; float re = 0.f, rb = 0.f;
#define GDN_PREFETCH(t0) do { \
        if (pk_ok) { const size_t o_ = (size_t)(row0 + (t0) + ptok) * 512 + h * 128 + pch; rk = *(const u32x4*)(GK + o_); rq = *(const u32x4*)(GQ + o_); } \
        if (pv_ok) { rv = *(const u32x4*)(GV + (size_t)(row0 + (t0) + vtok) * 512 + h * 128 + qd * 32 + vch); } \
        if (pe_ok) { re = GD[(size_t)(row0 + (t0) + tid) * 4 + h]; rb = BT[(size_t)(row0 + (t0) + tid) * 4 + h]; } } while (0)
    GDN_PREFETCH(0);
    for (int t0 = 0; t0 < T; t0 += TB) {
        if (pk_ok) {
            float x[8];
            unpack8(rk, x); *(LAS f32x4*)(kb + ptok * 128 + pch) = (f32x4){x[0], x[1], x[2], x[3]}; *(LAS f32x4*)(kb + ptok * 128 + pch + 4) = (f32x4){x[4], x[5], x[6], x[7]};
            unpack8(rq, x); *(LAS f32x4*)(qb + ptok * 128 + pch) = (f32x4){x[0], x[1], x[2], x[3]}; *(LAS f32x4*)(qb + ptok * 128 + pch + 4) = (f32x4){x[4], x[5], x[6], x[7]};
        }
        if (pv_ok) { float x[8]; unpack8(rv, x); *(LAS f32x4*)(vb + vtok * 32 + vch) = (f32x4){x[0], x[1], x[2], x[3]}; *(LAS f32x4*)(vb + vtok * 32 + vch + 4) = (f32x4){x[4], x[5], x[6], x[7]}; }
        if (pe_ok) { eg[tid] = __expf(re); bt[tid] = rb; }
        __syncthreads();
        if (t0 + TB < T) GDN_PREFETCH(t0 + TB);
        for (int tok = 0; tok < TB; ++tok) {
            const f32x4 k0 = *(const LAS f32x4*)(kb + tok * 128 + part * 8), k1 = *(const LAS f32x4*)(kb + tok * 128 + part * 8 + 4);
            const f32x4 q0 = *(const LAS f32x4*)(qb + tok * 128 + part * 8), q1 = *(const LAS f32x4*)(qb + tok * 128 + part * 8 + 4);
            const float v = vb[tok * 32 + cl], e = eg[tok], be = bt[tok];
            float ks = ((k0[0] * S[0] + k0[1] * S[1]) + (k0[2] * S[2] + k0[3] * S[3])) + ((k1[0] * S[4] + k1[1] * S[5]) + (k1[2] * S[6] + k1[3] * S[7]));
            ks = reduce16(ks);
            const float vn = be * (v - e * ks);
            S[0] = e * S[0] + k0[0] * vn; S[1] = e * S[1] + k0[1] * vn; S[2] = e * S[2] + k0[2] * vn; S[3] = e * S[3] + k0[3] * vn;
            S[4] = e * S[4] + k1[0] * vn; S[5] = e * S[5] + k1[1] * vn; S[6] = e * S[6] + k1[2] * vn; S[7] = e * S[7] + k1[3] * vn;
            float o = ((q0[0] * S[0] + q0[1] * S[1]) + (q0[2] * S[2] + q0[3] * S[3])) + ((q1[0] * S[4] + q1[1] * S[5]) + (q1[2] * S[6] + q1[3] * S[7]));
            o = reduce16(o);
            if (part == 0) ob[tok * 32 + cl] = o;
        }
        __syncthreads();
        if (tid < 256) {
            const int tok = tid >> 3, c4 = (tid & 7) * 4;
            if (tok < TB) {
                float* og = (float*)(PROJb + (size_t)(row0 + t0 + tok) * (NINP * 2));
                *(f32x4*)(og + h * 128 + qd * 32 + c4) = *(const LAS f32x4*)(ob + tok * 32 + c4);
            }
        }
    }
#undef GDN_PREFETCH
    __syncthreads();
#pragma unroll
    for (int i = 0; i < 8; ++i) sb[(part * 8 + i) * 33 + cl] = S[i];
    __syncthreads();
    {
        const int dk = tid >> 2, c8 = (tid & 3) * 8;
        f32x4 s0, s1;
#pragma unroll
        for (int i = 0; i < 4; ++i) { s0[i] = sb[dk * 33 + c8 + i]; s1[i] = sb[dk * 33 + c8 + 4 + i]; }
        *(f32x4*)(Sout + (size_t)dk * 128 + qd * 32 + c8) = s0; *(f32x4*)(Sout + (size_t)dk * 128 + qd * 32 + c8 + 4) = s1;
    }
}

typedef short bf16x8 __attribute__((ext_vector_type(8)));
#define MFMA16(a_, b_, c_) __builtin_amdgcn_mfma_f32_16x16x32_bf16(a_, b_, c_, 0, 0, 0)
__device__ __forceinline__ void gdn_chunk_prep(CArgs* a, LAS unsigned char* L, int pair) {
    const int tid = threadIdx.x, hb = tid >> 8, t2 = tid & 255, w = t2 >> 6, lane = tid & 63, fr = lane & 15, fq = lane >> 4;
    unsigned char* ws = a->ws;
    bf16_t* GQ = (bf16_t*)(ws + WS_GQ); bf16_t* GK = (bf16_t*)(ws + WS_GK); const bf16_t* GV = (const bf16_t*)(ws + WS_GV);
    const float* GD = (const float*)(ws + WS_GD); const float* BT = (const float*)(ws + WS_BT);
    unsigned char* PROJb = ws + WS_PROJ; float* EGL = (float*)(ws + WS_EGL);
    const int ci = pair * 2 + hb;
    const int b = ci >> 7, h = (ci >> 5) & 3, c = ci & 31;
    const int r0 = b * TP + c * 64;
    LAS unsigned char* Lh = L + hb * 66560;
    LAS float* gcs = (LAS float*)Lh;
    LAS float* bts = gcs + 64;
    LAS float* egc = bts + 64;
    LAS float* ekd = egc + 64;
    LAS float* Af = ekd + 64;
    LAS unsigned char* STG = Lh + 1024 + 16384;
    __syncthreads();
    if (w == 0) {
        float v = GD[(size_t)(r0 + lane) * 4 + h];
#pragma unroll
        for (int o = 1; o < 64; o <<= 1) { const float t = __shfl_up(v, o); if (lane >= o) v += t; }
        const float gl = __shfl(v, 63);
        gcs[lane] = v; bts[lane] = BT[(size_t)(r0 + lane) * 4 + h]; egc[lane] = __expf(v); ekd[lane] = __expf(gl - v);
    }
#pragma unroll 2
    for (int jj = 0; jj < 8; ++jj) {
        const int e = t2 + 256 * jj, row = e >> 5, ch = e & 31;
        const bf16_t* src = (ch < 16 ? GV : (const bf16_t*)GK) + (size_t)(r0 + row) * 512 + h * 128 + (ch & 15) * 8;
        *(LAS u32x4*)(STG + row * 512 + ch * 16) = *(const u32x4*)src;
    }
    __syncthreads();
    bf16x8 aK[4], aQ[4];
    {
        const size_t o_ = (size_t)(r0 + 16 * w + fr) * 512 + h * 128 + fq * 8;
#pragma unroll
        for (int ks = 0; ks < 4; ++ks) { aK[ks] = *(const bf16x8*)(GK + o_ + ks * 32); aQ[ks] = *(const bf16x8*)(GQ + o_ + ks * 32); }
    }
    f32x4 qkd[4];
#pragma unroll
    for (int n = 0; n < 4; ++n) {
        bf16x8 bK[4];
        const size_t o_ = (size_t)(r0 + 16 * n + fr) * 512 + h * 128 + fq * 8;
#pragma unroll
        for (int ks = 0; ks < 4; ++ks) bK[ks] = *(const bf16x8*)(GK + o_ + ks * 32);
        f32x4 kk = {0.f, 0.f, 0.f, 0.f}, qk = {0.f, 0.f, 0.f, 0.f};
#pragma unroll
        for (int ks = 0; ks < 4; ++ks) { kk = MFMA16(aK[ks], bK[ks], kk); qk = MFMA16(aQ[ks], bK[ks], qk); }
        const int j = 16 * n + fr; const float gj = gcs[j];
#pragma unroll
        for (int r = 0; r < 4; ++r) {
            const int i = 16 * w + 4 * fq + r;
            const float d = (i >= j) ? __expf(gcs[i] - gj) : 0.f;
            Af[i * 64 + j] = (i > j) ? bts[i] * kk[r] * d : 0.f;
            qkd[n][r] = qk[r] * d;
        }
    }
#pragma unroll
    for (int jj = 0; jj < 4; ++jj) {
        const int e = t2 + 256 * jj, tok = e >> 4, ch = (e & 15) * 8;
        float x[8]; unpack8(*(const u32x4*)(GQ + (size_t)(r0 + tok) * 512 + h * 128 + ch), x);
        const float sc = egc[tok];
#pragma unroll
        for (int i = 0; i < 8; ++i) x[i] *= sc;
        *(u32x4*)((bf16_t*)(PROJb + (size_t)(r0 + tok) * (NINP * 2)) + 2048 + h * 128 + ch) = pack8(x);
    }
    const bool isU = t2 < 128; const int col = t2 & 127;
    float cv[64], x[64];
#pragma unroll
    for (int i = 0; i < 64; ++i) cv[i] = bf2f(*(const LAS bf16_t*)(STG + i * 512 + t2 * 2));
    asm volatile("s_waitcnt vmcnt(0)" ::: "memory");
    __syncthreads();
#pragma unroll
    for (int n = 0; n < 4; ++n)
#pragma unroll
        for (int r = 0; r < 4; ++r) {
            const int i = 16 * w + 4 * fq + r, j = 16 * n + fr;
            GQ[(size_t)(r0 + (i >> 1)) * 512 + h * 128 + (i & 1) * 64 + j] = (bf16_t)(cvt_pk_bf16(qkd[n][r], 0.f) & 0xffffu);
        }
    if (!isU) {
        bf16_t* dst = GK + (size_t)(r0 + (col >> 1)) * 512 + h * 128 + (col & 1) * 64;
#pragma unroll
        for (int jj = 0; jj < 8; ++jj) {
            float y[8];
#pragma unroll
            for (int i = 0; i < 8; ++i) y[i] = cv[8 * jj + i] * ekd[8 * jj + i];
            *(u32x4*)(dst + 8 * jj) = pack8(y);
        }
    }
    {
        const float um = isU ? 1.f : 0.f, km = 1.f - um;
#pragma unroll
        for (int i = 0; i < 64; ++i) x[i] = bts[i] * cv[i] * (um + km * egc[i]);
    }
    asm volatile("" ::: "memory");
#pragma unroll
    for (int i = 1; i < 64; ++i) {
        float s = x[i];
#pragma unroll
        for (int j = 0; j < i; ++j) s -= Af[i * 64 + j] * x[j];
        x[i] = s;
        asm volatile("" ::: "memory");
    }
    if (isU) {
#pragma unroll
        for (int i = 0; i < 64; ++i) *(LAS float*)(STG + (i * 128 + col) * 4) = x[i];
    } else {
#pragma unroll
        for (int i = 0; i < 64; ++i) *(LAS bf16_t*)(STG + 32768 + (i * 128 + col) * 2) = (bf16_t)(cvt_pk_bf16(x[i], 0.f) & 0xffffu);
    }
    __syncthreads();
#pragma unroll 1
    for (int jj = 0; jj < 8; ++jj) {
        const int e = t2 + 256 * jj, row = e >> 5, ch = e & 31;
        *(f32x4*)((float*)(PROJb + (size_t)(r0 + row) * (NINP * 2)) + h * 128 + ch * 4) = *(const LAS f32x4*)(STG + (row * 128 + ch * 4) * 4);
    }
#pragma unroll 1
    for (int jj = 0; jj < 4; ++jj) {
        const int e = t2 + 256 * jj, row = e >> 4, ch = e & 15;
        *(u32x4*)((bf16_t*)(PROJb + (size_t)(r0 + row) * (NINP * 2)) + 1024 + h * 128 + ch * 8) = *(const LAS u32x4*)(STG + 32768 + (row * 128 + ch * 8) * 2);
    }
    if (t2 == 0) EGL[ci] = egc[63];
}

__device__ __forceinline__ void gdn_chunk_scan(CArgs* a, LAS unsigned char* L, int item) {
    const int tid = threadIdx.x, w = __builtin_amdgcn_readfirstlane(tid >> 6), lane = tid & 63, fr = lane & 15, fq = lane >> 4;
    unsigned char* ws = a->ws;
    const bf16_t* GQ = (const bf16_t*)(ws + WS_GQ); const bf16_t* GK = (const bf16_t*)(ws + WS_GK);
    const unsigned char* PROJb = ws + WS_PROJ; const float* EGL = (const float*)(ws + WS_EGL); bf16_t* MIX = (bf16_t*)(ws + WS_MIX);
    const int b = item >> 2, h = item & 3;
    LAS unsigned char* St = L;
    LAS unsigned char* Vn = L + 34816;
    LAS float* ssp = (LAS float*)(L + 53248);
    LAS unsigned char* Wl = L + 57344;
    LAS unsigned char* Ql = Wl + 17408;
    LAS unsigned char* Kl = Ql + 17408;
    LAS unsigned char* Xl = Kl + 18432;
    f32x4 Sacc[8];
#pragma unroll
    for (int n = 0; n < 8; ++n) Sacc[n] = (f32x4){0.f, 0.f, 0.f, 0.f};
    const f32x4 gnv = *(const f32x4*)(a->in[16] + 16 * w + 4 * fq);
    u32x4 pfW[2], pfQ[2], pfK[2], pfX; f32x4 pfU[4]; u32x2 pfZ[4]; float pfE;
    const int s_row = tid >> 4, s_ch = tid & 15;
    const int k_dk = tid >> 3, k_ch = tid & 7;
#define SCAN_PREFETCH(cc) do { const int r0_ = b * TP + (cc) * 64; \
        _Pragma("unroll") for (int jj = 0; jj < 2; ++jj) { \
            const unsigned char* pr_ = PROJb + (size_t)(r0_ + s_row + 32 * jj) * (NINP * 2); \
            pfW[jj] = *(const u32x4*)((const bf16_t*)pr_ + 1024 + h * 128 + s_ch * 8); \
            pfQ[jj] = *(const u32x4*)((const bf16_t*)pr_ + 2048 + h * 128 + s_ch * 8); \
            const int dk_ = k_dk + 64 * jj; \
            pfK[jj] = *(const u32x4*)(GK + (size_t)(r0_ + (dk_ >> 1)) * 512 + h * 128 + (dk_ & 1) * 64 + k_ch * 8); } \
        pfX = *(const u32x4*)(GQ + (size_t)(r0_ + (k_dk >> 1)) * 512 + h * 128 + (k_dk & 1) * 64 + k_ch * 8); \
        _Pragma("unroll") for (int n = 0; n < 4; ++n) { \
            const unsigned char* pr_ = PROJb + (size_t)(r0_ + 16 * n + fr) * (NINP * 2); \
            pfU[n] = *(const f32x4*)((const float*)pr_ + h * 128 + 16 * w + 4 * fq); \
            pfZ[n] = *(const u32x2*)((const bf16_t*)pr_ + 1536 + h * 128 + 16 * w + 4 * fq); } \
        pfE = EGL[(b * 4 + h) * 32 + (cc)]; } while (0)
#define SCAN_STAGE() do { \
        _Pragma("unroll") for (int jj = 0; jj < 2; ++jj) { \
            *(LAS u32x4*)(Wl + (s_row + 32 * jj) * 272 + s_ch * 16) = pfW[jj]; \
            *(LAS u32x4*)(Ql + (s_row + 32 * jj) * 272 + s_ch * 16) = pfQ[jj]; \
            *(LAS u32x4*)(Kl + (k_dk + 64 * jj) * 144 + k_ch * 16) = pfK[jj]; } \
        *(LAS u32x4*)(Xl + k_dk * 144 + k_ch * 16) = pfX; } while (0)
    __syncthreads();
    SCAN_PREFETCH(0);
    SCAN_STAGE();
    for (int c = 0; c < 32; ++c) {
        const int r0 = b * TP + c * 64;
        f32x4 cu[4]; u32x2 cz[4];
#pragma unroll
        for (int n = 0; n < 4; ++n) { cu[n] = pfU[n]; cz[n] = pfZ[n]; }
        const float eg = pfE;
        __syncthreads();
        if (c + 1 < 32) SCAN_PREFETCH(c + 1);
#pragma unroll
        for (int n8 = 0; n8 < 8; ++n8)
#pragma unroll
            for (int r = 0; r < 4; ++r) *(LAS bf16_t*)(St + (16 * w + 4 * fq + r) * 272 + (16 * n8 + fr) * 2) = (bf16_t)(cvt_pk_bf16(Sacc[n8][r], 0.f) & 0xffffu);
        LDS_WAIT();
        bf16x8 sA[4];
#pragma unroll
        for (int ks = 0; ks < 4; ++ks) sA[ks] = *(const LAS bf16x8*)(St + (16 * w + fr) * 272 + (ks * 32 + fq * 8) * 2);
        f32x4 vn[4], oa[4];
#pragma unroll
        for (int n = 0; n < 4; ++n) {
            f32x4 acc = {0.f, 0.f, 0.f, 0.f}, o = {0.f, 0.f, 0.f, 0.f};
#pragma unroll
            for (int ks = 0; ks < 4; ++ks) {
                acc = MFMA16(sA[ks], *(const LAS bf16x8*)(Wl + (16 * n + fr) * 272 + (ks * 32 + fq * 8) * 2), acc);
                o = MFMA16(sA[ks], *(const LAS bf16x8*)(Ql + (16 * n + fr) * 272 + (ks * 32 + fq * 8) * 2), o);
            }
            vn[n] = cu[n] - acc; oa[n] = o;
        }
#pragma unroll
        for (int n = 0; n < 4; ++n)
#pragma unroll
            for (int r = 0; r < 4; ++r) *(LAS bf16_t*)(Vn + (16 * w + 4 * fq + r) * 144 + (16 * n + fr) * 2) = (bf16_t)(cvt_pk_bf16(vn[n][r], 0.f) & 0xffffu);
        LDS_WAIT();
        bf16x8 vA[2];
#pragma unroll
        for (int k2 = 0; k2 < 2; ++k2) vA[k2] = *(const LAS bf16x8*)(Vn + (16 * w + fr) * 144 + (k2 * 32 + fq * 8) * 2);
#pragma unroll
        for (int n = 0; n < 4; ++n)
#pragma unroll
            for (int k2 = 0; k2 < 2; ++k2) oa[n] = MFMA16(vA[k2], *(const LAS bf16x8*)(Xl + (16 * n + fr) * 144 + (k2 * 32 + fq * 8) * 2), oa[n]);
#pragma unroll
        for (int n8 = 0; n8 < 8; ++n8) {
            f32x4 sv = Sacc[n8] * eg;
#pragma unroll
            for (int k2 = 0; k2 < 2; ++k2) sv = MFMA16(vA[k2], *(const LAS bf16x8*)(Kl + (16 * n8 + fr) * 144 + (k2 * 32 + fq * 8) * 2), sv);
            Sacc[n8] = sv;
        }
        LAS float* sp = ssp + (c & 1) * 512;
#pragma unroll
        for (int n = 0; n < 4; ++n) {
            float q = (oa[n][0] * oa[n][0] + oa[n][1] * oa[n][1]) + (oa[n][2] * oa[n][2] + oa[n][3] * oa[n][3]);
            q += __shfl_xor(q, 16); q += __shfl_xor(q, 32);
            if (fq == 0) sp[w * 64 + 16 * n + fr] = q;
        }
        __syncthreads();
        if (c + 1 < 32) SCAN_STAGE();
#pragma unroll
        for (int n = 0; n < 4; ++n) {
            const int tok = 16 * n + fr;
            float tot = 0.f;
#pragma unroll
            for (int ww = 0; ww < 8; ++ww) tot += sp[ww * 64 + tok];
            const float rs = rsqrtf(tot * (1.f / 128.f) + EPS);
            const u32x2 zr = cz[n];
            const float z0 = bf2f(zr.x & 0xffffu), z1 = bf2f(zr.x >> 16), z2 = bf2f(zr.y & 0xffffu), z3 = bf2f(zr.y >> 16);
            u32x2 ow;
            ow.x = cvt_pk_bf16(oa[n][0] * rs * gnv[0] * (z0 * sigmoidf_(z0)), oa[n][1] * rs * gnv[1] * (z1 * sigmoidf_(z1)));
            ow.y = cvt_pk_bf16(oa[n][2] * rs * gnv[2] * (z2 * sigmoidf_(z2)), oa[n][3] * rs * gnv[3] * (z3 * sigmoidf_(z3)));
            *(u32x2*)(MIX + (size_t)(r0 + tok) * 1024 + h * 128 + 16 * w + 4 * fq) = ow;
        }
    }
#undef SCAN_PREFETCH
#undef SCAN_STAGE
    float* Sout = a->out + O_SGP + (size_t)(b * 4 + h) * 16384;
#pragma unroll
    for (int n8 = 0; n8 < 8; ++n8) *(f32x4*)(Sout + (size_t)(16 * n8 + fr) * 128 + 16 * w + 4 * fq) = Sacc[n8];
}

__device__ __forceinline__ void swa_item(CArgs* a, LAS unsigned char* L, int it) {
    const int tid = threadIdx.x, lane = tid & 63, wave = tid >> 6;
    unsigned char* ws = a->ws;
    const bf16_t* QS = (const bf16_t*)(ws + WS_QS); const bf16_t* KS = (const bf16_t*)(ws + WS_KS); const bf16_t* VS = (const bf16_t*)(ws + WS_VS);
    bf16_t* MIX = (bf16_t*)(ws + WS_MIX);
    const bool samp = it >= 2048;
    int b, kvh, tq0, nq, row0;
    if (!samp) { b = it >> 7; const int rem = it & 127; kvh = rem & 1; tq0 = (rem >> 1) * 32; nq = 32; row0 = b * TP; }
    else { const int i2 = it - 2048; b = i2 >> 1; kvh = i2 & 1; tq0 = 0; nq = TS; row0 = MP + b * TS; }
    const int nrows = 127 + nq;
    LAS float* Kf = (LAS float*)L;
    LAS float* Vf = Kf + 159 * 68;
    LAS float* Qw = Vf + 159 * 68;
    LAS float* Pw = Qw + 8 * 256;
    __syncthreads();
    for (int e = tid; e < nrows * 8; e += 512) {
        const int j = e >> 3, d8 = (e & 7) * 8, p = tq0 - 127 + j;
        float kx[8], vx[8];
        if (p >= 0) {
            const size_t o_ = (size_t)(row0 + p) * 128 + kvh * 64 + d8;
            unpack8(*(const u32x4*)(KS + o_), kx); unpack8(*(const u32x4*)(VS + o_), vx);
        } else if (samp) {
            const size_t o_ = ((size_t)b * 128 + (128 + p)) * 128 + kvh * 64 + d8;
            const f32x4 k0 = *(const f32x4*)(a->in[4] + o_), k1 = *(const f32x4*)(a->in[4] + o_ + 4), v0 = *(const f32x4*)(a->in[5] + o_), v1 = *(const f32x4*)(a->in[5] + o_ + 4);
#pragma unroll
            for (int i = 0; i < 4; ++i) { kx[i] = k0[i]; kx[4 + i] = k1[i]; vx[i] = v0[i]; vx[4 + i] = v1[i]; }
        } else {
#pragma unroll
            for (int i = 0; i < 8; ++i) { kx[i] = 0.f; vx[i] = 0.f; }
        }
        *(LAS f32x4*)(Kf + j * 68 + d8) = (f32x4){kx[0], kx[1], kx[2], kx[3]}; *(LAS f32x4*)(Kf + j * 68 + d8 + 4) = (f32x4){kx[4], kx[5], kx[6], kx[7]};
        *(LAS f32x4*)(Vf + j * 68 + d8) = (f32x4){vx[0], vx[1], vx[2], vx[3]}; *(LAS f32x4*)(Vf + j * 68 + d8 + 4) = (f32x4){vx[4], vx[5], vx[6], vx[7]};
    }
    __syncthreads();
    LAS float* Qm = Qw + wave * 256;
    LAS float* Pm = Pw + wave * 512;
    for (int i = wave; i < nq; i += 8) {
        const int row = row0 + tq0 + i;
        {
            const u32x2 rq = *(const u32x2*)(QS + (size_t)row * 512 + kvh * 256 + lane * 4);
            *(LAS f32x4*)(Qm + lane * 4) = (f32x4){bf2f(rq.x & 0xffffu), bf2f(rq.x >> 16), bf2f(rq.y & 0xffffu), bf2f(rq.y >> 16)};
        }
        LDS_WAIT();
        float s[2][4];
#pragma unroll
        for (int kk = 0; kk < 2; ++kk) {
            const int j = i + lane + 64 * kk;
            const LAS float* kr = Kf + j * 68;
            float ac[4] = {0.f, 0.f, 0.f, 0.f};
#pragma unroll 4
            for (int d4 = 0; d4 < 16; ++d4) {
                const f32x4 kv = *(const LAS f32x4*)(kr + d4 * 4);
#pragma unroll
                for (int hh = 0; hh < 4; ++hh) {
                    const f32x4 qv = *(const LAS f32x4*)(Qm + hh * 64 + d4 * 4);
                    ac[hh] += (kv[0] * qv[0] + kv[1] * qv[1]) + (kv[2] * qv[2] + kv[3] * qv[3]);
                }
            }
            const bool valid = samp || (tq0 - 127 + j >= 0);
#pragma unroll
            for (int hh = 0; hh < 4; ++hh) s[kk][hh] = valid ? ac[hh] : -INFINITY;
        }
        f32x4 p0, p1;
#pragma unroll
        for (int hh = 0; hh < 4; ++hh) {
            const float sk = a->in[17][kvh * 4 + hh];
            float mx = wave_max(fmaxf(s[0][hh], s[1][hh]));
            mx = fmaxf(mx, sk);
            const float e0 = __expf(s[0][hh] - mx), e1 = __expf(s[1][hh] - mx);
            const float den = wave_sum(e0 + e1) + __expf(sk - mx);
            const float inv = 1.f / den;
            p0[hh] = e0 * inv; p1[hh] = e1 * inv;
        }
        *(LAS f32x4*)(Pm + lane * 4) = p0; *(LAS f32x4*)(Pm + (lane + 64) * 4) = p1;
        LDS_WAIT();
        float o[4] = {0.f, 0.f, 0.f, 0.f};
#pragma unroll 8
        for (int jj = 0; jj < 128; ++jj) {
            const f32x4 pj = *(const LAS f32x4*)(Pm + jj * 4);
            const float v = Vf[(i + jj) * 68 + lane];
            o[0] += pj[0] * v; o[1] += pj[1] * v; o[2] += pj[2] * v; o[3] += pj[3] * v;
        }
#pragma unroll
        for (int hh = 0; hh < 4; ++hh) MIX[(size_t)row * 1024 + 512 + (kvh * 4 + hh) * 64 + lane] = (bf16_t)(cvt_pk_bf16(o[hh], 0.f) & 0xffffu);
        LDS_WAIT();
    }
}

__device__ __forceinline__ void swa_item_mfma(CArgs* a, LAS unsigned char* L, int it) {
    const int tid = threadIdx.x, w = __builtin_amdgcn_readfirstlane(tid >> 6), lane = tid & 63, fr = lane & 15, fq = lane >> 4;
    unsigned char* ws = a->ws;
    const bf16_t* QS = (const bf16_t*)(ws + WS_QS); const bf16_t* KS = (const bf16_t*)(ws + WS_KS); const bf16_t* VS = (const bf16_t*)(ws + WS_VS);
    bf16_t* MIX = (bf16_t*)(ws + WS_MIX);
    const bool samp = it >= 1024;
    int b, kvh, tq0, nq, row0;
    if (!samp) { b = it >> 6; const int rem = it & 63; kvh = rem & 1; tq0 = (rem >> 1) * 64; nq = 64; row0 = b * TP; }
    else { const int i2 = it - 1024; b = i2 >> 1; kvh = i2 & 1; tq0 = 0; nq = TS; row0 = MP + b * TS; }
    LAS unsigned char* Ks = L;
    LAS unsigned char* Vt = L + 208 * 144;
    __syncthreads();
    for (int e = tid; e < 208 * 8; e += 512) {
        const int j = e >> 3, d8 = (e & 7) * 8, p = tq0 - 127 + j;
        u32x4 kraw = {0u, 0u, 0u, 0u}, vraw = {0u, 0u, 0u, 0u};
        if (j < 127 + nq) {
            if (p >= 0) { const size_t o_ = (size_t)(row0 + p) * 128 + kvh * 64 + d8; kraw = *(const u32x4*)(KS + o_); vraw = *(const u32x4*)(VS + o_); }
            else if (samp) {
                const size_t o_ = ((size_t)b * 128 + (128 + p)) * 128 + kvh * 64 + d8;
                const f32x4 k0 = *(const f32x4*)(a->in[4] + o_), k1 = *(const f32x4*)(a->in[4] + o_ + 4), v0 = *(const f32x4*)(a->in[5] + o_), v1 = *(const f32x4*)(a->in[5] + o_ + 4);
                kraw.x = cvt_pk_bf16(k0[0], k0[1]); kraw.y = cvt_pk_bf16(k0[2], k0[3]); kraw.z = cvt_pk_bf16(k1[0], k1[1]); kraw.w = cvt_pk_bf16(k1[2], k1[3]);
                vraw.x = cvt_pk_bf16(v0[0], v0[1]); vraw.y = cvt_pk_bf16(v0[2], v0[3]); vraw.z = cvt_pk_bf16(v1[0], v1[1]); vraw.w = cvt_pk_bf16(v1[2], v1[3]);
            }
        }
        *(LAS u32x4*)(Ks + j * 144 + d8 * 2) = kraw;
        LAS unsigned char* vp = Vt + d8 * 432 + j * 2;
        *(LAS bf16_t*)(vp + 0 * 432) = (bf16_t)(vraw.x & 0xffffu); *(LAS bf16_t*)(vp + 1 * 432) = (bf16_t)(vraw.x >> 16);
        *(LAS bf16_t*)(vp + 2 * 432) = (bf16_t)(vraw.y & 0xffffu); *(LAS bf16_t*)(vp + 3 * 432) = (bf16_t)(vraw.y >> 16);
        *(LAS bf16_t*)(vp + 4 * 432) = (bf16_t)(vraw.z & 0xffffu); *(LAS bf16_t*)(vp + 5 * 432) = (bf16_t)(vraw.z >> 16);
        *(LAS bf16_t*)(vp + 6 * 432) = (bf16_t)(vraw.w & 0xffffu); *(LAS bf16_t*)(vp + 7 * 432) = (bf16_t)(vraw.w >> 16);
    }
    __syncthreads();
    const int head = kvh * 4 + (w & 3);
    const float sink = a->in[17][head];
    for (int qt = (w >> 2) * 2; qt < (w >> 2) * 2 + 2; ++qt) {
        const int ql0 = qt * 16;
        if (ql0 >= nq) break;
        const int ql = ql0 + fr, qrow = ql < nq ? ql : nq - 1;
        bf16x8 qB[2];
#pragma unroll
        for (int ks = 0; ks < 2; ++ks) qB[ks] = *(const bf16x8*)(QS + (size_t)(row0 + tq0 + qrow) * 512 + head * 64 + ks * 32 + fq * 8);
        f32x4 st[10];
#pragma unroll
        for (int t = 0; t < 10; ++t) {
            f32x4 acc = {0.f, 0.f, 0.f, 0.f};
#pragma unroll
            for (int ks = 0; ks < 2; ++ks) acc = MFMA16(*(const LAS bf16x8*)(Ks + (ql0 + 16 * t + fr) * 144 + (ks * 32 + fq * 8) * 2), qB[ks], acc);
            st[t] = acc;
        }
        float mx = sink;
#pragma unroll
        for (int t = 0; t < 10; ++t)
#pragma unroll
            for (int r = 0; r < 4; ++r) {
                const int j = ql0 + 16 * t + 4 * fq + r, diff = ql + 127 - j;
                const bool valid = diff >= 0 && diff < 128 && (samp || tq0 - 127 + j >= 0);
                st[t][r] = valid ? st[t][r] : -INFINITY;
                mx = fmaxf(mx, st[t][r]);
            }
        mx = fmaxf(mx, __shfl_xor(mx, 16)); mx = fmaxf(mx, __shfl_xor(mx, 32));
        float sum = 0.f;
#pragma unroll
        for (int t = 0; t < 10; ++t)
#pragma unroll
            for (int r = 0; r < 4; ++r) { const float p = __expf(st[t][r] - mx); st[t][r] = p; sum += p; }
        sum += __shfl_xor(sum, 16); sum += __shfl_xor(sum, 32);
        const float inv = 1.f / (sum + __expf(sink - mx));
        f32x4 oa[4];
#pragma unroll
        for (int mt = 0; mt < 4; ++mt) oa[mt] = (f32x4){0.f, 0.f, 0.f, 0.f};
#pragma unroll
        for (int s2 = 0; s2 < 5; ++s2) {
            u32x4 pw;
            pw.x = cvt_pk_bf16(st[2 * s2][0], st[2 * s2][1]); pw.y = cvt_pk_bf16(st[2 * s2][2], st[2 * s2][3]);
            pw.z = cvt_pk_bf16(st[2 * s2 + 1][0], st[2 * s2 + 1][1]); pw.w = cvt_pk_bf16(st[2 * s2 + 1][2], st[2 * s2 + 1][3]);
            const bf16x8 pB = __builtin_bit_cast(bf16x8, pw);
#pragma unroll
            for (int mt = 0; mt < 4; ++mt) {
                const LAS unsigned char* vp = Vt + (16 * mt + fr) * 432 + (ql0 + 32 * s2 + 4 * fq) * 2;
                const u32x2 v0 = *(const LAS u32x2*)vp, v1 = *(const LAS u32x2*)(vp + 32);
                u32x4 vw; vw.x = v0.x; vw.y = v0.y; vw.z = v1.x; vw.w = v1.y;
                oa[mt] = MFMA16(__builtin_bit_cast(bf16x8, vw), pB, oa[mt]);
            }
        }
        if (ql < nq) {
            bf16_t* dst = MIX + (size_t)(row0 + tq0 + ql) * 1024 + 512 + head * 64 + 4 * fq;
#pragma unroll
            for (int mt = 0; mt < 4; ++mt) {
                u32x2 ow; ow.x = cvt_pk_bf16(oa[mt][0] * inv, oa[mt][1] * inv); ow.y = cvt_pk_bf16(oa[mt][2] * inv, oa[mt][3] * inv);
                *(u32x2*)(dst + 16 * mt) = ow;
            }
        }
    }
}

__device__ __forceinline__ void p5b_finalize(CArgs* a) {
    const int tid = threadIdx.x, lane = tid & 63, wave = tid >> 6;
    unsigned char* ws = a->ws;
    const unsigned char* PROJb = ws + WS_PROJ; bf16_t* MIX = (bf16_t*)(ws + WS_MIX);
    const int gw = blockIdx.x * 8 + wave, NGW = gridDim.x * 8;
    const float* gn = a->in[16] + (lane & 15) * 8;
    const f32x4 g0 = *(const f32x4*)gn, g1 = *(const f32x4*)(gn + 4);
    for (int r = MP + gw; r < M; r += NGW) {
        const float* og = (const float*)(PROJb + (size_t)r * (NINP * 2)) + lane * 8;
        const f32x4 o0 = *(const f32x4*)og, o1 = *(const f32x4*)(og + 4);
        float z[8]; unpack8(*(const u32x4*)((const bf16_t*)(PROJb + (size_t)r * (NINP * 2)) + 1536 + lane * 8), z);
        float ssq = (o0[0] * o0[0] + o0[1] * o0[1]) + (o0[2] * o0[2] + o0[3] * o0[3]) + (o1[0] * o1[0] + o1[1] * o1[1]) + (o1[2] * o1[2] + o1[3] * o1[3]);
        ssq += __shfl_xor(ssq, 1); ssq += __shfl_xor(ssq, 2); ssq += __shfl_xor(ssq, 4); ssq += __shfl_xor(ssq, 8);
        const float rs = rsqrtf(ssq * (1.f / 128.f) + EPS);
        float x[8];
#pragma unroll
        for (int i = 0; i < 4; ++i) { x[i] = o0[i] * rs * g0[i] * (z[i] * sigmoidf_(z[i])); x[4 + i] = o1[i] * rs * g1[i] * (z[4 + i] * sigmoidf_(z[4 + i])); }
        *(u32x4*)(MIX + (size_t)r * 1024 + lane * 8) = pack8(x);
    }
}

__device__ __forceinline__ void p10_final(CArgs* a) {
    const int tid = threadIdx.x, lane = tid & 63, wave = tid >> 6;
    const float* SS5 = (const float*)(a->ws + WS_SS) + 4 * (size_t)M;
    const int gw = blockIdx.x * 8 + wave, NGW = gridDim.x * 8;
    f32x4 g[4];
#pragma unroll
    for (int j = 0; j < 4; ++j) g[j] = ((const f32x4*)a->in[25])[lane + 64 * j];
    for (int r0 = gw; r0 < M; r0 += 2 * NGW) {
        f32x4 v[2][4]; float rs[2];
#pragma unroll
        for (int u = 0; u < 2; ++u) {
            const int r = r0 + u * NGW;
            if (r < M) {
                rs[u] = rsqrtf(SS5[r] * (1.f / DM) + EPS);
                const f32x4* y = (const f32x4*)(a->out + O_Y + (size_t)r * DM);
#pragma unroll
                for (int j = 0; j < 4; ++j) v[u][j] = y[lane + 64 * j];
            }
        }
#pragma unroll
        for (int u = 0; u < 2; ++u) {
            const int r = r0 + u * NGW;
            if (r < M) {
                f32x4* y = (f32x4*)(a->out + O_Y + (size_t)r * DM);
#pragma unroll
                for (int j = 0; j < 4; ++j) y[lane + 64 * j] = v[u][j] * rs[u] * g[j];
            }
        }
    }
}

#define XB_TMO      128
#define XB_XCNT(j)  (256  + 64 * (j))
#define XB_XSUB(j)  (1280 + 64 * (j))
#define XB_XGEN(j)  (2304 + 64 * (j))
#define XB_TOP      3328
#define XB_TOPGEN   3392
#define XCD_BAR_WORDS 3456
#define XB_SPIN_CAP (1u << 18)

__device__ __forceinline__ unsigned xb_ld(unsigned* p)              { return __hip_atomic_load(p, __ATOMIC_RELAXED, __HIP_MEMORY_SCOPE_AGENT); }
__device__ __forceinline__ unsigned xb_add(unsigned* p, unsigned v) { return __hip_atomic_fetch_add(p, v, __ATOMIC_RELAXED, __HIP_MEMORY_SCOPE_AGENT); }
__device__ __forceinline__ unsigned xb_xcc_id() { return (unsigned)__builtin_amdgcn_s_getreg((3 << 11) | 20) & 0xFu; }
#define XB_SPIN(cond, bar) do { unsigned _sp = 0; while (cond) { __builtin_amdgcn_s_sleep(1); \
    if ((++_sp & 255u) == 0u) { if (xb_ld(&(bar)[XB_TMO])) break; if (_sp > XB_SPIN_CAP) { atomicAdd(&(bar)[XB_TMO], 1u); break; } } } } while (0)

struct XcdBarrier {
    unsigned* bar; unsigned x;
    volatile LAS unsigned* st;
};

__device__ __forceinline__ XcdBarrier xcd_barrier_post(unsigned* bar, volatile LAS unsigned* st) {
    XcdBarrier b; b.bar = bar; b.x = xb_xcc_id(); b.st = st;
    if (threadIdx.x == 0) (void)xb_add(&bar[XB_XCNT(b.x)], 1u);
    return b;
}
__device__ __forceinline__ void xcd_barrier_complete(unsigned* bar, unsigned x, unsigned& nloc, unsigned& nx) {
    const unsigned G = gridDim.x * gridDim.y * gridDim.z;
    unsigned sum, cnt, mine, sp = 0u;
    for (;;) {
        sum = 0u; cnt = 0u; mine = 0u;
#pragma unroll
        for (unsigned j = 0; j < 16; ++j) { const unsigned c = xb_ld(&bar[XB_XCNT(j)]); sum += c; cnt += (c > 0u) ? 1u : 0u; mine = (j == x) ? c : mine; }
        if (sum == G) break;
        __builtin_amdgcn_s_sleep(1);
        if ((++sp & 255u) == 0u) { if (xb_ld(&bar[XB_TMO])) break; if (sp > XB_SPIN_CAP) { atomicAdd(&bar[XB_TMO], 1u); break; } }
    }
    nloc = mine > 0u ? mine : 1u; nx = cnt > 0u ? cnt : 1u;
}

__device__ __forceinline__ void xcd_barrier(const XcdBarrier& b) {
    asm volatile("s_waitcnt vmcnt(0)" ::: "memory");
    __syncthreads();
    if (threadIdx.x == 0) {
        unsigned* bar = b.bar;
        __builtin_amdgcn_s_waitcnt(0);
        unsigned nloc = b.st[0], nx = b.st[1];
        if (nloc == 0u) { xcd_barrier_complete(bar, b.x, nloc, nx); b.st[0] = nloc; b.st[1] = nx; }
        const unsigned old = xb_add(&bar[XB_XSUB(b.x)], 1u);
        const unsigned gen = old / nloc;
        if (old + 1u == (gen + 1u) * nloc) {
            __builtin_amdgcn_fence(__ATOMIC_RELEASE, "agent");
            asm volatile("s_waitcnt vmcnt(0)" ::: "memory");
            const unsigned og = xb_add(&bar[XB_TOP], 1u);
            const unsigned tg = og / nx;
            if (og + 1u == (tg + 1u) * nx) xb_add(&bar[XB_TOPGEN], 1u);
            else XB_SPIN(xb_ld(&bar[XB_TOPGEN]) == tg, bar);
            __builtin_amdgcn_fence(__ATOMIC_ACQUIRE, "agent");
            xb_add(&bar[XB_XGEN(b.x)], 1u);
            asm volatile("s_waitcnt vmcnt(0)" ::: "memory");
        } else {
            XB_SPIN(xb_ld(&bar[XB_XGEN(b.x)]) == gen, bar);
            __builtin_amdgcn_fence(__ATOMIC_ACQUIRE, "agent");
            asm volatile("s_waitcnt vmcnt(0)" ::: "memory");
        }
    }
    __syncthreads();
}

constexpr int NPHASE = 13;
#ifndef PHMASK
#define PHMASK 0x1FFF
#endif
#ifndef DUP_MISC
#define DUP_MISC 1
#endif
__global__ void __launch_bounds__(512, 2) mk_fwd(Args a_by_value) {
    extern __shared__ __attribute__((aligned(16))) unsigned char lds_raw[];
    LAS unsigned char* L = (LAS unsigned char*)lds_raw;
    cg::grid_group grid = cg::this_grid();
    const int lo = get_args()->ph_lo, hi = get_args()->ph_hi, G = gridDim.x, bid = blockIdx.x;
    if (lo > 1000) grid.sync();
    volatile LAS unsigned* xbst = (volatile LAS unsigned*)(L + LDS_XB);
    if (threadIdx.x < 2) xbst[threadIdx.x] = 0u;
    __syncthreads();
    if (hi - lo > 1) (void)xcd_barrier_post((unsigned*)(get_args()->ws + WS_BAR), xbst);
#define IN(k) (((PHMASK >> (k)) & 1) && lo <= (k) && (k) < hi)
#define SEAM(k) do { if (IN(k) && IN((k) + 1)) { XcdBarrier xb_; xb_.bar = (unsigned*)(get_args()->ws + WS_BAR); xb_.x = xb_xcc_id(); xb_.st = xbst; xcd_barrier(xb_); } } while (0)
#define PH_ARGS() CArgs* a = get_args(); unsigned char* ws = a->ws; (void)ws
    if (IN(0)) { PH_ARGS(); for (int rep = 0; rep < DUP_MISC; ++rep) p0_prologue(a, L); } SEAM(0);
    if (IN(1)) {
        PH_ARGS(); float* SS = (float*)(ws + WS_SS);
        pg8::Gemm g{(const bf16_t*)(ws + WS_HB), (const bf16_t*)(ws + WS_GU1), M, NGU, DM}; pg8::StaticOrder S; S.init(M, NGU, G, bid);
        EpiSwiglu E{(bf16_t*)(ws + WS_ACT), SS};
#ifndef DUP_P1
#define DUP_P1 1
#endif
        for (int rep = 0; rep < DUP_P1; ++rep)
        pg8::gemm_phase<EpiSwiglu, pg8::StaticOrder, true, true>(L, g, S, E);
    } SEAM(1);
    if (IN(2)) {
        PH_ARGS(); float* SS = (float*)(ws + WS_SS);
        pg8::Gemm g{(const bf16_t*)(ws + WS_ACT), (const bf16_t*)(ws + WS_D1), M, DM, DFF}; pg8::StaticOrder S; S.init(M, DM, G, bid);
        EpiResid E{a->in[0], a->in[1], a->out + O_Y, (bf16_t*)(ws + WS_HB), SS + M, 0.5f};
        pg8::gemm_phase<EpiResid, pg8::StaticOrder, true, true>(L, g, S, E);
    } SEAM(2);
    if (IN(3)) {
        PH_ARGS(); float* SS = (float*)(ws + WS_SS);
        pg8::Gemm g{(const bf16_t*)(ws + WS_HB), (const bf16_t*)(ws + WS_IN), M, NINP, DM}; pg8::StaticOrder S; S.init(M, NINP, G, bid);
        EpiProj E{(bf16_t*)(ws + WS_PROJ), SS + M, (float*)(ws + WS_AB)};
        pg8::gemm_phase<EpiProj, pg8::StaticOrder, true, true>(L, g, S, E);
    } SEAM(3);
    if (IN(4)) { PH_ARGS(); for (int rep = 0; rep < DUP_MISC; ++rep) p4_mixprep(a); } SEAM(4);
    if (IN(5)) { PH_ARGS(); for (int pr = bid; pr < 1024; pr += G) gdn_chunk_prep(a, L, pr); } SEAM(5);
    if (IN(6)) {
        PH_ARGS();
        const int nded = G >= 128 ? 64 : 0;
        if (bid < nded) gdn_chunk_scan(a, L, bid);
        unsigned* ctr = (unsigned*)(ws + WS_CTR);
        LAS unsigned* wq = (LAS unsigned*)(L + LDS_WQ);
        const int nitems = (nded ? 0 : 64) + 2048 + 1280;
        for (;;) {
            __syncthreads();
            if (threadIdx.x == 0) *wq = __hip_atomic_fetch_add(ctr, 1u, __ATOMIC_RELAXED, __HIP_MEMORY_SCOPE_AGENT);
            __syncthreads();
            int it = (int)*wq;
            if (it >= nitems) break;
            if (!nded) { if (it < 64) { gdn_chunk_scan(a, L, it); continue; } it -= 64; }
            if (it < 1280) swa_item_mfma(a, L, it);
            else gdn_item(a, L, it - 1280, true);
        }
    } SEAM(6);
    if (IN(7)) { PH_ARGS(); p5b_finalize(a); } SEAM(7);
    if (IN(8)) {
        PH_ARGS(); float* SS = (float*)(ws + WS_SS); float* HF = a->out + O_Y;
        pg8::Gemm g{(const bf16_t*)(ws + WS_MIX), (const bf16_t*)(ws + WS_OUT), M, DM, DM}; pg8::StaticOrder S; S.init(M, DM, G, bid);
        EpiResid E{HF, HF + (size_t)MP * DM, HF, (bf16_t*)(ws + WS_HB), SS + 2 * M, 1.0f};
        pg8::gemm_phase<EpiResid, pg8::StaticOrder, true, true>(L, g, S, E);
    } SEAM(8);
    if (IN(9)) {
        PH_ARGS(); float* SS = (float*)(ws + WS_SS);
        pg8::Gemm g{(const bf16_t*)(ws + WS_HB), (const bf16_t*)(ws + WS_GU2), M, NGU, DM}; pg8::StaticOrder S; S.init(M, NGU, G, bid);
        EpiSwiglu E{(bf16_t*)(ws + WS_ACT), SS + 2 * M};
        pg8::gemm_phase<EpiSwiglu, pg8::StaticOrder, true, true>(L, g, S, E);
    } SEAM(9);
    if (IN(10)) {
        {
            PH_ARGS(); float* SS = (float*)(ws + WS_SS); float* HF = a->out + O_Y;
            pg8::Gemm g{(const bf16_t*)(ws + WS_ACT), (const bf16_t*)(ws + WS_D2), M, DM, DFF}; pg8::StaticOrder S; S.init(M, DM, G, bid);
            EpiResid E{HF, HF + (size_t)MP * DM, HF, (bf16_t*)(ws + WS_HB), SS + 3 * M, 0.5f};
            pg8::gemm_phase<EpiResid, pg8::StaticOrder, true, true>(L, g, S, E);
        }
        const int nheavy = (G == 256) ? 16 : 0;
        if (bid >= nheavy) {
            PH_ARGS();
            int kple = PLE; asm volatile("" : "+s"(kple)); kple = __builtin_amdgcn_readfirstlane(kple);
            pg8::Gemm g{(const bf16_t*)(ws + WS_PB), (const bf16_t*)(ws + WS_PPW), M, DM, kple}; pg8::StaticOrder S; S.init(M, DM, G - nheavy, bid - nheavy);
            EpiPlain E{(bf16_t*)(ws + WS_PP)};
            pg8::gemm_phase<EpiPlain, pg8::StaticOrder, true, true>(L, g, S, E);
        }
    } SEAM(10);
    if (IN(11)) {
        PH_ARGS(); float* SS = (float*)(ws + WS_SS);
        pg8::Gemm g{(const bf16_t*)(ws + WS_HB), (const bf16_t*)(ws + WS_PG), M, DM, DM}; pg8::StaticOrder S; S.init(M, DM, G, bid);
        EpiGate E{a->out + O_Y, (const bf16_t*)(ws + WS_PP), SS + 3 * M, SS + 4 * M};
        pg8::gemm_phase<EpiGate, pg8::StaticOrder, true, true>(L, g, S, E);
    } SEAM(11);
    if (IN(12)) { PH_ARGS(); p10_final(a); }
#undef IN
#undef SEAM
#undef PH_ARGS
}

#ifndef MK_LAUNCHES
#define MK_LAUNCHES 1
#endif
extern "C" void kernel_launch(void* const* d_in, const int* in_sizes, int n_in, void* d_out, int out_size, void* d_ws, size_t ws_size, hipStream_t stream) {
    static int grid = 0;
    if (grid == 0) {
        if (n_in != 26 || (size_t)out_size != O_END || ws_size < WS_END) {
            fprintf(stderr, "kernel_launch: unexpected shapes: n_in %d out %d ws %zu (need out %zu, ws >= %zu)\n", n_in, out_size, ws_size, (size_t)O_END, (size_t)WS_END);
            grid = -1; return;
        }
        int dev = 0, cus = 0, per_cu = 0;
        hipGetDevice(&dev);
        hipDeviceGetAttribute(&cus, hipDeviceAttributeMultiprocessorCount, dev);
        if (hipFuncSetAttribute((const void*)mk_fwd, hipFuncAttributeMaxDynamicSharedMemorySize, LDS_BYTES) != hipSuccess) { fprintf(stderr, "kernel_launch: hipFuncSetAttribute failed\n"); grid = -1; return; }
        if (hipOccupancyMaxActiveBlocksPerMultiprocessor(&per_cu, (const void*)mk_fwd, 512, LDS_BYTES) != hipSuccess || per_cu < 1) { fprintf(stderr, "kernel_launch: occupancy query gave %d\n", per_cu); per_cu = 1; }
        (void)hipGetLastError();
        grid = cus * per_cu;
        fprintf(stderr, "kernel_launch: grid %d (cus %d x %d)\n", grid, cus, per_cu);
    }
    if (grid < 0) return;
    Args a{};
    for (int i = 0; i < 26; ++i) a.in[i] = (const float*)d_in[i];
    a.out = (float*)d_out; a.ws = (unsigned char*)d_ws;
    if (hipMemsetAsync((unsigned char*)d_ws + WS_BAR, 0, WS_BAR_BYTES, stream) != hipSuccess) { fprintf(stderr, "kernel_launch: memset of the barrier words failed\n"); return; }
#if MK_LAUNCHES == 1
    a.ph_lo = 0; a.ph_hi = NPHASE;
    void* kargs[] = {&a};
    hipError_t e = hipLaunchCooperativeKernel((const void*)mk_fwd, dim3(grid), dim3(512), kargs, LDS_BYTES, stream);
    if (e != hipSuccess) fprintf(stderr, "kernel_launch: cooperative launch failed: %s (grid %d)\n", hipGetErrorString(e), grid);
#else
    for (int p = 0; p < NPHASE; ++p) {
        a.ph_lo = p; a.ph_hi = p + 1;
        hipLaunchKernelGGL(mk_fwd, dim3(grid), dim3(512), LDS_BYTES, stream, a);
    }
#endif
}
```
